# Optimizing an MI355X kernel written in HIP

```python
import jax, jax.numpy as jnp
from jax import lax
import numpy as np


D_MODEL = 1024
BATCH = 16
SEQ = 2048
DEPTH = 4

GRID_W = 64
CTX_LEN = 256
N_MIXERS = 4
EPS = 1e-6
ROPE_THETA = 10000.0
NEG_INF = -1e30
Q_BLOCK = 128
HEAD_DIM = 64
D_FF = -(-(8 * D_MODEL) // (3 * 256)) * 256
SWA_HEADS = D_MODEL // HEAD_DIM
SWA_KV_HEADS = 4
SWA_WINDOW = 128
NA_HEADS = D_MODEL // HEAD_DIM
NA_KH = 8
NA_KW = 16
NA_QCB = 16
NA_SLAB = 2 * NA_KW
POOL_WINDOWS = (2, 4, 8, 16)
POOL_GROUPS = len(POOL_WINDOWS)
POOL_DG = D_MODEL // POOL_GROUPS
MLA_HEADS = 16
MLA_NOPE = 64
MLA_ROPE = 32
MLA_V = 64
MLA_Q_RANK = 256
MLA_KV_RANK = 128

kernel_name = 'hybrid_interleaved_diffusion_trunk'


def n_layers_of(m):
    return len(range(m, DEPTH, N_MIXERS))


def rms_norm(x, g):
    xf = x.astype(jnp.float32)
    y = xf * lax.rsqrt(jnp.mean(xf * xf, axis=-1, keepdims=True) + EPS)
    return (y * g.astype(jnp.float32)).astype(x.dtype)


def modulate(x, g, shift, scale):
    return rms_norm(x, g) * (1 + scale) + shift


def rope_1d(x, pos):
    half = x.shape[-1] // 2
    freqs = ROPE_THETA ** (-jnp.arange(half, dtype=jnp.float32) / half)
    ang = pos.astype(jnp.float32)[:, None] * freqs[None, :]
    cos = jnp.cos(ang)[:, None, :]
    sin = jnp.sin(ang)[:, None, :]
    xf = x.astype(jnp.float32)
    x1, x2 = xf[..., :half], xf[..., half:]
    return jnp.concatenate([x1 * cos - x2 * sin, x1 * sin + x2 * cos], -1).astype(x.dtype)


def rope_2d_axial(x, length):
    t = jnp.arange(length)
    d = x.shape[-1] // 2
    return jnp.concatenate([rope_1d(x[..., :d], t // GRID_W), rope_1d(x[..., d:], t % GRID_W)], -1)


def softmax_f32(s, sink=None):
    if sink is None:
        return jax.nn.softmax(s, axis=-1)
    sink = jnp.broadcast_to(sink, s.shape[:-1] + (1,))
    return jax.nn.softmax(jnp.concatenate([s, sink], -1), axis=-1)[..., :-1]


def swiglu(h, w_gu, w_down):
    gu = h @ w_gu
    return (jax.nn.silu(gu[..., :D_FF]) * gu[..., D_FF:]) @ w_down


def swa_mixer(a_lat, a_ctx, w_qkv, g_q, g_k, sink, w_o, need_ctx):
    B, L, _ = a_lat.shape
    Lc = a_ctx.shape[1]
    Hq, Hk, dh = SWA_HEADS, SWA_KV_HEADS, HEAD_DIM
    G = Hq // Hk
    nq, nk = Hq * dh, Hk * dh
    scale = dh ** -0.5
    qkv = a_lat @ w_qkv
    q = rope_2d_axial(rms_norm(qkv[..., :nq].reshape(B, L, Hq, dh), g_q), L)
    k = rope_2d_axial(rms_norm(qkv[..., nq:nq + nk].reshape(B, L, Hk, dh), g_k), L)
    v = qkv[..., nq + nk:].reshape(B, L, Hk, dh)
    kv_c = a_ctx @ w_qkv[:, nq:]
    k_c = rms_norm(kv_c[..., :nk].reshape(B, Lc, Hk, dh), g_k)
    v_c = kv_c[..., nk:].reshape(B, Lc, Hk, dh)
    sink_g = sink.astype(jnp.float32).reshape(Hk, G)[None, :, :, None, None]
    nb = L // Q_BLOCK
    span = Q_BLOCK + 2 * SWA_WINDOW
    pad = ((0, 0), (SWA_WINDOW, SWA_WINDOW), (0, 0), (0, 0))
    k_p = jnp.pad(k, pad)
    v_p = jnp.pad(v, pad)
    q_blocks = jnp.moveaxis(q.reshape(B, nb, Q_BLOCK, Hk, G, dh), 1, 0)
    ctx_valid = jnp.ones((Q_BLOCK, Lc), bool)

    def block(args):
        b, q_b = args
        start = b * Q_BLOCK
        k_b = jnp.concatenate([lax.dynamic_slice_in_dim(k_p, start, span, 1), k_c], 1)
        v_b = jnp.concatenate([lax.dynamic_slice_in_dim(v_p, start, span, 1), v_c], 1)
        q_pos = start + jnp.arange(Q_BLOCK)
        k_pos = start - SWA_WINDOW + jnp.arange(span)
        valid = (jnp.abs(q_pos[:, None] - k_pos[None, :]) <= SWA_WINDOW) & (k_pos >= 0) & (k_pos < L)
        valid = jnp.concatenate([valid, ctx_valid], 1)
        s = jnp.einsum('bqhgd,bkhd->bhgqk', q_b, k_b, preferred_element_type=jnp.float32) * scale
        p = softmax_f32(jnp.where(valid, s, NEG_INF), sink_g).astype(v_b.dtype)
        return jnp.einsum('bhgqk,bkhd->bqhgd', p, v_b)

    o = lax.map(block, (jnp.arange(nb), q_blocks))
    y_lat = jnp.moveaxis(o, 0, 1).reshape(B, L, nq) @ w_o
    y_ctx = None
    if need_ctx:
        q_c = rms_norm((a_ctx @ w_qkv[:, :nq]).reshape(B, Lc, Hk, G, dh), g_q)
        s = jnp.einsum('bqhgd,bkhd->bhgqk', q_c, k_c, preferred_element_type=jnp.float32) * scale
        p = softmax_f32(s, sink_g).astype(v_c.dtype)
        y_ctx = jnp.einsum('bhgqk,bkhd->bqhgd', p, v_c).reshape(B, Lc, nq) @ w_o
    return y_lat, y_ctx


def na_mixer(a_lat, a_ctx, w_qkv, g_q, g_k, rpb, w_o, need_ctx):
    B, L, _ = a_lat.shape
    Lc = a_ctx.shape[1]
    H, dh = NA_HEADS, HEAD_DIM
    n = H * dh
    scale = dh ** -0.5
    rows = L // GRID_W
    kh = min(NA_KH, rows)
    qkv = a_lat @ w_qkv
    q = rms_norm(qkv[..., :n].reshape(B, rows, GRID_W, H, dh), g_q)
    k = rms_norm(qkv[..., n:2 * n].reshape(B, rows, GRID_W, H, dh), g_k)
    v = qkv[..., 2 * n:].reshape(B, rows, GRID_W, H, dh)
    kv_c = a_ctx @ w_qkv[:, n:]
    k_c = rms_norm(kv_c[..., :n].reshape(B, Lc, H, dh), g_k)
    v_c = kv_c[..., n:].reshape(B, Lc, H, dh)
    ncb = GRID_W // NA_QCB
    q_col = np.arange(GRID_W).reshape(ncb, NA_QCB)
    slab0 = [int(s) for s in np.clip(np.arange(ncb) * NA_QCB - NA_KW // 2, 0, GRID_W - NA_SLAB)]
    col_start = np.clip(q_col - NA_KW // 2, 0, GRID_W - NA_KW)
    key_col = np.asarray(slab0)[:, None] + np.arange(NA_SLAB)
    kc3 = key_col[:, None, :]
    col_valid = (kc3 >= col_start[..., None]) & (kc3 < col_start[..., None] + NA_KW)
    dc_idx = (np.clip(kc3 - q_col[..., None], -(NA_KW - 1), NA_KW - 1) + NA_KW - 1)[:, :, None, :]
    nkey = kh * NA_SLAB
    valid_lat = np.broadcast_to(col_valid[:, :, None, :], (ncb, NA_QCB, kh, NA_SLAB)).reshape(ncb, NA_QCB, nkey)
    valid = jnp.asarray(np.concatenate([valid_lat, np.ones((ncb, NA_QCB, Lc), bool)], -1))
    rpb_f = rpb.astype(jnp.float32)

    def slabs(t):
        return jnp.stack([t[:, :, s:s + NA_SLAB] for s in slab0], 1).reshape(B, ncb, nkey, H, dh)

    def row_step(args):
        r, q_r = args
        r0 = jnp.clip(r - kh // 2, 0, rows - kh)
        k_s = slabs(lax.dynamic_slice_in_dim(k, r0, kh, 1))
        v_s = slabs(lax.dynamic_slice_in_dim(v, r0, kh, 1))
        dr_idx = (r0 + jnp.arange(kh) - r + NA_KH - 1)[None, None, :, None]
        bias = rpb_f[:, dr_idx, dc_idx].reshape(H, ncb, NA_QCB, nkey)
        q_b = q_r.reshape(B, ncb, NA_QCB, H, dh)
        s_lat = jnp.einsum('bjqhd,bjkhd->bhjqk', q_b, k_s, preferred_element_type=jnp.float32) * scale + bias
        s_ctx = jnp.einsum('bjqhd,bkhd->bhjqk', q_b, k_c, preferred_element_type=jnp.float32) * scale
        p = softmax_f32(jnp.where(valid, jnp.concatenate([s_lat, s_ctx], -1), NEG_INF)).astype(v.dtype)
        o = (jnp.einsum('bhjqk,bjkhd->bjqhd', p[..., :nkey], v_s)
             + jnp.einsum('bhjqk,bkhd->bjqhd', p[..., nkey:], v_c))
        return o.reshape(B, GRID_W, H, dh)

    o = lax.map(row_step, (jnp.arange(rows), jnp.moveaxis(q, 1, 0)))
    y_lat = jnp.moveaxis(o, 0, 1).reshape(B, L, n) @ w_o
    y_ctx = None
    if need_ctx:
        q_c = rms_norm((a_ctx @ w_qkv[:, :n]).reshape(B, Lc, H, dh), g_q)
        s = jnp.einsum('bqhd,bkhd->bhqk', q_c, k_c, preferred_element_type=jnp.float32) * scale
        p = softmax_f32(s).astype(v_c.dtype)
        y_ctx = jnp.einsum('bhqk,bkhd->bqhd', p, v_c).reshape(B, Lc, n) @ w_o
    return y_lat, y_ctx


def multi_pool(h):
    B, L, _ = h.shape
    hf = h.astype(jnp.float32)
    cs = jnp.pad(lax.cumsum(hf, axis=1), ((0, 0), (1, 0), (0, 0)))
    t = jnp.arange(L)
    outs = []
    for g, w in enumerate(POOL_WINDOWS):
        lo = jnp.clip(t - w // 2, 0, L)
        hi = jnp.clip(t - w // 2 + w, 0, L)
        cg = cs[..., g * POOL_DG:(g + 1) * POOL_DG]
        outs.append((cg[:, hi] - cg[:, lo]) / (hi - lo).astype(jnp.float32)[None, :, None])
    return (jnp.concatenate(outs, -1) - hf).astype(h.dtype)


def pool_mixer(a_lat, a_ctx, w, b, scale, need_ctx):
    def mix(h):
        B, L, _ = h.shape
        p = multi_pool(h).reshape(B, L, POOL_GROUPS, POOL_DG)
        y = jnp.einsum('blgc,gcd->blgd', p, w) + b
        return y.reshape(B, L, D_MODEL) * scale
    return mix(a_lat), (mix(a_ctx) if need_ctx else None)


def mla_mixer(a_lat, a_ctx, w_a, g_cq, g_ckv, w_uq, w_ukv, g_q, g_k, w_o, need_ctx):
    H, dn, dr, dv = MLA_HEADS, MLA_NOPE, MLA_ROPE, MLA_V
    dqk = dn + dr
    qr = MLA_Q_RANK
    scale = dqk ** -0.5

    def queries(cq_raw):
        B_, L_, _ = cq_raw.shape
        c_q = rms_norm(cq_raw, g_cq)
        return rms_norm((c_q @ w_uq).reshape(B_, L_, H, dqk), g_q)

    def keys_values(kv_raw):
        B_, L_, _ = kv_raw.shape
        c_kv = rms_norm(kv_raw[..., :MLA_KV_RANK], g_ckv)
        k_r = jnp.broadcast_to(kv_raw[..., MLA_KV_RANK:][:, :, None, :], (B_, L_, H, dr))
        kv = (c_kv @ w_ukv).reshape(B_, L_, H, dn + dv)
        k = rms_norm(jnp.concatenate([kv[..., :dn], k_r], -1), g_k)
        return k, kv[..., dn:]

    def rope_part(t):
        return jnp.concatenate([t[..., :dn], rope_2d_axial(t[..., dn:], t.shape[1])], -1)

    B, L, _ = a_lat.shape
    Lc = a_ctx.shape[1]
    proj = a_lat @ w_a
    q = rope_part(queries(proj[..., :qr]))
    k, v = keys_values(proj[..., qr:])
    k = rope_part(k)
    if need_ctx:
        proj_c = a_ctx @ w_a
        q_c = queries(proj_c[..., :qr])
        kv_raw_c = proj_c[..., qr:]
    else:
        kv_raw_c = a_ctx @ w_a[:, qr:]
    k_c, v_c = keys_values(kv_raw_c)
    k_all = jnp.concatenate([k, k_c], 1)
    v_all = jnp.concatenate([v, v_c], 1)
    nb = L // Q_BLOCK
    q_blocks = jnp.moveaxis(q.reshape(B, nb, Q_BLOCK, H, dqk), 1, 0)

    def block(q_b):
        s = jnp.einsum('bqhd,bkhd->bhqk', q_b, k_all, preferred_element_type=jnp.float32) * scale
        p = softmax_f32(s).astype(v_all.dtype)
        return jnp.einsum('bhqk,bkhd->bqhd', p, v_all)

    o = lax.map(block, q_blocks)
    y_lat = jnp.moveaxis(o, 0, 1).reshape(B, L, H * dv) @ w_o
    y_ctx = None
    if need_ctx:
        s = jnp.einsum('bqhd,bkhd->bhqk', q_c, k_c, preferred_element_type=jnp.float32) * scale
        p = softmax_f32(s).astype(v_c.dtype)
        y_ctx = jnp.einsum('bhqk,bkhd->bqhd', p, v_c).reshape(B, Lc, H * dv) @ w_o
    return y_lat, y_ctx


def setup_inputs(seed: int = 0) -> dict:
    key = jax.random.key(seed)
    ks = iter(jax.random.split(key, 48))
    f32 = jnp.float32

    def nrm(shape, fan_in, gain=1.0):
        return jax.random.normal(next(ks), shape, f32) * (gain * fan_in ** -0.5)

    def gains(shape):
        return 1.0 + 0.05 * jax.random.normal(next(ks), shape, f32)

    def small(shape, s=0.01):
        return s * jax.random.normal(next(ks), shape, f32)

    D = D_MODEL
    nA, nB, nC, nD = (n_layers_of(m) for m in range(N_MIXERS))
    dqk = MLA_NOPE + MLA_ROPE
    return {
        'x': jax.random.normal(next(ks), (BATCH, SEQ, D), f32),
        'c': jax.random.normal(next(ks), (BATCH, D), f32),
        'ctx': jax.random.normal(next(ks), (BATCH, CTX_LEN, D), f32),
        'c_ctx': jax.random.normal(next(ks), (D,), f32),
        'w_ada': nrm((DEPTH, D, 6 * D), D, 0.5),
        'b_ada': small((DEPTH, 6 * D)),
        'g_mix': gains((DEPTH, D)),
        'g_ffn': gains((DEPTH, D)),
        'w_gate_up': nrm((DEPTH, D, 2 * D_FF), D),
        'w_down': nrm((DEPTH, D_FF, D), D_FF),
        'swa_w_qkv': nrm((nA, D, (SWA_HEADS + 2 * SWA_KV_HEADS) * HEAD_DIM), D),
        'swa_g_q': gains((nA, HEAD_DIM)),
        'swa_g_k': gains((nA, HEAD_DIM)),
        'swa_sink': small((nA, SWA_HEADS), 0.5),
        'swa_w_o': nrm((nA, SWA_HEADS * HEAD_DIM, D), SWA_HEADS * HEAD_DIM),
        'na_w_qkv': nrm((nB, D, 3 * NA_HEADS * HEAD_DIM), D),
        'na_g_q': gains((nB, HEAD_DIM)),
        'na_g_k': gains((nB, HEAD_DIM)),
        'na_rpb': small((nB, NA_HEADS, 2 * NA_KH - 1, 2 * NA_KW - 1), 0.1),
        'na_w_o': nrm((nB, NA_HEADS * HEAD_DIM, D), NA_HEADS * HEAD_DIM),
        'pool_w': nrm((nC, POOL_GROUPS, POOL_DG, POOL_DG), POOL_DG),
        'pool_b': small((nC, POOL_GROUPS, POOL_DG)),
        'pool_scale': gains((nC, D)),
        'mla_w_a': nrm((nD, D, MLA_Q_RANK + MLA_KV_RANK + MLA_ROPE), D),
        'mla_g_cq': gains((nD, MLA_Q_RANK)),
        'mla_g_ckv': gains((nD, MLA_KV_RANK)),
        'mla_w_uq': nrm((nD, MLA_Q_RANK, MLA_HEADS * dqk), MLA_Q_RANK),
        'mla_w_ukv': nrm((nD, MLA_KV_RANK, MLA_HEADS * (MLA_NOPE + MLA_V)), MLA_KV_RANK),
        'mla_g_q': gains((nD, dqk)),
        'mla_g_k': gains((nD, dqk)),
        'mla_w_o': nrm((nD, MLA_HEADS * MLA_V, D), MLA_HEADS * MLA_V),
    }


def reference(x, c, ctx, c_ctx, w_ada, b_ada, g_mix, g_ffn, w_gate_up, w_down,
              swa_w_qkv, swa_g_q, swa_g_k, swa_sink, swa_w_o,
              na_w_qkv, na_g_q, na_g_k, na_rpb, na_w_o,
              pool_w, pool_b, pool_scale,
              mla_w_a, mla_g_cq, mla_g_ckv, mla_w_uq, mla_w_ukv, mla_g_q, mla_g_k, mla_w_o):
    cond = jax.nn.silu(c)
    cond_c = jax.nn.silu(c_ctx)
    h, hc = x, ctx
    for i in range(DEPTH):
        m, j = i % N_MIXERS, i // N_MIXERS
        need_ctx = i < DEPTH - 1
        mod = (cond @ w_ada[i] + b_ada[i])[:, None, :]
        mod_c = cond_c @ w_ada[i] + b_ada[i]
        sh1, sc1, gt1, sh2, sc2, gt2 = jnp.split(mod, 6, axis=-1)
        sh1c, sc1c, gt1c, sh2c, sc2c, gt2c = jnp.split(mod_c, 6, axis=-1)
        a = modulate(h, g_mix[i], sh1, sc1)
        ac = modulate(hc, g_mix[i], sh1c, sc1c)
        if m == 0:
            y, yc = swa_mixer(a, ac, swa_w_qkv[j], swa_g_q[j], swa_g_k[j], swa_sink[j], swa_w_o[j], need_ctx)
        elif m == 1:
            y, yc = na_mixer(a, ac, na_w_qkv[j], na_g_q[j], na_g_k[j], na_rpb[j], na_w_o[j], need_ctx)
        elif m == 2:
            y, yc = pool_mixer(a, ac, pool_w[j], pool_b[j], pool_scale[j], need_ctx)
        else:
            y, yc = mla_mixer(a, ac, mla_w_a[j], mla_g_cq[j], mla_g_ckv[j], mla_w_uq[j], mla_w_ukv[j],
                              mla_g_q[j], mla_g_k[j], mla_w_o[j], need_ctx)
        h = h + gt1 * y
        h = h + gt2 * swiglu(modulate(h, g_ffn[i], sh2, sc2), w_gate_up[i], w_down[i])
        if need_ctx:
            hc = hc + gt1c * yc
            hc = hc + gt2c * swiglu(modulate(hc, g_ffn[i], sh2c, sc2c), w_gate_up[i], w_down[i])
    return h
```

```cpp
#include <hip/hip_runtime.h>
#include <hip/hip_cooperative_groups.h>
#include <cstdio>
#include <cstdint>
#include <cmath>
namespace cg = cooperative_groups;

namespace pg8 {
#define PG8_LAS __attribute__((address_space(3)))
typedef unsigned short bf16_t;
typedef short bf16x8 __attribute__((ext_vector_type(8)));
typedef float f32x4 __attribute__((ext_vector_type(4)));
typedef unsigned u32x4 __attribute__((ext_vector_type(4)));
constexpr int BM = 256, BK = 64, HALF = 128, HTB = HALF * BK * 2  , STAGE_BYTES = 8 * HTB, NXCD = 8, WGM = 8;

__host__ __device__ __forceinline__ int lds_byte(int r, int c) { const int st = (r >> 4) * 2 + (c >> 5), rr = r & 15, cc = c & 31, ob = rr * 64 + cc * 2; return st * 1024 + (ob ^ (((ob >> 9) & 1) << 5)); }
__host__ __device__ __forceinline__ void stage_rc(int b, int& R, int& C) { const int st = b / 1024, sb = b % 1024, swz = sb ^ (((sb >> 9) & 1) << 5); R = (st >> 1) * 16 + swz / 64; C = (st & 1) * 32 + (swz % 64) / 2; }
__host__ __device__ __forceinline__ int perm32(int rho) { const int n = rho >> 4, i = rho & 15; return 8 * (i >> 2) + 4 * n + (i & 3); }

struct Unit { int pm, pn; };
struct Gemm { const bf16_t* A; const bf16_t* Bt; int M, N, K, lda, ldb, akoff; };

struct StaticOrder {
    int nM, nN, nwg, G, c;
    __host__ __device__ void init(int M, int N, int G_, int c_) { nM = M / BM; nN = N / BM; nwg = nM * nN; G = G_; c = c_; }
    __host__ __device__ bool next(int i, Unit& u) const {
        const long L = (long)i * G + c; if (L >= nwg) return false;
        int wgid = (int)L; { const int q = nwg / NXCD, r = nwg % NXCD, xcd = wgid % NXCD, off = wgid / NXCD; wgid = (xcd < r ? xcd * (q + 1) : r * (q + 1) + (xcd - r) * q) + off; }
        const int nig = WGM * nN, gid = wgid / nig, fm = gid * WGM, gsz = (nM - fm) < WGM ? (nM - fm) : WGM;
        u.pm = fm + ((wgid % nig) % gsz); u.pn = (wgid % nig) / gsz; return true;
    }
    __device__ __forceinline__ void a_ready(const Unit&) const {}
    __device__ __forceinline__ void done(const Unit&) const {}
};

__device__ __forceinline__ unsigned cvt_pk_bf16(float lo, float hi) { unsigned r; asm volatile("v_cvt_pk_bf16_f32 %0, %1, %2" : "=v"(r) : "v"(lo), "v"(hi)); return r; }

struct EpiStore {
    static constexpr bool PERM = true, AFTER_DRAIN = false;
    bf16_t* O; int ldc;
    __device__ __forceinline__ void operator()(const f32x4 (&acc)[2][2][4][2], const Unit& u, int wr, int wc, int fr, int fq) const {
        const int row0 = u.pm * BM + wr * 64 + fr, col0 = u.pn * BM + wc * 32 + 8 * fq;
#pragma unroll
        for (int ai = 0; ai < 2; ++ai)
#pragma unroll
            for (int m = 0; m < 4; ++m) { bf16_t* rowp = O + (size_t)(row0 + ai * HALF + m * 16) * ldc + col0;
#pragma unroll
                for (int bj = 0; bj < 2; ++bj) { const f32x4 v0 = acc[ai][bj][m][0], v1 = acc[ai][bj][m][1];
                    u32x4 w; w.x = cvt_pk_bf16(v0[0], v0[1]); w.y = cvt_pk_bf16(v0[2], v0[3]); w.z = cvt_pk_bf16(v1[0], v1[1]); w.w = cvt_pk_bf16(v1[2], v1[3]);
                    *(u32x4*)(rowp + bj * HALF) = w; } }
    }
};
__device__ __forceinline__ float silu_mul(float g, float u) { return g * u * __builtin_amdgcn_rcpf(1.0f + __builtin_amdgcn_exp2f(-1.4426950408889634f * g)); }
struct EpiSwiglu {
    static constexpr bool PERM = true, AFTER_DRAIN = false;
    bf16_t* O; int ldc;
    __device__ __forceinline__ void operator()(const f32x4 (&acc)[2][2][4][2], const Unit& u, int wr, int wc, int fr, int fq) const {
        const int row0 = u.pm * BM + wr * 64 + fr, col0 = u.pn * HALF + wc * 32 + 8 * fq;
#pragma unroll
        for (int ai = 0; ai < 2; ++ai)
#pragma unroll
            for (int m = 0; m < 4; ++m) { bf16_t* rowp = O + (size_t)(row0 + ai * HALF + m * 16) * ldc + col0;
                const f32x4 g0 = acc[ai][0][m][0], g1 = acc[ai][0][m][1], u0 = acc[ai][1][m][0], u1 = acc[ai][1][m][1];
                u32x4 w; w.x = cvt_pk_bf16(silu_mul(g0[0], u0[0]), silu_mul(g0[1], u0[1])); w.y = cvt_pk_bf16(silu_mul(g0[2], u0[2]), silu_mul(g0[3], u0[3]));
                w.z = cvt_pk_bf16(silu_mul(g1[0], u1[0]), silu_mul(g1[1], u1[1])); w.w = cvt_pk_bf16(silu_mul(g1[2], u1[2]), silu_mul(g1[3], u1[3]));
                *(u32x4*)rowp = w; }
    }
};
constexpr int EP_LAT = 32768, EP_SEQ = 2048, EP_D = 1024, EP_MODLD = 6144;
struct EpiArgs { const float* in[31]; float* out; unsigned char* ws; int ph_lo, ph_hi; };
struct EpiResid {
    static constexpr bool PERM = false, AFTER_DRAIN = false;
    int first;
    int gate_off;
    int pool;
    unsigned mod_byte, hc_byte;
    __device__ __forceinline__ void operator()(const f32x4 (&acc)[2][2][4][2], const Unit& u, int wr, int wc, int fr, int fq) const {
        const __attribute__((address_space(4))) EpiArgs* a = (const __attribute__((address_space(4))) EpiArgs*)__builtin_amdgcn_kernarg_segment_ptr(); asm volatile("" : "+s"(a));
        unsigned char* ws = a->ws; float* HCp = (float*)(ws + hc_byte);
        const float* in_lat = first ? a->in[0] : a->out; const float* in_ctx = first ? a->in[2] : HCp; float* out_lat = a->out; float* out_ctx = HCp;
        const float* gate = (const float*)(ws + mod_byte) + gate_off; const float* bias = pool ? a->in[21] : nullptr; const float* cscale = pool ? a->in[22] : nullptr;
        const int rt = u.pm * BM; const bool isl = rt < EP_LAT; const int b = isl ? rt / EP_SEQ : 16;
        const float* ip = isl ? in_lat : in_ctx - (size_t)EP_LAT * EP_D; float* op = isl ? out_lat : out_ctx - (size_t)EP_LAT * EP_D;
        const int col0 = u.pn * BM + wc * 32 + 4 * fq; const float* gp = gate + (size_t)b * EP_MODLD + col0;
        f32x4 gv[2][2], bv[2][2], sv[2][2];
#pragma unroll
        for (int bj = 0; bj < 2; ++bj)
#pragma unroll
            for (int n = 0; n < 2; ++n) { gv[bj][n] = *(const f32x4*)(gp + bj * HALF + n * 16);
                bv[bj][n] = bias ? *(const f32x4*)(bias + col0 + bj * HALF + n * 16) : (f32x4){0.f, 0.f, 0.f, 0.f};
                sv[bj][n] = cscale ? *(const f32x4*)(cscale + col0 + bj * HALF + n * 16) : (f32x4){1.f, 1.f, 1.f, 1.f}; }
#pragma unroll
        for (int ai = 0; ai < 2; ++ai)
#pragma unroll
            for (int m = 0; m < 4; ++m) { const size_t off = (size_t)(rt + ai * HALF + wr * 64 + m * 16 + fr) * EP_D + col0;
#pragma unroll
                for (int bj = 0; bj < 2; ++bj)
#pragma unroll
                    for (int n = 0; n < 2; ++n) { const f32x4 bs = *(const f32x4*)(ip + off + bj * HALF + n * 16);
                        *(f32x4*)(op + off + bj * HALF + n * 16) = bs + gv[bj][n] * ((acc[ai][bj][m][n] + bv[bj][n]) * sv[bj][n]); } }
    }
};

template <class Epi, class Sched, bool ALIGN_EPI = false, bool SP2 = false>
__device__ __forceinline__ void gemm_phase(PG8_LAS unsigned char* lds, const Gemm g, const Sched& S, const Epi& E) {
    int tid_ = threadIdx.x; asm volatile("" : "+v"(tid_));
    const int tid = tid_, wid = __builtin_amdgcn_readfirstlane(tid >> 6), lane = tid & 63, wr = wid >> 2, wc = wid & 3, fr = lane & 15, fq = lane >> 4;
    const int K = g.K, nt = K / BK;
    unsigned voffA[2], voffB[2];
#pragma unroll
    for (int i = 0; i < 2; ++i) { int R, C; stage_rc(tid * 16 + i * 8192, R, C); const int Rb = Epi::PERM ? ((R & ~31) + perm32(R & 31)) : R;
        voffA[i] = (unsigned)(R * g.lda + C) * 2u; voffB[i] = (unsigned)(Rb * g.ldb + C) * 2u; }
    const size_t kstep = (size_t)(BK * 2);
    const size_t hstepA = (size_t)HALF * g.lda * 2, hstepB = (size_t)HALF * g.ldb * 2;
    const size_t tstepA = 2 * hstepA, tstepB = 2 * hstepB; const size_t akoff = (size_t)g.akoff * 2;
    const unsigned ldsw = (unsigned)wid * 1024u;
    const int aoff = lds_byte(wr * 64 + fr, fq * 8), boff = lds_byte(wc * 32 + fr, fq * 8);
#define PG8_SA(b, h) (((b) * 2 + (h)) * HTB)
#define PG8_SB(b, h) ((4 + (b) * 2 + (h)) * HTB)
#define PG8_STAGE(bufoff, gbase, voff) do { _Pragma("unroll") for (int _i = 0; _i < 2; ++_i) \
        __builtin_amdgcn_global_load_lds((const unsigned*)((const char*)(gbase) + (voff)[_i]), (PG8_LAS unsigned*)(lds + (bufoff) + ldsw + _i * 8192), 16, 0, 0); } while (0)
#define PG8_LDA(dst, b, h) do { _Pragma("unroll") for (int m = 0; m < 4; ++m) _Pragma("unroll") for (int k = 0; k < 2; ++k) dst[m][k] = *(const PG8_LAS bf16x8*)(lds + PG8_SA(b, h) + aoff + m * 2048 + k * 1024); } while (0)
#define PG8_LDB(dst, b, h) do { _Pragma("unroll") for (int n = 0; n < 2; ++n) _Pragma("unroll") for (int k = 0; k < 2; ++k) dst[n][k] = *(const PG8_LAS bf16x8*)(lds + PG8_SB(b, h) + boff + n * 2048 + k * 1024); } while (0)
#define PG8_MMA(ai, bj, At, Bt) do { __builtin_amdgcn_s_setprio(1); _Pragma("unroll") for (int m = 0; m < 4; ++m) _Pragma("unroll") for (int n = 0; n < 2; ++n) _Pragma("unroll") for (int k = 0; k < 2; ++k) \
        acc[ai][bj][m][n] = __builtin_amdgcn_mfma_f32_16x16x32_bf16(Bt[n][k], At[m][k], acc[ai][bj][m][n], 0, 0, 0); __builtin_amdgcn_s_setprio(0); } while (0)
#define PG8_WAIT_V(n) asm volatile("s_waitcnt vmcnt(" #n ")" ::: "memory")
#define PG8_WAIT_L(n) asm volatile("s_waitcnt lgkmcnt(" #n ")" ::: "memory")
#define PG8_BAR __builtin_amdgcn_s_barrier()
#define PG8_SCHED __builtin_amdgcn_sched_barrier(0)
    Unit cur, nxt; int ui = 0;
    if (!S.next(0, cur)) return;
    f32x4 acc[2][2][4][2];
#pragma unroll
    for (int a = 0; a < 2; ++a)
#pragma unroll
        for (int b = 0; b < 2; ++b)
#pragma unroll
            for (int m = 0; m < 4; ++m)
#pragma unroll
                for (int n = 0; n < 2; ++n) acc[a][b][m][n] = (f32x4){0.f, 0.f, 0.f, 0.f};
    bf16x8 At[4][2], B0[2][2], B1[2][2];
    const char* cA = (const char*)g.A + (size_t)cur.pm * tstepA + (size_t)cur.pn * akoff; const char* cB = (const char*)g.Bt + (size_t)cur.pn * tstepB;
    S.a_ready(cur);
    if constexpr (SP2) {
        PG8_STAGE(PG8_SB(0, 0), cB, voffB); PG8_STAGE(PG8_SB(0, 1), cB + hstepB, voffB); PG8_STAGE(PG8_SA(0, 0), cA, voffA); PG8_STAGE(PG8_SA(0, 1), cA + hstepA, voffA);
        if (wr == 1) PG8_BAR;
        PG8_WAIT_V(2); PG8_BAR;
        PG8_STAGE(PG8_SB(1, 0), cB + kstep, voffB); PG8_STAGE(PG8_SA(1, 0), cA + kstep, voffA); PG8_STAGE(PG8_SB(1, 1), cB + hstepB + kstep, voffB);
        PG8_WAIT_V(6); PG8_BAR;
    } else {
        PG8_STAGE(PG8_SB(0, 0), cB, voffB); PG8_STAGE(PG8_SA(0, 0), cA, voffA); PG8_STAGE(PG8_SB(0, 1), cB + hstepB, voffB); PG8_STAGE(PG8_SA(0, 1), cA + hstepA, voffA);
        if (wr == 1) PG8_BAR;
        PG8_WAIT_V(4); PG8_BAR;
        PG8_STAGE(PG8_SB(1, 0), cB + kstep, voffB); PG8_STAGE(PG8_SA(1, 0), cA + kstep, voffA); PG8_STAGE(PG8_SB(1, 1), cB + hstepB + kstep, voffB);
        PG8_WAIT_V(6); PG8_BAR;
    }
    for (;;) {
        const bool has_next = S.next(ui + 1, nxt);
        const char* nA = has_next ? (const char*)g.A + (size_t)nxt.pm * tstepA + (size_t)nxt.pn * akoff : cA; const char* nB = has_next ? (const char*)g.Bt + (size_t)nxt.pn * tstepB : cB;
        for (int t = 0; t < nt; t += 2) {
            const bool last = (t == nt - 2);
            const char* a1 = cA + (size_t)(t + 1) * kstep;
            const char* a2 = last ? nA : cA + (size_t)(t + 2) * kstep; const char* b2 = last ? nB : cB + (size_t)(t + 2) * kstep;
            const char* a3 = a2 + kstep; const char* b3 = b2 + kstep;
            if (last && has_next) S.a_ready(nxt);
            if constexpr (SP2) {
            PG8_LDB(B0, 0, 0); PG8_LDB(B1, 0, 1); PG8_SCHED; PG8_LDA(At, 0, 0); PG8_STAGE(PG8_SA(1, 1), a1 + hstepA, voffA);
            PG8_WAIT_V(8); PG8_WAIT_L(0); PG8_BAR; PG8_MMA(0, 0, At, B0); PG8_MMA(0, 1, At, B1); PG8_BAR; PG8_SCHED;
            PG8_LDA(At, 0, 1); PG8_STAGE(PG8_SB(0, 0), b2, voffB); PG8_STAGE(PG8_SB(0, 1), b2 + hstepB, voffB); PG8_STAGE(PG8_SA(0, 0), a2, voffA);
            PG8_WAIT_V(8); PG8_WAIT_L(0); PG8_BAR; PG8_MMA(1, 0, At, B0); PG8_MMA(1, 1, At, B1); PG8_BAR; PG8_SCHED;
            PG8_LDB(B0, 1, 0); PG8_LDB(B1, 1, 1); PG8_SCHED; PG8_LDA(At, 1, 0); PG8_STAGE(PG8_SA(0, 1), a2 + hstepA, voffA);
            PG8_WAIT_V(8); PG8_WAIT_L(0); PG8_BAR; PG8_MMA(0, 0, At, B0); PG8_MMA(0, 1, At, B1); PG8_BAR; PG8_SCHED;
            PG8_LDA(At, 1, 1); PG8_STAGE(PG8_SB(1, 0), b3, voffB); PG8_STAGE(PG8_SB(1, 1), b3 + hstepB, voffB); PG8_STAGE(PG8_SA(1, 0), a3, voffA);
            PG8_WAIT_V(8); PG8_WAIT_L(0); PG8_BAR; PG8_MMA(1, 0, At, B0); PG8_MMA(1, 1, At, B1); PG8_BAR; PG8_SCHED;
            } else {
            PG8_LDB(B0, 0, 0); PG8_SCHED; PG8_LDA(At, 0, 0); PG8_STAGE(PG8_SA(1, 1), a1 + hstepA, voffA);
            PG8_WAIT_L(8); PG8_BAR; PG8_WAIT_L(0); PG8_MMA(0, 0, At, B0); PG8_BAR; PG8_SCHED;
            PG8_LDB(B1, 0, 1); PG8_STAGE(PG8_SB(0, 0), b2, voffB);
            PG8_BAR; PG8_WAIT_L(0); PG8_MMA(0, 1, At, B1); PG8_BAR;
            PG8_LDA(At, 0, 1); PG8_STAGE(PG8_SA(0, 0), a2, voffA);
            PG8_BAR; PG8_WAIT_L(0); PG8_MMA(1, 0, At, B0); PG8_BAR; PG8_SCHED;
            PG8_STAGE(PG8_SB(0, 1), b2 + hstepB, voffB);
            PG8_WAIT_V(6); PG8_BAR; PG8_MMA(1, 1, At, B1); PG8_BAR;
            PG8_LDB(B0, 1, 0); PG8_SCHED; PG8_LDA(At, 1, 0); PG8_STAGE(PG8_SA(0, 1), a2 + hstepA, voffA);
            PG8_WAIT_L(8); PG8_BAR; PG8_WAIT_L(0); PG8_MMA(0, 0, At, B0); PG8_BAR; PG8_SCHED;
            PG8_LDB(B1, 1, 1); PG8_STAGE(PG8_SB(1, 0), b3, voffB);
            PG8_BAR; PG8_WAIT_L(0); PG8_MMA(0, 1, At, B1); PG8_BAR;
            PG8_LDA(At, 1, 1); PG8_STAGE(PG8_SA(1, 0), a3, voffA);
            PG8_BAR; PG8_WAIT_L(0); PG8_MMA(1, 0, At, B0); PG8_BAR; PG8_SCHED;
            PG8_STAGE(PG8_SB(1, 1), b3 + hstepB, voffB);
            PG8_WAIT_V(6); PG8_BAR; PG8_MMA(1, 1, At, B1); PG8_BAR;
            }
        }
        if constexpr (ALIGN_EPI) { if (wr == 0) PG8_BAR; }
        if constexpr (!Epi::AFTER_DRAIN) { E(acc, cur, wr, wc, fr, fq); S.done(cur); }
        if (!has_next) break;
#pragma unroll
        for (int a = 0; a < 2; ++a)
#pragma unroll
            for (int b = 0; b < 2; ++b)
#pragma unroll
                for (int m = 0; m < 4; ++m)
#pragma unroll
                    for (int n = 0; n < 2; ++n) acc[a][b][m][n] = (f32x4){0.f, 0.f, 0.f, 0.f};
        cur = nxt; cA = nA; cB = nB; ++ui;
        if constexpr (ALIGN_EPI) { if (wr == 1) PG8_BAR; }
    }
    PG8_WAIT_V(0);
    if constexpr (!ALIGN_EPI) { if (wr == 0) PG8_BAR; }
    PG8_BAR;
    if constexpr (Epi::AFTER_DRAIN) { E.fused(acc, cur, wr, wc, fr, fq, lds, wid, lane); S.done(cur); }
#undef PG8_SA
#undef PG8_SB
#undef PG8_STAGE
#undef PG8_LDA
#undef PG8_LDB
#undef PG8_MMA
#undef PG8_WAIT_V
#undef PG8_WAIT_L
#undef PG8_BAR
#undef PG8_SCHED
}
}

using pg8::bf16_t; using pg8::bf16x8; using pg8::f32x4; using pg8::u32x4;
typedef float f32x16 __attribute__((ext_vector_type(16)));
typedef unsigned u32x2 __attribute__((ext_vector_type(2)));
#define LAS __attribute__((address_space(3)))
constexpr int DM = 1024, NBATCH = 16, SEQ = 2048, LAT = NBATCH * SEQ, CTXL = 256, NCTX = NBATCH * CTXL, MTOT = LAT + NCTX, DFF = 2816, MODLD = 6 * DM, NMODB = 17;
constexpr float EPS = 1e-6f, LOG2E = 1.4426950408889634f;
constexpr int NTHREADS = 512, NWAVES = 8;
constexpr int LDS_BYTES = 139264;

constexpr size_t MiB = 1u << 20;
constexpr size_t WS_MOD = 0;
constexpr size_t WS_W = 2 * MiB;
constexpr size_t SZ_WGU = (size_t)2 * DFF * DM * 2, SZ_WDN = (size_t)DM * DFF * 2;
constexpr size_t WS_WGU = WS_W, WS_WDN = WS_WGU + 4 * SZ_WGU;
constexpr size_t WS_SWA_QKV = WS_WDN + 4 * SZ_WDN, WS_SWA_WO = WS_SWA_QKV + (size_t)1536 * DM * 2;
constexpr size_t WS_NA_QKV = WS_SWA_WO + (size_t)DM * DM * 2, WS_NA_WO = WS_NA_QKV + (size_t)3072 * DM * 2;
constexpr size_t WS_POOL = WS_NA_WO + (size_t)DM * DM * 2;
constexpr size_t WS_MLA_WA = WS_POOL + (size_t)DM * 256 * 2, WS_MLA_WUQ = WS_MLA_WA + (size_t)512 * DM * 2, WS_MLA_WUKV = WS_MLA_WUQ + (size_t)1536 * 256 * 2;
constexpr size_t WS_MLA_WO = WS_MLA_WUKV + (size_t)2048 * 128 * 2, WS_W_END = WS_MLA_WO + (size_t)DM * DM * 2;
constexpr size_t WS_HC = 86 * MiB;
constexpr size_t WS_RA = 102 * MiB;
constexpr size_t WS_RO = WS_RA + 72 * MiB;
constexpr size_t WS_RB = WS_RO + 72 * MiB;
constexpr size_t WS_END = 507 * MiB;
static_assert(WS_W_END <= WS_HC, "weights fit");
static_assert(WS_RB + (size_t)MTOT * 3072 * 2 <= WS_END && WS_RB + (size_t)MTOT * DFF * 2 <= WS_END, "big region");
constexpr size_t WS_PROJ = WS_RO, WS_QR = WS_PROJ + (size_t)MTOT * 512 * 2, WS_KV = WS_QR + (size_t)LAT * 1536 * 2, WS_KR = WS_KV + (size_t)MTOT * 2048 * 2;
static_assert(WS_KR + (size_t)MTOT * 512 * 2 <= WS_END, "mla region");

__device__ __forceinline__ unsigned f2bf(float f) { unsigned u = __builtin_bit_cast(unsigned, f); return (u + 0x7fffu + ((u >> 16) & 1u)) >> 16; }
__device__ __forceinline__ unsigned pk2(float lo, float hi) { return f2bf(lo) | (f2bf(hi) << 16); }
__device__ __forceinline__ float bflo(unsigned w) { return __builtin_bit_cast(float, w << 16); }
__device__ __forceinline__ float bfhi(unsigned w) { return __builtin_bit_cast(float, w & 0xffff0000u); }
__device__ __forceinline__ float wave_sum(float v) {
#pragma unroll
    for (int o = 1; o < 64; o <<= 1) v += __shfl_xor(v, o);
    return v;
}

struct Args { const float* in[31]; float* out; unsigned char* ws; int ph_lo, ph_hi; };
typedef const __attribute__((address_space(4))) Args* KArgs;

__device__ __forceinline__ void transpose_item(const float* W, int K, int N, bf16_t* WT, int drow0, int k0, int n0, LAS float* scr, int lane) {
#pragma unroll 8
    for (int i = 0; i < 32; ++i) { const int kk = 2 * i + (lane >> 5); scr[kk * 33 + (lane & 31)] = W[(size_t)(k0 + kk) * N + n0 + (lane & 31)]; }
    asm volatile("s_waitcnt lgkmcnt(0)" ::: "memory");
    const int c = lane & 7;
#pragma unroll
    for (int j = 0; j < 4; ++j) { const int n = (lane >> 3) + 8 * j; const LAS float* s = scr + (8 * c) * 33 + n;
        u32x4 o; o.x = pk2(s[0 * 33], s[1 * 33]); o.y = pk2(s[2 * 33], s[3 * 33]); o.z = pk2(s[4 * 33], s[5 * 33]); o.w = pk2(s[6 * 33], s[7 * 33]);
        *(u32x4*)(WT + (size_t)(drow0 + n) * K + k0 + 8 * c) = o; }
    asm volatile("s_waitcnt lgkmcnt(0)" ::: "memory");
}
__device__ __forceinline__ void transpose_job(const float* W, int K, int N, bf16_t* WT, int map, int item, LAS float* scr, int lane) {
    const int nblk = N / 32, kb = item / nblk, nb = item % nblk, k0 = 64 * kb, n0 = 32 * nb;
    int drow0 = n0;
    if (map == 1) { const bool up = n0 >= DFF; const int j = up ? n0 - DFF : n0; drow0 = (j >> 7) * 256 + (up ? 128 : 0) + (j & 127); }
    transpose_item(W, K, N, WT, drow0, k0, n0, scr, lane);
}
__device__ __forceinline__ void prologue_phase(const int TID, KArgs a, LAS unsigned char* lds) {
    const int tid = TID, lane = tid & 63, wave = tid >> 6;
    unsigned char* ws = a->ws;
    LAS float* scr = (LAS float*)(lds + wave * 16384);
    const int gw = blockIdx.x * NWAVES + wave, NGW = gridDim.x * NWAVES;
    constexpr int I_GU = (DM / 64) * (2 * DFF / 32), I_DN = (DFF / 64) * (DM / 32), I_SQ = (DM / 64) * (1536 / 32), I_SQ2 = (DM / 64) * (DM / 32), I_NQ = (DM / 64) * (3072 / 32);
    constexpr int I_PL = (256 / 64) * (256 / 32), I_WA = (DM / 64) * (416 / 32), I_UQ = (256 / 64) * (1536 / 32), I_UKV = (128 / 64) * (2048 / 32);
    constexpr int NITEMS = 4 * I_GU + 4 * I_DN + I_SQ + I_SQ2 + I_NQ + I_SQ2 + 4 * I_PL + I_WA + I_UQ + I_UKV + I_SQ2;
    for (int it = gw; it < NITEMS; it += NGW) {
        int r = it;
        if (r < 4 * I_GU) { const int l = r / I_GU; transpose_job(a->in[8] + (size_t)l * DM * 2 * DFF, DM, 2 * DFF, (bf16_t*)(ws + WS_WGU + l * SZ_WGU), 1, r % I_GU, scr, lane); continue; } r -= 4 * I_GU;
        if (r < 4 * I_DN) { const int l = r / I_DN; transpose_job(a->in[9] + (size_t)l * DFF * DM, DFF, DM, (bf16_t*)(ws + WS_WDN + l * SZ_WDN), 0, r % I_DN, scr, lane); continue; } r -= 4 * I_DN;
        if (r < I_SQ) { transpose_job(a->in[10], DM, 1536, (bf16_t*)(ws + WS_SWA_QKV), 0, r, scr, lane); continue; } r -= I_SQ;
        if (r < I_SQ2) { transpose_job(a->in[14], DM, DM, (bf16_t*)(ws + WS_SWA_WO), 0, r, scr, lane); continue; } r -= I_SQ2;
        if (r < I_NQ) { transpose_job(a->in[15], DM, 3072, (bf16_t*)(ws + WS_NA_QKV), 0, r, scr, lane); continue; } r -= I_NQ;
        if (r < I_SQ2) { transpose_job(a->in[19], DM, DM, (bf16_t*)(ws + WS_NA_WO), 0, r, scr, lane); continue; } r -= I_SQ2;
        if (r < 4 * I_PL) { const int g = r / I_PL; transpose_job(a->in[20] + (size_t)g * 65536, 256, 256, (bf16_t*)(ws + WS_POOL) + (size_t)g * 65536, 0, r % I_PL, scr, lane); continue; } r -= 4 * I_PL;
        if (r < I_WA) { transpose_job(a->in[23], DM, 416, (bf16_t*)(ws + WS_MLA_WA), 0, r, scr, lane); continue; } r -= I_WA;
        if (r < I_UQ) { transpose_job(a->in[26], 256, 1536, (bf16_t*)(ws + WS_MLA_WUQ), 0, r, scr, lane); continue; } r -= I_UQ;
        if (r < I_UKV) { transpose_job(a->in[27], 128, 2048, (bf16_t*)(ws + WS_MLA_WUKV), 0, r, scr, lane); continue; } r -= I_UKV;
        transpose_job(a->in[30], DM, DM, (bf16_t*)(ws + WS_MLA_WO), 0, r, scr, lane);
    }
    { u32x4* z = (u32x4*)(ws + WS_MLA_WA + (size_t)416 * DM * 2); const int nz = 96 * DM * 2 / 16;
      for (int i = blockIdx.x * NTHREADS + tid; i < nz; i += gridDim.x * NTHREADS) z[i] = (u32x4){0u, 0u, 0u, 0u}; }
    __syncthreads();
    if ((int)blockIdx.x < 384) {
        LAS float* cond = (LAS float*)lds;
        LAS float* red = (LAS float*)(lds + 81920);
        for (int i = tid; i < NMODB * DM; i += NTHREADS) { const int b = i / DM, k = i % DM; const float v = b < 16 ? a->in[1][b * DM + k] : a->in[3][k];
            cond[k * 20 + b] = v / (1.0f + __expf(-v)); }
        __syncthreads();
        const int col = tid & 63, kg = tid >> 6;
        for (int u = blockIdx.x; u < 384; u += gridDim.x) {
            const int l = u / 96, cb = u % 96;
            const float* w = a->in[4] + (size_t)l * DM * MODLD + cb * 64 + col;
            float acc[NMODB];
#pragma unroll
            for (int b = 0; b < NMODB; ++b) acc[b] = 0.f;
#pragma unroll 4
            for (int k = kg * 128; k < kg * 128 + 128; ++k) { const float wv = w[(size_t)k * MODLD]; const LAS float* cp = cond + k * 20;
#pragma unroll
                for (int b = 0; b < NMODB; ++b) acc[b] += cp[b] * wv; }
#pragma unroll
            for (int b = 0; b < NMODB; ++b) red[(kg * NMODB + b) * 64 + col] = acc[b];
            __syncthreads();
            for (int i = tid; i < NMODB * 64; i += NTHREADS) { const int b = i >> 6, c = i & 63; float s = 0.f;
#pragma unroll
                for (int g = 0; g < 8; ++g) s += red[(g * NMODB + b) * 64 + c];
                ((float*)(ws + WS_MOD))[((size_t)l * NMODB + b) * MODLD + cb * 64 + c] = s + a->in[5][l * MODLD + cb * 64 + c]; }
            __syncthreads();
        }
    }
}

__device__ __forceinline__ void norm_phase(const int TID, const float* in_lat, const float* in_ctx, int M, const float* g, const float* sh, const float* sc, bf16_t* A) {
    const int lane = TID & 63, wave = TID >> 6;
    const int gw = blockIdx.x * NWAVES + wave, NGW = gridDim.x * NWAVES;
    f32x4 gv[4];
#pragma unroll
    for (int j = 0; j < 4; ++j) gv[j] = *(const f32x4*)(g + 4 * lane + 256 * j);
    for (int row = gw; row < M; row += NGW) {
        const float* xr = row < LAT ? in_lat + (size_t)row * DM : in_ctx + (size_t)(row - LAT) * DM;
        const int b = row < LAT ? row / SEQ : 16;
        f32x4 v[4]; float s = 0.f;
#pragma unroll
        for (int j = 0; j < 4; ++j) { v[j] = *(const f32x4*)(xr + 4 * lane + 256 * j); s += (v[j].x * v[j].x + v[j].y * v[j].y) + (v[j].z * v[j].z + v[j].w * v[j].w); }
        const float rstd = 1.0f / sqrtf(wave_sum(s) * (1.0f / DM) + EPS);
        const float* shp = sh + (size_t)b * MODLD + 4 * lane; const float* scp = sc + (size_t)b * MODLD + 4 * lane;
        bf16_t* op = A + (size_t)row * DM + 4 * lane;
#pragma unroll
        for (int j = 0; j < 4; ++j) { const f32x4 s4 = *(const f32x4*)(scp + 256 * j), h4 = *(const f32x4*)(shp + 256 * j);
            const f32x4 y = (v[j] * rstd * gv[j]) * (s4 + 1.0f) + h4;
            u32x2 w; w.x = pk2(y.x, y.y); w.y = pk2(y.z, y.w); *(u32x2*)(op + 256 * j) = w; }
    }
}

template <int HALFD> __device__ __forceinline__ void rope_table(const int TID, LAS float* tab) {
    for (int i = TID; i < 64 * HALFD; i += NTHREADS) { const int pos = i / HALFD, f = i % HALFD;
        const float fr = powf(10000.0f, -(float)f / (float)HALFD); float sn, cs; sincosf((float)pos * fr, &sn, &cs); tab[2 * i] = cs; tab[2 * i + 1] = sn; }
    __syncthreads();
}

__device__ __forceinline__ void qknorm_phase(const int TID, bf16_t* QKV, int ld, int nq, int nk, const float* gq, const float* gk, bool rope, float qscale, LAS unsigned char* lds) {
    LAS float* tab = (LAS float*)lds;
    if (rope) rope_table<16>(TID, tab);
    const int lane = TID & 63, wave = TID >> 6, l16 = lane & 15;
    const int gw = blockIdx.x * NWAVES + wave, NGW = gridDim.x * NWAVES;
    const f32x4 gq4 = *(const f32x4*)(gq + 4 * l16), gk4 = *(const f32x4*)(gk + 4 * l16);
    const int npass = (nq + nk) / 4;
    for (int row = gw; row < MTOT; row += NGW) {
        const bool dorope = rope && row < LAT; const int t = row & (SEQ - 1);
        const int pos = (l16 & 8) ? (t & 63) : (t >> 6); const int fi = 4 * (l16 & 3); const bool x2 = (l16 & 4) != 0;
        f32x4 cs = {1.f, 1.f, 1.f, 1.f}, sn = {0.f, 0.f, 0.f, 0.f};
        if (dorope) {
#pragma unroll
            for (int j = 0; j < 4; ++j) { cs[j] = tab[2 * (pos * 16 + fi + j)]; sn[j] = tab[2 * (pos * 16 + fi + j) + 1]; } }
        for (int p = 0; p < npass; ++p) {
            const int hh = 4 * p + (lane >> 4); const bool isq = hh < nq;
            bf16_t* ptr = QKV + (size_t)row * ld + hh * 64 + 4 * l16;
            const u32x2 w = *(const u32x2*)ptr;
            f32x4 x = {bflo(w.x), bfhi(w.x), bflo(w.y), bfhi(w.y)};
            float s = (x.x * x.x + x.y * x.y) + (x.z * x.z + x.w * x.w);
            s += __shfl_xor(s, 1); s += __shfl_xor(s, 2); s += __shfl_xor(s, 4); s += __shfl_xor(s, 8);
            const float rstd = 1.0f / sqrtf(s * (1.0f / 64.0f) + EPS);
            x = x * rstd * (isq ? gq4 : gk4);
            f32x4 o;
#pragma unroll
            for (int j = 0; j < 4; ++j) { const float other = __shfl_xor(x[j], 4); o[j] = x2 ? (other * sn[j] + x[j] * cs[j]) : (x[j] * cs[j] - other * sn[j]); }
            if (isq) o = o * qscale;
            u32x2 wo; wo.x = pk2(o.x, o.y); wo.y = pk2(o.z, o.w); *(u32x2*)ptr = wo;
        }
    }
}

__device__ __forceinline__ void mlanorm1_phase(const int TID, bf16_t* PROJ, const float* gcq, const float* gckv) {
    const int lane = TID & 63, wave = TID >> 6;
    const int gw = blockIdx.x * NWAVES + wave, NGW = gridDim.x * NWAVES;
    const f32x4 g1 = *(const f32x4*)(gcq + 4 * lane);
    const float g2a = gckv[2 * lane], g2b = gckv[2 * lane + 1];
    for (int row = gw; row < MTOT; row += NGW) {
        bf16_t* p = PROJ + (size_t)row * 512;
        const u32x2 w = *(const u32x2*)(p + 4 * lane); const unsigned w2 = *(const unsigned*)(p + 256 + 2 * lane);
        f32x4 x = {bflo(w.x), bfhi(w.x), bflo(w.y), bfhi(w.y)}; float ya = bflo(w2), yb = bfhi(w2);
        const float s1 = wave_sum((x.x * x.x + x.y * x.y) + (x.z * x.z + x.w * x.w)), s2 = wave_sum(ya * ya + yb * yb);
        const float r1 = 1.0f / sqrtf(s1 * (1.0f / 256.0f) + EPS), r2 = 1.0f / sqrtf(s2 * (1.0f / 128.0f) + EPS);
        x = x * r1 * g1; ya *= r2 * g2a; yb *= r2 * g2b;
        u32x2 wo; wo.x = pk2(x.x, x.y); wo.y = pk2(x.z, x.w); *(u32x2*)(p + 4 * lane) = wo; *(unsigned*)(p + 256 + 2 * lane) = pk2(ya, yb);
    }
}
__device__ __forceinline__ void mlanorm2_phase(const int TID, bf16_t* QR, bf16_t* KV, const bf16_t* PROJ, bf16_t* KR, const float* gq, const float* gk, float qscale, LAS unsigned char* lds) {
    LAS float* tab = (LAS float*)lds;
    rope_table<8>(TID, tab);
    const int lane = TID & 63, wave = TID >> 6, l32 = lane & 31, hs = lane >> 5;
    const int gw = blockIdx.x * NWAVES + wave, NGW = gridDim.x * NWAVES;
    const float gq0 = gq[l32], gq1 = gq[l32 + 32], gq2 = gq[l32 + 64], gk0 = gk[l32], gk1 = gk[l32 + 32], gk2 = gk[l32 + 64];
    const int fi = l32 & 7; const bool x2 = (l32 & 8) != 0, colpos = (l32 & 16) != 0;
    for (int row = gw; row < MTOT; row += NGW) {
        const bool islat = row < LAT; const int t = row & (SEQ - 1); const int pos = colpos ? (t & 63) : (t >> 6);
        float cs = 1.f, sn = 0.f; if (islat) { cs = tab[2 * (pos * 8 + fi)]; sn = tab[2 * (pos * 8 + fi) + 1]; }
        if (islat) {
            for (int p = 0; p < 8; ++p) { bf16_t* q = QR + (size_t)row * 1536 + (2 * p + hs) * 96;
                float a = bflo((unsigned)q[l32]), b = bflo((unsigned)q[l32 + 32]), c = bflo((unsigned)q[l32 + 64]);
                float s = a * a + b * b + c * c; s += __shfl_xor(s, 1); s += __shfl_xor(s, 2); s += __shfl_xor(s, 4); s += __shfl_xor(s, 8); s += __shfl_xor(s, 16);
                const float rstd = 1.0f / sqrtf(s * (1.0f / 96.0f) + EPS);
                a *= rstd * gq0; b *= rstd * gq1; c *= rstd * gq2;
                const float other = __shfl_xor(c, 8); c = x2 ? (other * sn + c * cs) : (c * cs - other * sn);
                q[l32] = (bf16_t)f2bf(a * qscale); q[l32 + 32] = (bf16_t)f2bf(b * qscale); q[l32 + 64] = (bf16_t)f2bf(c * qscale); }
        }
        const float kr = bflo((unsigned)PROJ[(size_t)row * 512 + 384 + l32]);
        for (int p = 0; p < 8; ++p) { const int hh = 2 * p + hs; bf16_t* k = KV + (size_t)row * 2048 + hh * 128;
            float a = bflo((unsigned)k[l32]), b = bflo((unsigned)k[l32 + 32]), c = kr;
            float s = a * a + b * b + c * c; s += __shfl_xor(s, 1); s += __shfl_xor(s, 2); s += __shfl_xor(s, 4); s += __shfl_xor(s, 8); s += __shfl_xor(s, 16);
            const float rstd = 1.0f / sqrtf(s * (1.0f / 96.0f) + EPS);
            a *= rstd * gk0; b *= rstd * gk1; c *= rstd * gk2;
            const float other = __shfl_xor(c, 8); c = x2 ? (other * sn + c * cs) : (c * cs - other * sn);
            k[l32] = (bf16_t)f2bf(a); k[l32 + 32] = (bf16_t)f2bf(b); KR[(size_t)row * 512 + hh * 32 + l32] = (bf16_t)f2bf(c); }
    }
}

__device__ __forceinline__ void pool_phase(const int TID, const bf16_t* A, bf16_t* P) {
    const int lane = TID & 63, wave = TID >> 6;
    const int gw = blockIdx.x * NWAVES + wave, NGW = gridDim.x * NWAVES;
    for (int row = gw; row < MTOT; row += NGW) {
        int base, L, t; if (row < LAT) { base = row & ~(SEQ - 1); L = SEQ; t = row - base; } else { const int r = row - LAT; base = LAT + (r & ~(CTXL - 1)); L = CTXL; t = r & (CTXL - 1); }
#pragma unroll
        for (int j = 0; j < 4; ++j) {
            const int w = 2 << j; int lo = t - w / 2, hi = t - w / 2 + w; lo = lo < 0 ? 0 : lo; hi = hi > L ? L : hi;
            f32x4 s = {0.f, 0.f, 0.f, 0.f};
            for (int k = lo; k < hi; ++k) { const u32x2 v = *(const u32x2*)(A + (size_t)(base + k) * DM + 256 * j + 4 * lane); s += (f32x4){bflo(v.x), bfhi(v.x), bflo(v.y), bfhi(v.y)}; }
            const u32x2 v = *(const u32x2*)(A + (size_t)row * DM + 256 * j + 4 * lane); const f32x4 self = {bflo(v.x), bfhi(v.x), bflo(v.y), bfhi(v.y)};
            const f32x4 o = s * (1.0f / (float)(hi - lo)) - self;
            u32x2 wo; wo.x = pk2(o.x, o.y); wo.y = pk2(o.z, o.w); *(u32x2*)(P + (size_t)row * DM + 256 * j + 4 * lane) = wo;
        }
    }
}

struct KVSrc { const bf16_t* k; const bf16_t* k2; const bf16_t* v; int ldk, ldk2, ldv; };
template <int DQK> __device__ __forceinline__ void nv_key(const KVSrc& S, int krow, float bias, const float (&q)[DQK], float& m, float& l, float (&o)[64]) {
    const bf16_t* kp = S.k + (size_t)krow * S.ldk; float s = 0.f;
#pragma unroll
    for (int c = 0; c < 8; ++c) { const u32x4 w = *(const u32x4*)(kp + 8 * c);
        s += q[8 * c] * bflo(w.x) + q[8 * c + 1] * bfhi(w.x) + q[8 * c + 2] * bflo(w.y) + q[8 * c + 3] * bfhi(w.y) + q[8 * c + 4] * bflo(w.z) + q[8 * c + 5] * bfhi(w.z) + q[8 * c + 6] * bflo(w.w) + q[8 * c + 7] * bfhi(w.w); }
    if constexpr (DQK == 96) { const bf16_t* k2 = S.k2 + (size_t)krow * S.ldk2;
#pragma unroll
        for (int c = 0; c < 4; ++c) { const u32x4 w = *(const u32x4*)(k2 + 8 * c); const int d = 64 + 8 * c;
            s += q[d] * bflo(w.x) + q[d + 1] * bfhi(w.x) + q[d + 2] * bflo(w.y) + q[d + 3] * bfhi(w.y) + q[d + 4] * bflo(w.z) + q[d + 5] * bfhi(w.z) + q[d + 6] * bflo(w.w) + q[d + 7] * bfhi(w.w); } }
    s += bias;
    const float mn = fmaxf(m, s), alpha = __builtin_amdgcn_exp2f(m - mn), p = __builtin_amdgcn_exp2f(s - mn);
    l = l * alpha + p; m = mn;
    const bf16_t* vp = S.v + (size_t)krow * S.ldv;
#pragma unroll
    for (int c = 0; c < 8; ++c) { const u32x4 w = *(const u32x4*)(vp + 8 * c);
        o[8 * c] = o[8 * c] * alpha + p * bflo(w.x); o[8 * c + 1] = o[8 * c + 1] * alpha + p * bfhi(w.x); o[8 * c + 2] = o[8 * c + 2] * alpha + p * bflo(w.y); o[8 * c + 3] = o[8 * c + 3] * alpha + p * bfhi(w.y);
        o[8 * c + 4] = o[8 * c + 4] * alpha + p * bflo(w.z); o[8 * c + 5] = o[8 * c + 5] * alpha + p * bfhi(w.z); o[8 * c + 6] = o[8 * c + 6] * alpha + p * bflo(w.w); o[8 * c + 7] = o[8 * c + 7] * alpha + p * bfhi(w.w); }
}
template <int MODE> __device__ __forceinline__ void naive_attn_phase(const int TID, KArgs a) {
    constexpr int DQK = MODE == 2 ? 96 : 64;
    unsigned char* ws = a->ws;
    const int NQ = MODE == 2 ? LAT : MTOT; const long total = (long)NQ * 16;
    for (long gi = (long)blockIdx.x * NTHREADS + TID; gi < total; gi += (long)gridDim.x * NTHREADS) {
        const int h = (int)(gi / NQ), row = (int)(gi % NQ);
        const bool islat = row < LAT; const int b = islat ? row / SEQ : (row - LAT) / CTXL; const int t = row & (SEQ - 1);
        const bf16_t* qp; KVSrc S; bf16_t* op;
        if (MODE == 0) { const bf16_t* QKV = (const bf16_t*)(ws + WS_RB); qp = QKV + (size_t)row * 1536 + h * 64; S.k = QKV + 1024 + (h >> 2) * 64; S.v = QKV + 1280 + (h >> 2) * 64; S.k2 = nullptr; S.ldk = S.ldv = 1536; S.ldk2 = 0;
            op = (bf16_t*)(ws + WS_RO) + (size_t)row * DM + h * 64; }
        else if (MODE == 1) { const bf16_t* QKV = (const bf16_t*)(ws + WS_RB); qp = QKV + (size_t)row * 3072 + h * 64; S.k = QKV + 1024 + h * 64; S.v = QKV + 2048 + h * 64; S.k2 = nullptr; S.ldk = S.ldv = 3072; S.ldk2 = 0;
            op = (bf16_t*)(ws + WS_RO) + (size_t)row * DM + h * 64; }
        else { qp = (const bf16_t*)(ws + WS_QR) + (size_t)row * 1536 + h * 96; const bf16_t* KV = (const bf16_t*)(ws + WS_KV); S.k = KV + h * 128; S.v = KV + h * 128 + 64; S.k2 = (const bf16_t*)(ws + WS_KR) + h * 32; S.ldk = S.ldv = 2048; S.ldk2 = 512;
            op = (bf16_t*)(ws + WS_RA) + (size_t)row * DM + h * 64; }
        float q[DQK];
#pragma unroll
        for (int c = 0; c < DQK / 8; ++c) { const u32x4 w = *(const u32x4*)(qp + 8 * c); q[8 * c] = bflo(w.x); q[8 * c + 1] = bfhi(w.x); q[8 * c + 2] = bflo(w.y); q[8 * c + 3] = bfhi(w.y); q[8 * c + 4] = bflo(w.z); q[8 * c + 5] = bfhi(w.z); q[8 * c + 6] = bflo(w.w); q[8 * c + 7] = bfhi(w.w); }
        float o[64];
#pragma unroll
        for (int d = 0; d < 64; ++d) o[d] = 0.f;
        float m = -1e30f, l = 0.f;
        for (int j = 0; j < CTXL; ++j) nv_key<DQK>(S, LAT + b * CTXL + j, 0.f, q, m, l, o);
        if (islat) {
            if (MODE == 0) { const int j0 = t - 128 < 0 ? 0 : t - 128, j1 = t + 128 > SEQ - 1 ? SEQ - 1 : t + 128;
                for (int j = j0; j <= j1; ++j) nv_key<DQK>(S, b * SEQ + j, 0.f, q, m, l, o); }
            else if (MODE == 1) { const int r = t >> 6, c = t & 63; int r0 = r - 4; r0 = r0 < 0 ? 0 : (r0 > 24 ? 24 : r0); int cs = c - 8; cs = cs < 0 ? 0 : (cs > 48 ? 48 : cs);
                const float* rpb = a->in[18] + (size_t)h * 15 * 31;
                for (int kr = r0; kr < r0 + 8; ++kr) for (int kc = cs; kc < cs + 16; ++kc) nv_key<DQK>(S, b * SEQ + kr * 64 + kc, rpb[(kr - r + 7) * 31 + (kc - c + 15)] * LOG2E, q, m, l, o); }
            else { for (int j = 0; j < SEQ; ++j) nv_key<DQK>(S, b * SEQ + j, 0.f, q, m, l, o); }
        }
        if (MODE == 0) l += __builtin_amdgcn_exp2f(a->in[13][h] * LOG2E - m);
        const float inv = 1.0f / l;
#pragma unroll
        for (int c = 0; c < 8; ++c) { u32x4 w; w.x = pk2(o[8 * c] * inv, o[8 * c + 1] * inv); w.y = pk2(o[8 * c + 2] * inv, o[8 * c + 3] * inv); w.z = pk2(o[8 * c + 4] * inv, o[8 * c + 5] * inv); w.w = pk2(o[8 * c + 6] * inv, o[8 * c + 7] * inv);
            *(u32x4*)(op + 8 * c) = w; }
    }
}

enum Kind { K_PRO = 0, K_N1, K_G1, K_QKN, K_ATT, K_G2, K_N2, K_G3, K_G4, K_POOL, K_GPOOL, K_GPROJ, K_MLAN1, K_GUP, K_MLAN2 };
constexpr int NPHASES = 33;
__device__ __forceinline__ void decode_phase(int p, int& L, int& kind) {
    if (p == 0) { L = 0; kind = K_PRO; return; }
    if (p <= 16) { L = (p - 1) >> 3; kind = K_N1 + ((p - 1) & 7); return; }
    if (p <= 22) { L = 2; const int k = p - 17; kind = k == 0 ? K_N1 : k == 1 ? K_POOL : k == 2 ? K_GPOOL : k == 3 ? K_N2 : k == 4 ? K_G3 : K_G4; return; }
    L = 3; const int k = p - 23;
    kind = k == 0 ? K_N1 : k == 1 ? K_GPROJ : k == 2 ? K_MLAN1 : k == 3 ? K_GUP : k == 4 ? K_MLAN2 : k == 5 ? K_ATT : k == 6 ? K_G2 : k == 7 ? K_N2 : k == 8 ? K_G3 : K_G4;
}

__global__ void __launch_bounds__(NTHREADS) fwd_kernel(Args a_by_value) {
    extern __shared__ __attribute__((aligned(16))) unsigned char lds_raw[];
    LAS unsigned char* lds = (LAS unsigned char*)lds_raw;
    cg::grid_group grid = cg::this_grid();
    const int ph_lo = a_by_value.ph_lo, ph_hi = a_by_value.ph_hi;
    for (int p = ph_lo; p < ph_hi; ++p) {
        int L, kind; decode_phase(p, L, kind);
        KArgs a = (KArgs)__builtin_amdgcn_kernarg_segment_ptr(); asm volatile("" : "+s"(a));
        unsigned char* ws = a->ws;
        const float* MOD = (const float*)(ws + WS_MOD);
        float* HC = (float*)(ws + WS_HC);
        bf16_t* RA = (bf16_t*)(ws + WS_RA); bf16_t* RO = (bf16_t*)(ws + WS_RO); bf16_t* RB = (bf16_t*)(ws + WS_RB);
        int TID = threadIdx.x; asm volatile("" : "+v"(TID));
        const float* modL = MOD + (size_t)L * NMODB * MODLD;
        const int Mffn = L == 3 ? LAT : MTOT;
        if (kind == K_PRO) {
            prologue_phase(TID, a, lds);
        } else if (kind == K_N1 || kind == K_N2) {
            const bool first = kind == K_N1;
            const float* il = (L == 0 && first) ? a->in[0] : a->out; const float* ic = (L == 0 && first) ? a->in[2] : HC;
            norm_phase(TID, il, ic, first ? MTOT : Mffn, (first ? a->in[6] : a->in[7]) + L * DM, modL + (first ? 0 : 3 * DM), modL + (first ? DM : 4 * DM), RA);
        } else if (kind == K_G1 || kind == K_GPROJ || kind == K_GUP) {
            const int nrep = kind == K_GUP ? 2 : 1;
            for (int rep = 0; rep < nrep; ++rep) {
                pg8::Gemm g; pg8::EpiStore E;
                if (kind == K_G1) { const int N = L == 0 ? 1536 : 3072; g = pg8::Gemm{RA, (const bf16_t*)(ws + (L == 0 ? WS_SWA_QKV : WS_NA_QKV)), MTOT, N, DM, DM, DM, 0}; E = pg8::EpiStore{RB, N}; }
                else if (kind == K_GPROJ) { g = pg8::Gemm{RA, (const bf16_t*)(ws + WS_MLA_WA), MTOT, 512, DM, DM, DM, 0}; E = pg8::EpiStore{(bf16_t*)(ws + WS_PROJ), 512}; }
                else if (rep == 0) { g = pg8::Gemm{(const bf16_t*)(ws + WS_PROJ), (const bf16_t*)(ws + WS_MLA_WUQ), LAT, 1536, 256, 512, 256, 0}; E = pg8::EpiStore{(bf16_t*)(ws + WS_QR), 1536}; }
                else { g = pg8::Gemm{(const bf16_t*)(ws + WS_PROJ) + 256, (const bf16_t*)(ws + WS_MLA_WUKV), MTOT, 2048, 128, 512, 128, 0}; E = pg8::EpiStore{(bf16_t*)(ws + WS_KV), 2048}; }
                pg8::StaticOrder S; S.init(g.M, g.N, (int)gridDim.x, (int)blockIdx.x);
                pg8::gemm_phase<pg8::EpiStore, pg8::StaticOrder, true, true>(lds, g, S, E);
            }
        } else if (kind == K_G3) {
            pg8::Gemm g{RA, (const bf16_t*)(ws + WS_WGU + (size_t)L * SZ_WGU), Mffn, 2 * DFF, DM, DM, DM, 0};
            pg8::EpiSwiglu E{RB, DFF};
            pg8::StaticOrder S; S.init(g.M, g.N, (int)gridDim.x, (int)blockIdx.x);
            pg8::gemm_phase<pg8::EpiSwiglu, pg8::StaticOrder, true, true>(lds, g, S, E);
        } else if (kind == K_G2 || kind == K_GPOOL || kind == K_G4) {
            pg8::Gemm g; pg8::EpiResid E;
            E.first = (L == 0 && kind == K_G2) ? 1 : 0; E.pool = kind == K_GPOOL ? 1 : 0; E.mod_byte = (unsigned)WS_MOD; E.hc_byte = (unsigned)WS_HC;
            E.gate_off = L * NMODB * MODLD + (kind == K_G4 ? 5 * DM : 2 * DM);
            if (kind == K_G2) { const size_t wo = L == 0 ? WS_SWA_WO : L == 1 ? WS_NA_WO : WS_MLA_WO; g = pg8::Gemm{L == 3 ? RA : RO, (const bf16_t*)(ws + wo), Mffn, DM, DM, DM, DM, 0}; }
            else if (kind == K_GPOOL) { g = pg8::Gemm{RO, (const bf16_t*)(ws + WS_POOL), MTOT, DM, 256, DM, 256, 256}; }
            else { g = pg8::Gemm{RB, (const bf16_t*)(ws + WS_WDN + (size_t)L * SZ_WDN), Mffn, DM, DFF, DFF, DFF, 0}; }
            pg8::StaticOrder S; S.init(g.M, g.N, (int)gridDim.x, (int)blockIdx.x);
            pg8::gemm_phase<pg8::EpiResid, pg8::StaticOrder, true, true>(lds, g, S, E);
        } else if (kind == K_QKN) {
            if (L == 0) qknorm_phase(TID, RB, 1536, 16, 4, a->in[11], a->in[12], true, 0.125f * LOG2E, lds);
            else qknorm_phase(TID, RB, 3072, 16, 16, a->in[16], a->in[17], false, 0.125f * LOG2E, lds);
        } else if (kind == K_ATT) {
            if (L == 0) naive_attn_phase<0>(TID, a); else if (L == 1) naive_attn_phase<1>(TID, a); else naive_attn_phase<2>(TID, a);
        } else if (kind == K_POOL) {
            pool_phase(TID, RA, RO);
        } else if (kind == K_MLAN1) {
            mlanorm1_phase(TID, (bf16_t*)(ws + WS_PROJ), a->in[24], a->in[25]);
        } else if (kind == K_MLAN2) {
            mlanorm2_phase(TID, (bf16_t*)(ws + WS_QR), (bf16_t*)(ws + WS_KV), (const bf16_t*)(ws + WS_PROJ), (bf16_t*)(ws + WS_KR), a->in[28], a->in[29], 0.10206207261596577f * LOG2E, lds);
        }
        if (p + 1 < ph_hi) grid.sync();
    }
}

#ifndef MK_PER_PHASE
#define MK_PER_PHASE 1
#endif
extern "C" void kernel_launch(void* const* d_in, const int* in_sizes, int n_in, void* d_out, int out_size, void* d_ws, size_t ws_size, hipStream_t stream) {
    static int grid = 0;
    if (grid == 0) {
        if (n_in != 31 || in_sizes[0] != LAT * DM || out_size != LAT * DM || ws_size < WS_END) { fprintf(stderr, "kernel_launch: unexpected shapes (n_in %d, in0 %d, out %d, ws %zu < %zu)\n", n_in, n_in > 0 ? in_sizes[0] : -1, out_size, ws_size, (size_t)WS_END); grid = -1; return; }
        int dev = 0, cus = 0, per_cu = 0;
        if (hipGetDevice(&dev) != hipSuccess || hipDeviceGetAttribute(&cus, hipDeviceAttributeMultiprocessorCount, dev) != hipSuccess) { fprintf(stderr, "kernel_launch: device query failed\n"); grid = -1; return; }
        if (hipFuncSetAttribute((const void*)fwd_kernel, hipFuncAttributeMaxDynamicSharedMemorySize, LDS_BYTES) != hipSuccess) { fprintf(stderr, "kernel_launch: hipFuncSetAttribute failed\n"); grid = -1; return; }
        if (hipOccupancyMaxActiveBlocksPerMultiprocessor(&per_cu, (const void*)fwd_kernel, NTHREADS, LDS_BYTES) != hipSuccess || per_cu < 1) { fprintf(stderr, "kernel_launch: occupancy query says %d blocks per CU\n", per_cu); per_cu = 1; }
        (void)hipGetLastError();
        grid = cus * (per_cu > 1 ? 1 : per_cu);
    }
    if (grid < 0) return;
    Args a{};
    for (int i = 0; i < 31; ++i) a.in[i] = (const float*)d_in[i];
    a.out = (float*)d_out; a.ws = (unsigned char*)d_ws;
#if MK_PER_PHASE
    for (int p = 0; p < NPHASES; ++p) { a.ph_lo = p; a.ph_hi = p + 1; hipLaunchKernelGGL(fwd_kernel, dim3(grid), dim3(NTHREADS), LDS_BYTES, stream, a); }
#else
    a.ph_lo = 0; a.ph_hi = NPHASES;
    void* args[] = {&a};
    hipError_t e = hipLaunchCooperativeKernel((const void*)fwd_kernel, dim3(grid), dim3(NTHREADS), args, LDS_BYTES, stream);
    if (e != hipSuccess) fprintf(stderr, "kernel_launch: cooperative launch failed: %s (grid %d)\n", hipGetErrorString(e), grid);
#endif
}
```

```cpp
#include <hip/hip_runtime.h>
#include <hip/hip_cooperative_groups.h>
#include <cstdio>
#include <cstdint>
#include <cmath>
namespace cg = cooperative_groups;

namespace pg8 {
#define PG8_LAS __attribute__((address_space(3)))
typedef unsigned short bf16_t;
typedef short bf16x8 __attribute__((ext_vector_type(8)));
typedef float f32x4 __attribute__((ext_vector_type(4)));
typedef unsigned u32x4 __attribute__((ext_vector_type(4)));
constexpr int BM = 256, BK = 64, HALF = 128, HTB = HALF * BK * 2  , STAGE_BYTES = 8 * HTB, NXCD = 8, WGM = 8;

__host__ __device__ __forceinline__ int lds_byte(int r, int c) { const int st = (r >> 4) * 2 + (c >> 5), rr = r & 15, cc = c & 31, ob = rr * 64 + cc * 2; return st * 1024 + (ob ^ (((ob >> 9) & 1) << 5)); }
__host__ __device__ __forceinline__ void stage_rc(int b, int& R, int& C) { const int st = b / 1024, sb = b % 1024, swz = sb ^ (((sb >> 9) & 1) << 5); R = (st >> 1) * 16 + swz / 64; C = (st & 1) * 32 + (swz % 64) / 2; }
__host__ __device__ __forceinline__ int perm32(int rho) { const int n = rho >> 4, i = rho & 15; return 8 * (i >> 2) + 4 * n + (i & 3); }

struct Unit { int pm, pn; };
struct Gemm { const bf16_t* A; const bf16_t* Bt; int M, N, K, lda, ldb, akoff; };

struct StaticOrder {
    int nM, nN, nwg, G, c;
    __host__ __device__ void init(int M, int N, int G_, int c_) { nM = M / BM; nN = N / BM; nwg = nM * nN; G = G_; c = c_; }
    __host__ __device__ bool next(int i, Unit& u) const {
        const long L = (long)i * G + c; if (L >= nwg) return false;
        int wgid = (int)L; { const int q = nwg / NXCD, r = nwg % NXCD, xcd = wgid % NXCD, off = wgid / NXCD; wgid = (xcd < r ? xcd * (q + 1) : r * (q + 1) + (xcd - r) * q) + off; }
        const int nig = WGM * nN, gid = wgid / nig, fm = gid * WGM, gsz = (nM - fm) < WGM ? (nM - fm) : WGM;
        u.pm = fm + ((wgid % nig) % gsz); u.pn = (wgid % nig) / gsz; return true;
    }
    __device__ __forceinline__ void a_ready(const Unit&) const {}
    __device__ __forceinline__ void done(const Unit&) const {}
};

__device__ __forceinline__ unsigned cvt_pk_bf16(float lo, float hi) { unsigned r; asm volatile("v_cvt_pk_bf16_f32 %0, %1, %2" : "=v"(r) : "v"(lo), "v"(hi)); return r; }

struct EpiStore {
    static constexpr bool PERM = true, AFTER_DRAIN = false;
    bf16_t* O; int ldc;
    __device__ __forceinline__ void operator()(const f32x4 (&acc)[2][2][4][2], const Unit& u, int wr, int wc, int fr, int fq) const {
        const int row0 = u.pm * BM + wr * 64 + fr, col0 = u.pn * BM + wc * 32 + 8 * fq;
#pragma unroll
        for (int ai = 0; ai < 2; ++ai)
#pragma unroll
            for (int m = 0; m < 4; ++m) { bf16_t* rowp = O + (size_t)(row0 + ai * HALF + m * 16) * ldc + col0;
#pragma unroll
                for (int bj = 0; bj < 2; ++bj) { const f32x4 v0 = acc[ai][bj][m][0], v1 = acc[ai][bj][m][1];
                    u32x4 w; w.x = cvt_pk_bf16(v0[0], v0[1]); w.y = cvt_pk_bf16(v0[2], v0[3]); w.z = cvt_pk_bf16(v1[0], v1[1]); w.w = cvt_pk_bf16(v1[2], v1[3]);
                    *(u32x4*)(rowp + bj * HALF) = w; } }
    }
};
__device__ __forceinline__ float silu_mul(float g, float u) { return g * u * __builtin_amdgcn_rcpf(1.0f + __builtin_amdgcn_exp2f(-1.4426950408889634f * g)); }
struct EpiSwiglu {
    static constexpr bool PERM = true, AFTER_DRAIN = false;
    bf16_t* O; int ldc;
    __device__ __forceinline__ void operator()(const f32x4 (&acc)[2][2][4][2], const Unit& u, int wr, int wc, int fr, int fq) const {
        const int row0 = u.pm * BM + wr * 64 + fr, col0 = u.pn * HALF + wc * 32 + 8 * fq;
#pragma unroll
        for (int ai = 0; ai < 2; ++ai)
#pragma unroll
            for (int m = 0; m < 4; ++m) { bf16_t* rowp = O + (size_t)(row0 + ai * HALF + m * 16) * ldc + col0;
                const f32x4 g0 = acc[ai][0][m][0], g1 = acc[ai][0][m][1], u0 = acc[ai][1][m][0], u1 = acc[ai][1][m][1];
                u32x4 w; w.x = cvt_pk_bf16(silu_mul(g0[0], u0[0]), silu_mul(g0[1], u0[1])); w.y = cvt_pk_bf16(silu_mul(g0[2], u0[2]), silu_mul(g0[3], u0[3]));
                w.z = cvt_pk_bf16(silu_mul(g1[0], u1[0]), silu_mul(g1[1], u1[1])); w.w = cvt_pk_bf16(silu_mul(g1[2], u1[2]), silu_mul(g1[3], u1[3]));
                *(u32x4*)rowp = w; }
    }
};
constexpr int EP_LAT = 32768, EP_SEQ = 2048, EP_D = 1024, EP_MODLD = 6144;
struct EpiArgs { const float* in[31]; float* out; unsigned char* ws; int ph_lo, ph_hi; };
struct EpiResid {
    static constexpr bool PERM = false, AFTER_DRAIN = false;
    int first;
    int gate_off;
    int pool;
    unsigned mod_byte, hc_byte;
    __device__ __forceinline__ void operator()(const f32x4 (&acc)[2][2][4][2], const Unit& u, int wr, int wc, int fr, int fq) const {
        const __attribute__((address_space(4))) EpiArgs* a = (const __attribute__((address_space(4))) EpiArgs*)__builtin_amdgcn_kernarg_segment_ptr(); asm volatile("" : "+s"(a));
        unsigned char* ws = a->ws; float* HCp = (float*)(ws + hc_byte);
        const float* in_lat = first ? a->in[0] : a->out; const float* in_ctx = first ? a->in[2] : HCp; float* out_lat = a->out; float* out_ctx = HCp;
        const float* gate = (const float*)(ws + mod_byte) + gate_off; const float* bias = pool ? a->in[21] : nullptr; const float* cscale = pool ? a->in[22] : nullptr;
        const int rt = u.pm * BM; const bool isl = rt < EP_LAT; const int b = isl ? rt / EP_SEQ : 16;
        const float* ip = isl ? in_lat : in_ctx - (size_t)EP_LAT * EP_D; float* op = isl ? out_lat : out_ctx - (size_t)EP_LAT * EP_D;
        const int col0 = u.pn * BM + wc * 32 + 4 * fq; const float* gp = gate + (size_t)b * EP_MODLD + col0;
        f32x4 gv[2][2], bv[2][2], sv[2][2];
#pragma unroll
        for (int bj = 0; bj < 2; ++bj)
#pragma unroll
            for (int n = 0; n < 2; ++n) { gv[bj][n] = *(const f32x4*)(gp + bj * HALF + n * 16);
                bv[bj][n] = bias ? *(const f32x4*)(bias + col0 + bj * HALF + n * 16) : (f32x4){0.f, 0.f, 0.f, 0.f};
                sv[bj][n] = cscale ? *(const f32x4*)(cscale + col0 + bj * HALF + n * 16) : (f32x4){1.f, 1.f, 1.f, 1.f}; }
#pragma unroll
        for (int ai = 0; ai < 2; ++ai)
#pragma unroll
            for (int m = 0; m < 4; ++m) { const size_t off = (size_t)(rt + ai * HALF + wr * 64 + m * 16 + fr) * EP_D + col0;
#pragma unroll
                for (int bj = 0; bj < 2; ++bj)
#pragma unroll
                    for (int n = 0; n < 2; ++n) { const f32x4 bs = *(const f32x4*)(ip + off + bj * HALF + n * 16);
                        *(f32x4*)(op + off + bj * HALF + n * 16) = bs + gv[bj][n] * ((acc[ai][bj][m][n] + bv[bj][n]) * sv[bj][n]); } }
    }
};

template <class Epi, class Sched, bool ALIGN_EPI = false, bool SP2 = false>
__device__ __forceinline__ void gemm_phase(PG8_LAS unsigned char* lds, const Gemm g, const Sched& S, const Epi& E) {
    int tid_ = threadIdx.x; asm volatile("" : "+v"(tid_));
    const int tid = tid_, wid = __builtin_amdgcn_readfirstlane(tid >> 6), lane = tid & 63, wr = wid >> 2, wc = wid & 3, fr = lane & 15, fq = lane >> 4;
    const int K = g.K, nt = K / BK;
    unsigned voffA[2], voffB[2];
#pragma unroll
    for (int i = 0; i < 2; ++i) { int R, C; stage_rc(tid * 16 + i * 8192, R, C); const int Rb = Epi::PERM ? ((R & ~31) + perm32(R & 31)) : R;
        voffA[i] = (unsigned)(R * g.lda + C) * 2u; voffB[i] = (unsigned)(Rb * g.ldb + C) * 2u; }
    const size_t kstep = (size_t)(BK * 2);
    const size_t hstepA = (size_t)HALF * g.lda * 2, hstepB = (size_t)HALF * g.ldb * 2;
    const size_t tstepA = 2 * hstepA, tstepB = 2 * hstepB; const size_t akoff = (size_t)g.akoff * 2;
    const unsigned ldsw = (unsigned)wid * 1024u;
    const int aoff = lds_byte(wr * 64 + fr, fq * 8), boff = lds_byte(wc * 32 + fr, fq * 8);
#define PG8_SA(b, h) (((b) * 2 + (h)) * HTB)
#define PG8_SB(b, h) ((4 + (b) * 2 + (h)) * HTB)
#define PG8_STAGE(bufoff, gbase, voff) do { _Pragma("unroll") for (int _i = 0; _i < 2; ++_i) \
        __builtin_amdgcn_global_load_lds((const unsigned*)((const char*)(gbase) + (voff)[_i]), (PG8_LAS unsigned*)(lds + (bufoff) + ldsw + _i * 8192), 16, 0, 0); } while (0)
#define PG8_LDA(dst, b, h) do { _Pragma("unroll") for (int m = 0; m < 4; ++m) _Pragma("unroll") for (int k = 0; k < 2; ++k) dst[m][k] = *(const PG8_LAS bf16x8*)(lds + PG8_SA(b, h) + aoff + m * 2048 + k * 1024); } while (0)
#define PG8_LDB(dst, b, h) do { _Pragma("unroll") for (int n = 0; n < 2; ++n) _Pragma("unroll") for (int k = 0; k < 2; ++k) dst[n][k] = *(const PG8_LAS bf16x8*)(lds + PG8_SB(b, h) + boff + n * 2048 + k * 1024); } while (0)
#define PG8_MMA(ai, bj, At, Bt) do { __builtin_amdgcn_s_setprio(1); _Pragma("unroll") for (int m = 0; m < 4; ++m) _Pragma("unroll") for (int n = 0; n < 2; ++n) _Pragma("unroll") for (int k = 0; k < 2; ++k) \
        acc[ai][bj][m][n] = __builtin_amdgcn_mfma_f32_16x16x32_bf16(Bt[n][k], At[m][k], acc[ai][bj][m][n], 0, 0, 0); __builtin_amdgcn_s_setprio(0); } while (0)
#define PG8_WAIT_V(n) asm volatile("s_waitcnt vmcnt(" #n ")" ::: "memory")
#define PG8_WAIT_L(n) asm volatile("s_waitcnt lgkmcnt(" #n ")" ::: "memory")
#define PG8_BAR __builtin_amdgcn_s_barrier()
#define PG8_SCHED __builtin_amdgcn_sched_barrier(0)
    Unit cur, nxt; int ui = 0;
    if (!S.next(0, cur)) return;
    f32x4 acc[2][2][4][2];
#pragma unroll
    for (int a = 0; a < 2; ++a)
#pragma unroll
        for (int b = 0; b < 2; ++b)
#pragma unroll
            for (int m = 0; m < 4; ++m)
#pragma unroll
                for (int n = 0; n < 2; ++n) acc[a][b][m][n] = (f32x4){0.f, 0.f, 0.f, 0.f};
    bf16x8 At[4][2], B0[2][2], B1[2][2];
    const char* cA = (const char*)g.A + (size_t)cur.pm * tstepA + (size_t)cur.pn * akoff; const char* cB = (const char*)g.Bt + (size_t)cur.pn * tstepB;
    S.a_ready(cur);
    if constexpr (SP2) {
        PG8_STAGE(PG8_SB(0, 0), cB, voffB); PG8_STAGE(PG8_SB(0, 1), cB + hstepB, voffB); PG8_STAGE(PG8_SA(0, 0), cA, voffA); PG8_STAGE(PG8_SA(0, 1), cA + hstepA, voffA);
        if (wr == 1) PG8_BAR;
        PG8_WAIT_V(2); PG8_BAR;
        PG8_STAGE(PG8_SB(1, 0), cB + kstep, voffB); PG8_STAGE(PG8_SA(1, 0), cA + kstep, voffA); PG8_STAGE(PG8_SB(1, 1), cB + hstepB + kstep, voffB);
        PG8_WAIT_V(6); PG8_BAR;
    } else {
        PG8_STAGE(PG8_SB(0, 0), cB, voffB); PG8_STAGE(PG8_SA(0, 0), cA, voffA); PG8_STAGE(PG8_SB(0, 1), cB + hstepB, voffB); PG8_STAGE(PG8_SA(0, 1), cA + hstepA, voffA);
        if (wr == 1) PG8_BAR;
        PG8_WAIT_V(4); PG8_BAR;
        PG8_STAGE(PG8_SB(1, 0), cB + kstep, voffB); PG8_STAGE(PG8_SA(1, 0), cA + kstep, voffA); PG8_STAGE(PG8_SB(1, 1), cB + hstepB + kstep, voffB);
        PG8_WAIT_V(6); PG8_BAR;
    }
    for (;;) {
        const bool has_next = S.next(ui + 1, nxt);
        const char* nA = has_next ? (const char*)g.A + (size_t)nxt.pm * tstepA + (size_t)nxt.pn * akoff : cA; const char* nB = has_next ? (const char*)g.Bt + (size_t)nxt.pn * tstepB : cB;
        for (int t = 0; t < nt; t += 2) {
            const bool last = (t == nt - 2);
            const char* a1 = cA + (size_t)(t + 1) * kstep;
            const char* a2 = last ? nA : cA + (size_t)(t + 2) * kstep; const char* b2 = last ? nB : cB + (size_t)(t + 2) * kstep;
            const char* a3 = a2 + kstep; const char* b3 = b2 + kstep;
            if (last && has_next) S.a_ready(nxt);
            if constexpr (SP2) {
            PG8_LDB(B0, 0, 0); PG8_LDB(B1, 0, 1); PG8_SCHED; PG8_LDA(At, 0, 0); PG8_STAGE(PG8_SA(1, 1), a1 + hstepA, voffA);
            PG8_WAIT_V(8); PG8_WAIT_L(0); PG8_BAR; PG8_MMA(0, 0, At, B0); PG8_MMA(0, 1, At, B1); PG8_BAR; PG8_SCHED;
            PG8_LDA(At, 0, 1); PG8_STAGE(PG8_SB(0, 0), b2, voffB); PG8_STAGE(PG8_SB(0, 1), b2 + hstepB, voffB); PG8_STAGE(PG8_SA(0, 0), a2, voffA);
            PG8_WAIT_V(8); PG8_WAIT_L(0); PG8_BAR; PG8_MMA(1, 0, At, B0); PG8_MMA(1, 1, At, B1); PG8_BAR; PG8_SCHED;
            PG8_LDB(B0, 1, 0); PG8_LDB(B1, 1, 1); PG8_SCHED; PG8_LDA(At, 1, 0); PG8_STAGE(PG8_SA(0, 1), a2 + hstepA, voffA);
            PG8_WAIT_V(8); PG8_WAIT_L(0); PG8_BAR; PG8_MMA(0, 0, At, B0); PG8_MMA(0, 1, At, B1); PG8_BAR; PG8_SCHED;
            PG8_LDA(At, 1, 1); PG8_STAGE(PG8_SB(1, 0), b3, voffB); PG8_STAGE(PG8_SB(1, 1), b3 + hstepB, voffB); PG8_STAGE(PG8_SA(1, 0), a3, voffA);
            PG8_WAIT_V(8); PG8_WAIT_L(0); PG8_BAR; PG8_MMA(1, 0, At, B0); PG8_MMA(1, 1, At, B1); PG8_BAR; PG8_SCHED;
            } else {
            PG8_LDB(B0, 0, 0); PG8_SCHED; PG8_LDA(At, 0, 0); PG8_STAGE(PG8_SA(1, 1), a1 + hstepA, voffA);
            PG8_WAIT_L(8); PG8_BAR; PG8_WAIT_L(0); PG8_MMA(0, 0, At, B0); PG8_BAR; PG8_SCHED;
            PG8_LDB(B1, 0, 1); PG8_STAGE(PG8_SB(0, 0), b2, voffB);
            PG8_BAR; PG8_WAIT_L(0); PG8_MMA(0, 1, At, B1); PG8_BAR;
            PG8_LDA(At, 0, 1); PG8_STAGE(PG8_SA(0, 0), a2, voffA);
            PG8_BAR; PG8_WAIT_L(0); PG8_MMA(1, 0, At, B0); PG8_BAR; PG8_SCHED;
            PG8_STAGE(PG8_SB(0, 1), b2 + hstepB, voffB);
            PG8_WAIT_V(6); PG8_BAR; PG8_MMA(1, 1, At, B1); PG8_BAR;
            PG8_LDB(B0, 1, 0); PG8_SCHED; PG8_LDA(At, 1, 0); PG8_STAGE(PG8_SA(0, 1), a2 + hstepA, voffA);
            PG8_WAIT_L(8); PG8_BAR; PG8_WAIT_L(0); PG8_MMA(0, 0, At, B0); PG8_BAR; PG8_SCHED;
            PG8_LDB(B1, 1, 1); PG8_STAGE(PG8_SB(1, 0), b3, voffB);
            PG8_BAR; PG8_WAIT_L(0); PG8_MMA(0, 1, At, B1); PG8_BAR;
            PG8_LDA(At, 1, 1); PG8_STAGE(PG8_SA(1, 0), a3, voffA);
            PG8_BAR; PG8_WAIT_L(0); PG8_MMA(1, 0, At, B0); PG8_BAR; PG8_SCHED;
            PG8_STAGE(PG8_SB(1, 1), b3 + hstepB, voffB);
            PG8_WAIT_V(6); PG8_BAR; PG8_MMA(1, 1, At, B1); PG8_BAR;
            }
        }
        if constexpr (ALIGN_EPI) { if (wr == 0) PG8_BAR; }
        if constexpr (!Epi::AFTER_DRAIN) { E(acc, cur, wr, wc, fr, fq); S.done(cur); }
        if (!has_next) break;
#pragma unroll
        for (int a = 0; a < 2; ++a)
#pragma unroll
            for (int b = 0; b < 2; ++b)
#pragma unroll
                for (int m = 0; m < 4; ++m)
#pragma unroll
                    for (int n = 0; n < 2; ++n) acc[a][b][m][n] = (f32x4){0.f, 0.f, 0.f, 0.f};
        cur = nxt; cA = nA; cB = nB; ++ui;
        if constexpr (ALIGN_EPI) { if (wr == 1) PG8_BAR; }
    }
    PG8_WAIT_V(0);
    if constexpr (!ALIGN_EPI) { if (wr == 0) PG8_BAR; }
    PG8_BAR;
    if constexpr (Epi::AFTER_DRAIN) { E.fused(acc, cur, wr, wc, fr, fq, lds, wid, lane); S.done(cur); }
#undef PG8_SA
#undef PG8_SB
#undef PG8_STAGE
#undef PG8_LDA
#undef PG8_LDB
#undef PG8_MMA
#undef PG8_WAIT_V
#undef PG8_WAIT_L
#undef PG8_BAR
#undef PG8_SCHED
}
}

using pg8::bf16_t; using pg8::bf16x8; using pg8::f32x4; using pg8::u32x4;
typedef float f32x16 __attribute__((ext_vector_type(16)));
typedef unsigned u32x2 __attribute__((ext_vector_type(2)));
#define LAS __attribute__((address_space(3)))
constexpr int DM = 1024, NBATCH = 16, SEQ = 2048, LAT = NBATCH * SEQ, CTXL = 256, NCTX = NBATCH * CTXL, MTOT = LAT + NCTX, DFF = 2816, MODLD = 6 * DM, NMODB = 17;
constexpr float EPS = 1e-6f, LOG2E = 1.4426950408889634f;
constexpr int NTHREADS = 512, NWAVES = 8;
constexpr int LDS_BYTES = 139264;

constexpr size_t MiB = 1u << 20;
constexpr size_t WS_MOD = 0;
constexpr size_t WS_W = 2 * MiB;
constexpr size_t SZ_WGU = (size_t)2 * DFF * DM * 2, SZ_WDN = (size_t)DM * DFF * 2;
constexpr size_t WS_WGU = WS_W, WS_WDN = WS_WGU + 4 * SZ_WGU;
constexpr size_t WS_SWA_QKV = WS_WDN + 4 * SZ_WDN, WS_SWA_WO = WS_SWA_QKV + (size_t)1536 * DM * 2;
constexpr size_t WS_NA_QKV = WS_SWA_WO + (size_t)DM * DM * 2, WS_NA_WO = WS_NA_QKV + (size_t)3072 * DM * 2;
constexpr size_t WS_POOL = WS_NA_WO + (size_t)DM * DM * 2;
constexpr size_t WS_MLA_WA = WS_POOL + (size_t)DM * 256 * 2, WS_MLA_WUQ = WS_MLA_WA + (size_t)512 * DM * 2, WS_MLA_WUKV = WS_MLA_WUQ + (size_t)1536 * 256 * 2;
constexpr size_t WS_MLA_WO = WS_MLA_WUKV + (size_t)2048 * 128 * 2, WS_W_END = WS_MLA_WO + (size_t)DM * DM * 2;
constexpr size_t WS_HC = 86 * MiB;
constexpr size_t WS_RA = 102 * MiB;
constexpr size_t WS_RO = WS_RA + 72 * MiB;
constexpr size_t WS_RB = WS_RO + 72 * MiB;
constexpr size_t WS_END = 507 * MiB;
static_assert(WS_W_END <= WS_HC, "weights fit");
static_assert(WS_RB + (size_t)MTOT * 3072 * 2 <= WS_END && WS_RB + (size_t)MTOT * DFF * 2 <= WS_END, "big region");
constexpr size_t WS_PROJ = WS_RO, WS_QR = WS_PROJ + (size_t)MTOT * 512 * 2, WS_KV = WS_QR + (size_t)LAT * 1536 * 2, WS_KR = WS_KV + (size_t)MTOT * 2048 * 2;
static_assert(WS_KR + (size_t)MTOT * 512 * 2 <= WS_END, "mla region");

__device__ __forceinline__ unsigned f2bf(float f) { unsigned u = __builtin_bit_cast(unsigned, f); return (u + 0x7fffu + ((u >> 16) & 1u)) >> 16; }
__device__ __forceinline__ unsigned pk2(float lo, float hi) { return f2bf(lo) | (f2bf(hi) << 16); }
__device__ __forceinline__ float bflo(unsigned w) { return __builtin_bit_cast(float, w << 16); }
__device__ __forceinline__ float bfhi(unsigned w) { return __builtin_bit_cast(float, w & 0xffff0000u); }
__device__ __forceinline__ float wave_sum(float v) {
#pragma unroll
    for (int o = 1; o < 64; o <<= 1) v += __shfl_xor(v, o);
    return v;
}

struct Args { const float* in[31]; float* out; unsigned char* ws; int ph_lo, ph_hi; };
typedef const __attribute__((address_space(4))) Args* KArgs;

__device__ __forceinline__ void transpose_item(const float* W, int K, int N, bf16_t* WT, int drow0, int k0, int n0, LAS float* scr, int lane) {
#pragma unroll 8
    for (int i = 0; i < 32; ++i) { const int kk = 2 * i + (lane >> 5); scr[kk * 33 + (lane & 31)] = W[(size_t)(k0 + kk) * N + n0 + (lane & 31)]; }
    asm volatile("s_waitcnt lgkmcnt(0)" ::: "memory");
    const int c = lane & 7;
#pragma unroll
    for (int j = 0; j < 4; ++j) { const int n = (lane >> 3) + 8 * j; const LAS float* s = scr + (8 * c) * 33 + n;
        u32x4 o; o.x = pk2(s[0 * 33], s[1 * 33]); o.y = pk2(s[2 * 33], s[3 * 33]); o.z = pk2(s[4 * 33], s[5 * 33]); o.w = pk2(s[6 * 33], s[7 * 33]);
        *(u32x4*)(WT + (size_t)(drow0 + n) * K + k0 + 8 * c) = o; }
    asm volatile("s_waitcnt lgkmcnt(0)" ::: "memory");
}
__device__ __forceinline__ void transpose_job(const float* W, int K, int N, bf16_t* WT, int map, int item, LAS float* scr, int lane) {
    const int nblk = N / 32, kb = item / nblk, nb = item % nblk, k0 = 64 * kb, n0 = 32 * nb;
    int drow0 = n0;
    if (map == 1) { const bool up = n0 >= DFF; const int j = up ? n0 - DFF : n0; drow0 = (j >> 7) * 256 + (up ? 128 : 0) + (j & 127); }
    transpose_item(W, K, N, WT, drow0, k0, n0, scr, lane);
}
__device__ __forceinline__ void prologue_phase(const int TID, KArgs a, LAS unsigned char* lds) {
    const int tid = TID, lane = tid & 63, wave = tid >> 6;
    unsigned char* ws = a->ws;
    LAS float* scr = (LAS float*)(lds + wave * 16384);
    const int gw = blockIdx.x * NWAVES + wave, NGW = gridDim.x * NWAVES;
    constexpr int I_GU = (DM / 64) * (2 * DFF / 32), I_DN = (DFF / 64) * (DM / 32), I_SQ = (DM / 64) * (1536 / 32), I_SQ2 = (DM / 64) * (DM / 32), I_NQ = (DM / 64) * (3072 / 32);
    constexpr int I_PL = (256 / 64) * (256 / 32), I_WA = (DM / 64) * (416 / 32), I_UQ = (256 / 64) * (1536 / 32), I_UKV = (128 / 64) * (2048 / 32);
    constexpr int NITEMS = 4 * I_GU + 4 * I_DN + I_SQ + I_SQ2 + I_NQ + I_SQ2 + 4 * I_PL + I_WA + I_UQ + I_UKV + I_SQ2;
    for (int it = gw; it < NITEMS; it += NGW) {
        int r = it;
        if (r < 4 * I_GU) { const int l = r / I_GU; transpose_job(a->in[8] + (size_t)l * DM * 2 * DFF, DM, 2 * DFF, (bf16_t*)(ws + WS_WGU + l * SZ_WGU), 1, r % I_GU, scr, lane); continue; } r -= 4 * I_GU;
        if (r < 4 * I_DN) { const int l = r / I_DN; transpose_job(a->in[9] + (size_t)l * DFF * DM, DFF, DM, (bf16_t*)(ws + WS_WDN + l * SZ_WDN), 0, r % I_DN, scr, lane); continue; } r -= 4 * I_DN;
        if (r < I_SQ) { transpose_job(a->in[10], DM, 1536, (bf16_t*)(ws + WS_SWA_QKV), 0, r, scr, lane); continue; } r -= I_SQ;
        if (r < I_SQ2) { transpose_job(a->in[14], DM, DM, (bf16_t*)(ws + WS_SWA_WO), 0, r, scr, lane); continue; } r -= I_SQ2;
        if (r < I_NQ) { transpose_job(a->in[15], DM, 3072, (bf16_t*)(ws + WS_NA_QKV), 0, r, scr, lane); continue; } r -= I_NQ;
        if (r < I_SQ2) { transpose_job(a->in[19], DM, DM, (bf16_t*)(ws + WS_NA_WO), 0, r, scr, lane); continue; } r -= I_SQ2;
        if (r < 4 * I_PL) { const int g = r / I_PL; transpose_job(a->in[20] + (size_t)g * 65536, 256, 256, (bf16_t*)(ws + WS_POOL) + (size_t)g * 65536, 0, r % I_PL, scr, lane); continue; } r -= 4 * I_PL;
        if (r < I_WA) { transpose_job(a->in[23], DM, 416, (bf16_t*)(ws + WS_MLA_WA), 0, r, scr, lane); continue; } r -= I_WA;
        if (r < I_UQ) { transpose_job(a->in[26], 256, 1536, (bf16_t*)(ws + WS_MLA_WUQ), 0, r, scr, lane); continue; } r -= I_UQ;
        if (r < I_UKV) { transpose_job(a->in[27], 128, 2048, (bf16_t*)(ws + WS_MLA_WUKV), 0, r, scr, lane); continue; } r -= I_UKV;
        transpose_job(a->in[30], DM, DM, (bf16_t*)(ws + WS_MLA_WO), 0, r, scr, lane);
    }
    { u32x4* z = (u32x4*)(ws + WS_MLA_WA + (size_t)416 * DM * 2); const int nz = 96 * DM * 2 / 16;
      for (int i = blockIdx.x * NTHREADS + tid; i < nz; i += gridDim.x * NTHREADS) z[i] = (u32x4){0u, 0u, 0u, 0u}; }
    __syncthreads();
    if ((int)blockIdx.x < 384) {
        LAS float* cond = (LAS float*)lds;
        LAS float* red = (LAS float*)(lds + 81920);
        for (int i = tid; i < NMODB * DM; i += NTHREADS) { const int b = i / DM, k = i % DM; const float v = b < 16 ? a->in[1][b * DM + k] : a->in[3][k];
            cond[k * 20 + b] = v / (1.0f + __expf(-v)); }
        __syncthreads();
        const int col = tid & 63, kg = tid >> 6;
        for (int u = blockIdx.x; u < 384; u += gridDim.x) {
            const int l = u / 96, cb = u % 96;
            const float* w = a->in[4] + (size_t)l * DM * MODLD + cb * 64 + col;
            float acc[NMODB];
#pragma unroll
            for (int b = 0; b < NMODB; ++b) acc[b] = 0.f;
#pragma unroll 4
            for (int k = kg * 128; k < kg * 128 + 128; ++k) { const float wv = w[(size_t)k * MODLD]; const LAS float* cp = cond + k * 20;
#pragma unroll
                for (int b = 0; b < NMODB; ++b) acc[b] += cp[b] * wv; }
#pragma unroll
            for (int b = 0; b < NMODB; ++b) red[(kg * NMODB + b) * 64 + col] = acc[b];
            __syncthreads();
            for (int i = tid; i < NMODB * 64; i += NTHREADS) { const int b = i >> 6, c = i & 63; float s = 0.f;
#pragma unroll
                for (int g = 0; g < 8; ++g) s += red[(g * NMODB + b) * 64 + c];
                ((float*)(ws + WS_MOD))[((size_t)l * NMODB + b) * MODLD + cb * 64 + c] = s + a->in[5][l * MODLD + cb * 64 + c]; }
            __syncthreads();
        }
    }
}

__device__ __forceinline__ void norm_phase(const int TID, const float* in_lat, const float* in_ctx, int M, const float* g, const float* sh, const float* sc, bf16_t* A) {
    const int lane = TID & 63, wave = TID >> 6;
    const int gw = blockIdx.x * NWAVES + wave, NGW = gridDim.x * NWAVES;
    f32x4 gv[4];
#pragma unroll
    for (int j = 0; j < 4; ++j) gv[j] = *(const f32x4*)(g + 4 * lane + 256 * j);
    for (int row = gw; row < M; row += NGW) {
        const float* xr = row < LAT ? in_lat + (size_t)row * DM : in_ctx + (size_t)(row - LAT) * DM;
        const int b = row < LAT ? row / SEQ : 16;
        f32x4 v[4]; float s = 0.f;
#pragma unroll
        for (int j = 0; j < 4; ++j) { v[j] = *(const f32x4*)(xr + 4 * lane + 256 * j); s += (v[j].x * v[j].x + v[j].y * v[j].y) + (v[j].z * v[j].z + v[j].w * v[j].w); }
        const float rstd = 1.0f / sqrtf(wave_sum(s) * (1.0f / DM) + EPS);
        const float* shp = sh + (size_t)b * MODLD + 4 * lane; const float* scp = sc + (size_t)b * MODLD + 4 * lane;
        bf16_t* op = A + (size_t)row * DM + 4 * lane;
#pragma unroll
        for (int j = 0; j < 4; ++j) { const f32x4 s4 = *(const f32x4*)(scp + 256 * j), h4 = *(const f32x4*)(shp + 256 * j);
            const f32x4 y = (v[j] * rstd * gv[j]) * (s4 + 1.0f) + h4;
            u32x2 w; w.x = pk2(y.x, y.y); w.y = pk2(y.z, y.w); *(u32x2*)(op + 256 * j) = w; }
    }
}

template <int HALFD> __device__ __forceinline__ void rope_table(const int TID, LAS float* tab) {
    for (int i = TID; i < 64 * HALFD; i += NTHREADS) { const int pos = i / HALFD, f = i % HALFD;
        const float fr = powf(10000.0f, -(float)f / (float)HALFD); float sn, cs; sincosf((float)pos * fr, &sn, &cs); tab[2 * i] = cs; tab[2 * i + 1] = sn; }
    __syncthreads();
}

__device__ __forceinline__ void qknorm_phase(const int TID, bf16_t* QKV, int ld, int nq, int nk, const float* gq, const float* gk, bool rope, float qscale, LAS unsigned char* lds) {
    LAS float* tab = (LAS float*)lds;
    if (rope) rope_table<16>(TID, tab);
    const int lane = TID & 63, wave = TID >> 6, l16 = lane & 15;
    const int gw = blockIdx.x * NWAVES + wave, NGW = gridDim.x * NWAVES;
    const f32x4 gq4 = *(const f32x4*)(gq + 4 * l16), gk4 = *(const f32x4*)(gk + 4 * l16);
    const int npass = (nq + nk) / 4;
    for (int row = gw; row < MTOT; row += NGW) {
        const bool dorope = rope && row < LAT; const int t = row & (SEQ - 1);
        const int pos = (l16 & 8) ? (t & 63) : (t >> 6); const int fi = 4 * (l16 & 3); const bool x2 = (l16 & 4) != 0;
        f32x4 cs = {1.f, 1.f, 1.f, 1.f}, sn = {0.f, 0.f, 0.f, 0.f};
        if (dorope) {
#pragma unroll
            for (int j = 0; j < 4; ++j) { cs[j] = tab[2 * (pos * 16 + fi + j)]; sn[j] = tab[2 * (pos * 16 + fi + j) + 1]; } }
        for (int p = 0; p < npass; ++p) {
            const int hh = 4 * p + (lane >> 4); const bool isq = hh < nq;
            bf16_t* ptr = QKV + (size_t)row * ld + hh * 64 + 4 * l16;
            const u32x2 w = *(const u32x2*)ptr;
            f32x4 x = {bflo(w.x), bfhi(w.x), bflo(w.y), bfhi(w.y)};
            float s = (x.x * x.x + x.y * x.y) + (x.z * x.z + x.w * x.w);
            s += __shfl_xor(s, 1); s += __shfl_xor(s, 2); s += __shfl_xor(s, 4); s += __shfl_xor(s, 8);
            const float rstd = 1.0f / sqrtf(s * (1.0f / 64.0f) + EPS);
            x = x * rstd * (isq ? gq4 : gk4);
            f32x4 o;
#pragma unroll
            for (int j = 0; j < 4; ++j) { const float other = __shfl_xor(x[j], 4); o[j] = x2 ? (other * sn[j] + x[j] * cs[j]) : (x[j] * cs[j] - other * sn[j]); }
            if (isq) o = o * qscale;
            u32x2 wo; wo.x = pk2(o.x, o.y); wo.y = pk2(o.z, o.w); *(u32x2*)ptr = wo;
        }
    }
}

__device__ __forceinline__ void mlanorm1_phase(const int TID, bf16_t* PROJ, const float* gcq, const float* gckv) {
    const int lane = TID & 63, wave = TID >> 6;
    const int gw = blockIdx.x * NWAVES + wave, NGW = gridDim.x * NWAVES;
    const f32x4 g1 = *(const f32x4*)(gcq + 4 * lane);
    const float g2a = gckv[2 * lane], g2b = gckv[2 * lane + 1];
    for (int row = gw; row < MTOT; row += NGW) {
        bf16_t* p = PROJ + (size_t)row * 512;
        const u32x2 w = *(const u32x2*)(p + 4 * lane); const unsigned w2 = *(const unsigned*)(p + 256 + 2 * lane);
        f32x4 x = {bflo(w.x), bfhi(w.x), bflo(w.y), bfhi(w.y)}; float ya = bflo(w2), yb = bfhi(w2);
        const float s1 = wave_sum((x.x * x.x + x.y * x.y) + (x.z * x.z + x.w * x.w)), s2 = wave_sum(ya * ya + yb * yb);
        const float r1 = 1.0f / sqrtf(s1 * (1.0f / 256.0f) + EPS), r2 = 1.0f / sqrtf(s2 * (1.0f / 128.0f) + EPS);
        x = x * r1 * g1; ya *= r2 * g2a; yb *= r2 * g2b;
        u32x2 wo; wo.x = pk2(x.x, x.y); wo.y = pk2(x.z, x.w); *(u32x2*)(p + 4 * lane) = wo; *(unsigned*)(p + 256 + 2 * lane) = pk2(ya, yb);
    }
}
__device__ __forceinline__ void mlanorm2_phase(const int TID, bf16_t* QR, bf16_t* KV, const bf16_t* PROJ, bf16_t* KR, const float* gq, const float* gk, float qscale, LAS unsigned char* lds) {
    LAS float* tab = (LAS float*)lds;
    rope_table<8>(TID, tab);
    const int lane = TID & 63, wave = TID >> 6, l32 = lane & 31, hs = lane >> 5;
    const int gw = blockIdx.x * NWAVES + wave, NGW = gridDim.x * NWAVES;
    const float gq0 = gq[l32], gq1 = gq[l32 + 32], gq2 = gq[l32 + 64], gk0 = gk[l32], gk1 = gk[l32 + 32], gk2 = gk[l32 + 64];
    const int fi = l32 & 7; const bool x2 = (l32 & 8) != 0, colpos = (l32 & 16) != 0;
    for (int row = gw; row < MTOT; row += NGW) {
        const bool islat = row < LAT; const int t = row & (SEQ - 1); const int pos = colpos ? (t & 63) : (t >> 6);
        float cs = 1.f, sn = 0.f; if (islat) { cs = tab[2 * (pos * 8 + fi)]; sn = tab[2 * (pos * 8 + fi) + 1]; }
        if (islat) {
            for (int p = 0; p < 8; ++p) { bf16_t* q = QR + (size_t)row * 1536 + (2 * p + hs) * 96;
                float a = bflo((unsigned)q[l32]), b = bflo((unsigned)q[l32 + 32]), c = bflo((unsigned)q[l32 + 64]);
                float s = a * a + b * b + c * c; s += __shfl_xor(s, 1); s += __shfl_xor(s, 2); s += __shfl_xor(s, 4); s += __shfl_xor(s, 8); s += __shfl_xor(s, 16);
                const float rstd = 1.0f / sqrtf(s * (1.0f / 96.0f) + EPS);
                a *= rstd * gq0; b *= rstd * gq1; c *= rstd * gq2;
                const float other = __shfl_xor(c, 8); c = x2 ? (other * sn + c * cs) : (c * cs - other * sn);
                q[l32] = (bf16_t)f2bf(a * qscale); q[l32 + 32] = (bf16_t)f2bf(b * qscale); q[l32 + 64] = (bf16_t)f2bf(c * qscale); }
        }
        const float kr = bflo((unsigned)PROJ[(size_t)row * 512 + 384 + l32]);
        for (int p = 0; p < 8; ++p) { const int hh = 2 * p + hs; bf16_t* k = KV + (size_t)row * 2048 + hh * 128;
            float a = bflo((unsigned)k[l32]), b = bflo((unsigned)k[l32 + 32]), c = kr;
            float s = a * a + b * b + c * c; s += __shfl_xor(s, 1); s += __shfl_xor(s, 2); s += __shfl_xor(s, 4); s += __shfl_xor(s, 8); s += __shfl_xor(s, 16);
            const float rstd = 1.0f / sqrtf(s * (1.0f / 96.0f) + EPS);
            a *= rstd * gk0; b *= rstd * gk1; c *= rstd * gk2;
            const float other = __shfl_xor(c, 8); c = x2 ? (other * sn + c * cs) : (c * cs - other * sn);
            k[l32] = (bf16_t)f2bf(a); k[l32 + 32] = (bf16_t)f2bf(b); KR[(size_t)row * 512 + hh * 32 + l32] = (bf16_t)f2bf(c); }
    }
}

__device__ __forceinline__ void pool_phase(const int TID, const bf16_t* A, bf16_t* P) {
    const int lane = TID & 63, wave = TID >> 6;
    const int gw = blockIdx.x * NWAVES + wave, NGW = gridDim.x * NWAVES;
    for (int row = gw; row < MTOT; row += NGW) {
        int base, L, t; if (row < LAT) { base = row & ~(SEQ - 1); L = SEQ; t = row - base; } else { const int r = row - LAT; base = LAT + (r & ~(CTXL - 1)); L = CTXL; t = r & (CTXL - 1); }
#pragma unroll
        for (int j = 0; j < 4; ++j) {
            const int w = 2 << j; int lo = t - w / 2, hi = t - w / 2 + w; lo = lo < 0 ? 0 : lo; hi = hi > L ? L : hi;
            f32x4 s = {0.f, 0.f, 0.f, 0.f};
            for (int k = lo; k < hi; ++k) { const u32x2 v = *(const u32x2*)(A + (size_t)(base + k) * DM + 256 * j + 4 * lane); s += (f32x4){bflo(v.x), bfhi(v.x), bflo(v.y), bfhi(v.y)}; }
            const u32x2 v = *(const u32x2*)(A + (size_t)row * DM + 256 * j + 4 * lane); const f32x4 self = {bflo(v.x), bfhi(v.x), bflo(v.y), bfhi(v.y)};
            const f32x4 o = s * (1.0f / (float)(hi - lo)) - self;
            u32x2 wo; wo.x = pk2(o.x, o.y); wo.y = pk2(o.z, o.w); *(u32x2*)(P + (size_t)row * DM + 256 * j + 4 * lane) = wo;
        }
    }
}

struct KVSrc { const bf16_t* k; const bf16_t* k2; const bf16_t* v; int ldk, ldk2, ldv; };
template <int DQK> __device__ __forceinline__ void nv_key(const KVSrc& S, int krow, float bias, const float (&q)[DQK], float& m, float& l, float (&o)[64]) {
    const bf16_t* kp = S.k + (size_t)krow * S.ldk; float s = 0.f;
#pragma unroll
    for (int c = 0; c < 8; ++c) { const u32x4 w = *(const u32x4*)(kp + 8 * c);
        s += q[8 * c] * bflo(w.x) + q[8 * c + 1] * bfhi(w.x) + q[8 * c + 2] * bflo(w.y) + q[8 * c + 3] * bfhi(w.y) + q[8 * c + 4] * bflo(w.z) + q[8 * c + 5] * bfhi(w.z) + q[8 * c + 6] * bflo(w.w) + q[8 * c + 7] * bfhi(w.w); }
    if constexpr (DQK == 96) { const bf16_t* k2 = S.k2 + (size_t)krow * S.ldk2;
#pragma unroll
        for (int c = 0; c < 4; ++c) { const u32x4 w = *(const u32x4*)(k2 + 8 * c); const int d = 64 + 8 * c;
            s += q[d] * bflo(w.x) + q[d + 1] * bfhi(w.x) + q[d + 2] * bflo(w.y) + q[d + 3] * bfhi(w.y) + q[d + 4] * bflo(w.z) + q[d + 5] * bfhi(w.z) + q[d + 6] * bflo(w.w) + q[d + 7] * bfhi(w.w); } }
    s += bias;
    const float mn = fmaxf(m, s), alpha = __builtin_amdgcn_exp2f(m - mn), p = __builtin_amdgcn_exp2f(s - mn);
    l = l * alpha + p; m = mn;
    const bf16_t* vp = S.v + (size_t)krow * S.ldv;
#pragma unroll
    for (int c = 0; c < 8; ++c) { const u32x4 w = *(const u32x4*)(vp + 8 * c);
        o[8 * c] = o[8 * c] * alpha + p * bflo(w.x); o[8 * c + 1] = o[8 * c + 1] * alpha + p * bfhi(w.x); o[8 * c + 2] = o[8 * c + 2] * alpha + p * bflo(w.y); o[8 * c + 3] = o[8 * c + 3] * alpha + p * bfhi(w.y);
        o[8 * c + 4] = o[8 * c + 4] * alpha + p * bflo(w.z); o[8 * c + 5] = o[8 * c + 5] * alpha + p * bfhi(w.z); o[8 * c + 6] = o[8 * c + 6] * alpha + p * bflo(w.w); o[8 * c + 7] = o[8 * c + 7] * alpha + p * bfhi(w.w); }
}
template <int MODE> __device__ __forceinline__ void naive_attn_phase(const int TID, KArgs a) {
    constexpr int DQK = MODE == 2 ? 96 : 64;
    unsigned char* ws = a->ws;
    const int NQ = MODE == 2 ? LAT : MTOT; const long total = (long)NQ * 16;
    for (long gi = (long)blockIdx.x * NTHREADS + TID; gi < total; gi += (long)gridDim.x * NTHREADS) {
        const int h = (int)(gi / NQ), row = (int)(gi % NQ);
        const bool islat = row < LAT; const int b = islat ? row / SEQ : (row - LAT) / CTXL; const int t = row & (SEQ - 1);
        const bf16_t* qp; KVSrc S; bf16_t* op;
        if (MODE == 0) { const bf16_t* QKV = (const bf16_t*)(ws + WS_RB); qp = QKV + (size_t)row * 1536 + h * 64; S.k = QKV + 1024 + (h >> 2) * 64; S.v = QKV + 1280 + (h >> 2) * 64; S.k2 = nullptr; S.ldk = S.ldv = 1536; S.ldk2 = 0;
            op = (bf16_t*)(ws + WS_RO) + (size_t)row * DM + h * 64; }
        else if (MODE == 1) { const bf16_t* QKV = (const bf16_t*)(ws + WS_RB); qp = QKV + (size_t)row * 3072 + h * 64; S.k = QKV + 1024 + h * 64; S.v = QKV + 2048 + h * 64; S.k2 = nullptr; S.ldk = S.ldv = 3072; S.ldk2 = 0;
            op = (bf16_t*)(ws + WS_RO) + (size_t)row * DM + h * 64; }
        else { qp = (const bf16_t*)(ws + WS_QR) + (size_t)row * 1536 + h * 96; const bf16_t* KV = (const bf16_t*)(ws + WS_KV); S.k = KV + h * 128; S.v = KV + h * 128 + 64; S.k2 = (const bf16_t*)(ws + WS_KR) + h * 32; S.ldk = S.ldv = 2048; S.ldk2 = 512;
            op = (bf16_t*)(ws + WS_RA) + (size_t)row * DM + h * 64; }
        float q[DQK];
#pragma unroll
        for (int c = 0; c < DQK / 8; ++c) { const u32x4 w = *(const u32x4*)(qp + 8 * c); q[8 * c] = bflo(w.x); q[8 * c + 1] = bfhi(w.x); q[8 * c + 2] = bflo(w.y); q[8 * c + 3] = bfhi(w.y); q[8 * c + 4] = bflo(w.z); q[8 * c + 5] = bfhi(w.z); q[8 * c + 6] = bflo(w.w); q[8 * c + 7] = bfhi(w.w); }
        float o[64];
#pragma unroll
        for (int d = 0; d < 64; ++d) o[d] = 0.f;
        float m = -1e30f, l = 0.f;
        for (int j = 0; j < CTXL; ++j) nv_key<DQK>(S, LAT + b * CTXL + j, 0.f, q, m, l, o);
        if (islat) {
            if (MODE == 0) { const int j0 = t - 128 < 0 ? 0 : t - 128, j1 = t + 128 > SEQ - 1 ? SEQ - 1 : t + 128;
                for (int j = j0; j <= j1; ++j) nv_key<DQK>(S, b * SEQ + j, 0.f, q, m, l, o); }
            else if (MODE == 1) { const int r = t >> 6, c = t & 63; int r0 = r - 4; r0 = r0 < 0 ? 0 : (r0 > 24 ? 24 : r0); int cs = c - 8; cs = cs < 0 ? 0 : (cs > 48 ? 48 : cs);
                const float* rpb = a->in[18] + (size_t)h * 15 * 31;
                for (int kr = r0; kr < r0 + 8; ++kr) for (int kc = cs; kc < cs + 16; ++kc) nv_key<DQK>(S, b * SEQ + kr * 64 + kc, rpb[(kr - r + 7) * 31 + (kc - c + 15)] * LOG2E, q, m, l, o); }
            else { for (int j = 0; j < SEQ; ++j) nv_key<DQK>(S, b * SEQ + j, 0.f, q, m, l, o); }
        }
        if (MODE == 0) l += __builtin_amdgcn_exp2f(a->in[13][h] * LOG2E - m);
        const float inv = 1.0f / l;
#pragma unroll
        for (int c = 0; c < 8; ++c) { u32x4 w; w.x = pk2(o[8 * c] * inv, o[8 * c + 1] * inv); w.y = pk2(o[8 * c + 2] * inv, o[8 * c + 3] * inv); w.z = pk2(o[8 * c + 4] * inv, o[8 * c + 5] * inv); w.w = pk2(o[8 * c + 6] * inv, o[8 * c + 7] * inv);
            *(u32x4*)(op + 8 * c) = w; }
    }
}

enum Kind { K_PRO = 0, K_N1, K_G1, K_QKN, K_ATT, K_G2, K_N2, K_G3, K_G4, K_POOL, K_GPOOL, K_GPROJ, K_MLAN1, K_GUP, K_MLAN2 };
constexpr int NPHASES = 33;
__device__ __forceinline__ void decode_phase(int p, int& L, int& kind) {
    if (p == 0) { L = 0; kind = K_PRO; return; }
    if (p <= 16) { L = (p - 1) >> 3; kind = K_N1 + ((p - 1) & 7); return; }
    if (p <= 22) { L = 2; const int k = p - 17; kind = k == 0 ? K_N1 : k == 1 ? K_POOL : k == 2 ? K_GPOOL : k == 3 ? K_N2 : k == 4 ? K_G3 : K_G4; return; }
    L = 3; const int k = p - 23;
    kind = k == 0 ? K_N1 : k == 1 ? K_GPROJ : k == 2 ? K_MLAN1 : k == 3 ? K_GUP : k == 4 ? K_MLAN2 : k == 5 ? K_ATT : k == 6 ? K_G2 : k == 7 ? K_N2 : k == 8 ? K_G3 : K_G4;
}

__global__ void __launch_bounds__(NTHREADS) fwd_kernel(Args a_by_value) {
    extern __shared__ __attribute__((aligned(16))) unsigned char lds_raw[];
    LAS unsigned char* lds = (LAS unsigned char*)lds_raw;
    cg::grid_group grid = cg::this_grid();
    const int ph_lo = a_by_value.ph_lo, ph_hi = a_by_value.ph_hi;
    for (int p = ph_lo; p < ph_hi; ++p) {
        int L, kind; decode_phase(p, L, kind);
        KArgs a = (KArgs)__builtin_amdgcn_kernarg_segment_ptr(); asm volatile("" : "+s"(a));
        unsigned char* ws = a->ws;
        const float* MOD = (const float*)(ws + WS_MOD);
        float* HC = (float*)(ws + WS_HC);
        bf16_t* RA = (bf16_t*)(ws + WS_RA); bf16_t* RO = (bf16_t*)(ws + WS_RO); bf16_t* RB = (bf16_t*)(ws + WS_RB);
        int TID = threadIdx.x; asm volatile("" : "+v"(TID));
        const float* modL = MOD + (size_t)L * NMODB * MODLD;
        const int Mffn = L == 3 ? LAT : MTOT;
        if (kind == K_PRO) {
            prologue_phase(TID, a, lds);
        } else if (kind == K_N1 || kind == K_N2) {
            const bool first = kind == K_N1;
            const float* il = (L == 0 && first) ? a->in[0] : a->out; const float* ic = (L == 0 && first) ? a->in[2] : HC;
            norm_phase(TID, il, ic, first ? MTOT : Mffn, (first ? a->in[6] : a->in[7]) + L * DM, modL + (first ? 0 : 3 * DM), modL + (first ? DM : 4 * DM), RA);
        } else if (kind == K_G1 || kind == K_GPROJ || kind == K_GUP) {
            const int nrep = kind == K_GUP ? 2 : 1;
            for (int rep = 0; rep < nrep; ++rep) {
                pg8::Gemm g; pg8::EpiStore E;
                if (kind == K_G1) { const int N = L == 0 ? 1536 : 3072; g = pg8::Gemm{RA, (const bf16_t*)(ws + (L == 0 ? WS_SWA_QKV : WS_NA_QKV)), MTOT, N, DM, DM, DM, 0}; E = pg8::EpiStore{RB, N}; }
                else if (kind == K_GPROJ) { g = pg8::Gemm{RA, (const bf16_t*)(ws + WS_MLA_WA), MTOT, 512, DM, DM, DM, 0}; E = pg8::EpiStore{(bf16_t*)(ws + WS_PROJ), 512}; }
                else if (rep == 0) { g = pg8::Gemm{(const bf16_t*)(ws + WS_PROJ), (const bf16_t*)(ws + WS_MLA_WUQ), LAT, 1536, 256, 512, 256, 0}; E = pg8::EpiStore{(bf16_t*)(ws + WS_QR), 1536}; }
                else { g = pg8::Gemm{(const bf16_t*)(ws + WS_PROJ) + 256, (const bf16_t*)(ws + WS_MLA_WUKV), MTOT, 2048, 128, 512, 128, 0}; E = pg8::EpiStore{(bf16_t*)(ws + WS_KV), 2048}; }
                pg8::StaticOrder S; S.init(g.M, g.N, (int)gridDim.x, (int)blockIdx.x);
                pg8::gemm_phase<pg8::EpiStore, pg8::StaticOrder, true, true>(lds, g, S, E);
            }
        } else if (kind == K_G3) {
            pg8::Gemm g{RA, (const bf16_t*)(ws + WS_WGU + (size_t)L * SZ_WGU), Mffn, 2 * DFF, DM, DM, DM, 0};
            pg8::EpiSwiglu E{RB, DFF};
            pg8::StaticOrder S; S.init(g.M, g.N, (int)gridDim.x, (int)blockIdx.x);
            pg8::gemm_phase<pg8::EpiSwiglu, pg8::StaticOrder, true, true>(lds, g, S, E);
        } else if (kind == K_G2 || kind == K_GPOOL || kind == K_G4) {
            pg8::Gemm g; pg8::EpiResid E;
            E.first = (L == 0 && kind == K_G2) ? 1 : 0; E.pool = kind == K_GPOOL ? 1 : 0; E.mod_byte = (unsigned)WS_MOD; E.hc_byte = (unsigned)WS_HC;
            E.gate_off = L * NMODB * MODLD + (kind == K_G4 ? 5 * DM : 2 * DM);
            if (kind == K_G2) { const size_t wo = L == 0 ? WS_SWA_WO : L == 1 ? WS_NA_WO : WS_MLA_WO; g = pg8::Gemm{L == 3 ? RA : RO, (const bf16_t*)(ws + wo), Mffn, DM, DM, DM, DM, 0}; }
            else if (kind == K_GPOOL) { g = pg8::Gemm{RO, (const bf16_t*)(ws + WS_POOL), MTOT, DM, 256, DM, 256, 256}; }
            else { g = pg8::Gemm{RB, (const bf16_t*)(ws + WS_WDN + (size_t)L * SZ_WDN), Mffn, DM, DFF, DFF, DFF, 0}; }
            pg8::StaticOrder S; S.init(g.M, g.N, (int)gridDim.x, (int)blockIdx.x);
            pg8::gemm_phase<pg8::EpiResid, pg8::StaticOrder, true, true>(lds, g, S, E);
        } else if (kind == K_QKN) {
            if (L == 0) qknorm_phase(TID, RB, 1536, 16, 4, a->in[11], a->in[12], true, 0.125f * LOG2E, lds);
            else qknorm_phase(TID, RB, 3072, 16, 16, a->in[16], a->in[17], false, 0.125f * LOG2E, lds);
        } else if (kind == K_ATT) {
            if (L == 0) naive_attn_phase<0>(TID, a); else if (L == 1) naive_attn_phase<1>(TID, a); else naive_attn_phase<2>(TID, a);
        } else if (kind == K_POOL) {
            pool_phase(TID, RA, RO);
        } else if (kind == K_MLAN1) {
            mlanorm1_phase(TID, (bf16_t*)(ws + WS_PROJ), a->in[24], a->in[25]);
        } else if (kind == K_MLAN2) {
            mlanorm2_phase(TID, (bf16_t*)(ws + WS_QR), (bf16_t*)(ws + WS_KV), (const bf16_t*)(ws + WS_PROJ), (bf16_t*)(ws + WS_KR), a->in[28], a->in[29], 0.10206207261596577f * LOG2E, lds);
        }
        if (p + 1 < ph_hi) grid.sync();
    }
}

#ifndef MK_PER_PHASE
#define MK_PER_PHASE 0
#endif
extern "C" void kernel_launch(void* const* d_in, const int* in_sizes, int n_in, void* d_out, int out_size, void* d_ws, size_t ws_size, hipStream_t stream) {
    static int grid = 0;
    if (grid == 0) {
        if (n_in != 31 || in_sizes[0] != LAT * DM || out_size != LAT * DM || ws_size < WS_END) { fprintf(stderr, "kernel_launch: unexpected shapes (n_in %d, in0 %d, out %d, ws %zu < %zu)\n", n_in, n_in > 0 ? in_sizes[0] : -1, out_size, ws_size, (size_t)WS_END); grid = -1; return; }
        int dev = 0, cus = 0, per_cu = 0;
        if (hipGetDevice(&dev) != hipSuccess || hipDeviceGetAttribute(&cus, hipDeviceAttributeMultiprocessorCount, dev) != hipSuccess) { fprintf(stderr, "kernel_launch: device query failed\n"); grid = -1; return; }
        if (hipFuncSetAttribute((const void*)fwd_kernel, hipFuncAttributeMaxDynamicSharedMemorySize, LDS_BYTES) != hipSuccess) { fprintf(stderr, "kernel_launch: hipFuncSetAttribute failed\n"); grid = -1; return; }
        if (hipOccupancyMaxActiveBlocksPerMultiprocessor(&per_cu, (const void*)fwd_kernel, NTHREADS, LDS_BYTES) != hipSuccess || per_cu < 1) { fprintf(stderr, "kernel_launch: occupancy query says %d blocks per CU\n", per_cu); per_cu = 1; }
        (void)hipGetLastError();
        grid = cus * (per_cu > 1 ? 1 : per_cu);
    }
    if (grid < 0) return;
    Args a{};
    for (int i = 0; i < 31; ++i) a.in[i] = (const float*)d_in[i];
    a.out = (float*)d_out; a.ws = (unsigned char*)d_ws;
#if MK_PER_PHASE
    for (int p = 0; p < NPHASES; ++p) { a.ph_lo = p; a.ph_hi = p + 1; hipLaunchKernelGGL(fwd_kernel, dim3(grid), dim3(NTHREADS), LDS_BYTES, stream, a); }
#else
    a.ph_lo = 0; a.ph_hi = NPHASES;
    void* args[] = {&a};
    hipError_t e = hipLaunchCooperativeKernel((const void*)fwd_kernel, dim3(grid), dim3(NTHREADS), args, LDS_BYTES, stream);
    if (e != hipSuccess) fprintf(stderr, "kernel_launch: cooperative launch failed: %s (grid %d)\n", hipGetErrorString(e), grid);
#endif
}
```

```cpp
#include <hip/hip_runtime.h>
#include <hip/hip_cooperative_groups.h>
#include <cstdio>
#include <cstdint>
#include <cmath>
namespace cg = cooperative_groups;

namespace pg8 {
#define PG8_LAS __attribute__((address_space(3)))
typedef unsigned short bf16_t;
typedef short bf16x8 __attribute__((ext_vector_type(8)));
typedef float f32x4 __attribute__((ext_vector_type(4)));
typedef unsigned u32x4 __attribute__((ext_vector_type(4)));
constexpr int BM = 256, BK = 64, HALF = 128, HTB = HALF * BK * 2  , STAGE_BYTES = 8 * HTB, NXCD = 8, WGM = 8;

__host__ __device__ __forceinline__ int lds_byte(int r, int c) { const int st = (r >> 4) * 2 + (c >> 5), rr = r & 15, cc = c & 31, ob = rr * 64 + cc * 2; return st * 1024 + (ob ^ (((ob >> 9) & 1) << 5)); }
__host__ __device__ __forceinline__ void stage_rc(int b, int& R, int& C) { const int st = b / 1024, sb = b % 1024, swz = sb ^ (((sb >> 9) & 1) << 5); R = (st >> 1) * 16 + swz / 64; C = (st & 1) * 32 + (swz % 64) / 2; }
__host__ __device__ __forceinline__ int perm32(int rho) { const int n = rho >> 4, i = rho & 15; return 8 * (i >> 2) + 4 * n + (i & 3); }

struct Unit { int pm, pn; };
struct Gemm { const bf16_t* A; const bf16_t* Bt; int M, N, K, lda, ldb, akoff; };

struct StaticOrder {
    int nM, nN, nwg, G, c;
    __host__ __device__ void init(int M, int N, int G_, int c_) { nM = M / BM; nN = N / BM; nwg = nM * nN; G = G_; c = c_; }
    __host__ __device__ bool next(int i, Unit& u) const {
        const long L = (long)i * G + c; if (L >= nwg) return false;
        int wgid = (int)L; { const int q = nwg / NXCD, r = nwg % NXCD, xcd = wgid % NXCD, off = wgid / NXCD; wgid = (xcd < r ? xcd * (q + 1) : r * (q + 1) + (xcd - r) * q) + off; }
        const int nig = WGM * nN, gid = wgid / nig, fm = gid * WGM, gsz = (nM - fm) < WGM ? (nM - fm) : WGM;
        u.pm = fm + ((wgid % nig) % gsz); u.pn = (wgid % nig) / gsz; return true;
    }
    __device__ __forceinline__ void a_ready(const Unit&) const {}
    __device__ __forceinline__ void done(const Unit&) const {}
};

__device__ __forceinline__ unsigned cvt_pk_bf16(float lo, float hi) { unsigned r; asm volatile("v_cvt_pk_bf16_f32 %0, %1, %2" : "=v"(r) : "v"(lo), "v"(hi)); return r; }

struct EpiStore {
    static constexpr bool PERM = true, AFTER_DRAIN = false;
    bf16_t* O; int ldc;
    __device__ __forceinline__ void operator()(const f32x4 (&acc)[2][2][4][2], const Unit& u, int wr, int wc, int fr, int fq) const {
        const int row0 = u.pm * BM + wr * 64 + fr, col0 = u.pn * BM + wc * 32 + 8 * fq;
#pragma unroll
        for (int ai = 0; ai < 2; ++ai)
#pragma unroll
            for (int m = 0; m < 4; ++m) { bf16_t* rowp = O + (size_t)(row0 + ai * HALF + m * 16) * ldc + col0;
#pragma unroll
                for (int bj = 0; bj < 2; ++bj) { const f32x4 v0 = acc[ai][bj][m][0], v1 = acc[ai][bj][m][1];
                    u32x4 w; w.x = cvt_pk_bf16(v0[0], v0[1]); w.y = cvt_pk_bf16(v0[2], v0[3]); w.z = cvt_pk_bf16(v1[0], v1[1]); w.w = cvt_pk_bf16(v1[2], v1[3]);
                    *(u32x4*)(rowp + bj * HALF) = w; } }
    }
};
__device__ __forceinline__ float silu_mul(float g, float u) { return g * u * __builtin_amdgcn_rcpf(1.0f + __builtin_amdgcn_exp2f(-1.4426950408889634f * g)); }
struct EpiSwiglu {
    static constexpr bool PERM = true, AFTER_DRAIN = false;
    bf16_t* O; int ldc;
    __device__ __forceinline__ void operator()(const f32x4 (&acc)[2][2][4][2], const Unit& u, int wr, int wc, int fr, int fq) const {
        const int row0 = u.pm * BM + wr * 64 + fr, col0 = u.pn * HALF + wc * 32 + 8 * fq;
#pragma unroll
        for (int ai = 0; ai < 2; ++ai)
#pragma unroll
            for (int m = 0; m < 4; ++m) { bf16_t* rowp = O + (size_t)(row0 + ai * HALF + m * 16) * ldc + col0;
                const f32x4 g0 = acc[ai][0][m][0], g1 = acc[ai][0][m][1], u0 = acc[ai][1][m][0], u1 = acc[ai][1][m][1];
                u32x4 w; w.x = cvt_pk_bf16(silu_mul(g0[0], u0[0]), silu_mul(g0[1], u0[1])); w.y = cvt_pk_bf16(silu_mul(g0[2], u0[2]), silu_mul(g0[3], u0[3]));
                w.z = cvt_pk_bf16(silu_mul(g1[0], u1[0]), silu_mul(g1[1], u1[1])); w.w = cvt_pk_bf16(silu_mul(g1[2], u1[2]), silu_mul(g1[3], u1[3]));
                *(u32x4*)rowp = w; }
    }
};
constexpr int EP_LAT = 32768, EP_SEQ = 2048, EP_D = 1024, EP_MODLD = 6144;
struct EpiArgs { const float* in[31]; float* out; unsigned char* ws; int ph_lo, ph_hi; };
struct EpiResid {
    static constexpr bool PERM = false, AFTER_DRAIN = false;
    int first;
    int gate_off;
    int pool;
    unsigned mod_byte, hc_byte;
    __device__ __forceinline__ void operator()(const f32x4 (&acc)[2][2][4][2], const Unit& u, int wr, int wc, int fr, int fq) const {
        const __attribute__((address_space(4))) EpiArgs* a = (const __attribute__((address_space(4))) EpiArgs*)__builtin_amdgcn_kernarg_segment_ptr(); asm volatile("" : "+s"(a));
        unsigned char* ws = a->ws; float* HCp = (float*)(ws + hc_byte);
        const float* in_lat = first ? a->in[0] : a->out; const float* in_ctx = first ? a->in[2] : HCp; float* out_lat = a->out; float* out_ctx = HCp;
        const float* gate = (const float*)(ws + mod_byte) + gate_off; const float* bias = pool ? a->in[21] : nullptr; const float* cscale = pool ? a->in[22] : nullptr;
        const int rt = u.pm * BM; const bool isl = rt < EP_LAT; const int b = isl ? rt / EP_SEQ : 16;
        const float* ip = isl ? in_lat : in_ctx - (size_t)EP_LAT * EP_D; float* op = isl ? out_lat : out_ctx - (size_t)EP_LAT * EP_D;
        const int col0 = u.pn * BM + wc * 32 + 4 * fq; const float* gp = gate + (size_t)b * EP_MODLD + col0;
        f32x4 gv[2][2], bv[2][2], sv[2][2];
#pragma unroll
        for (int bj = 0; bj < 2; ++bj)
#pragma unroll
            for (int n = 0; n < 2; ++n) { gv[bj][n] = *(const f32x4*)(gp + bj * HALF + n * 16);
                bv[bj][n] = bias ? *(const f32x4*)(bias + col0 + bj * HALF + n * 16) : (f32x4){0.f, 0.f, 0.f, 0.f};
                sv[bj][n] = cscale ? *(const f32x4*)(cscale + col0 + bj * HALF + n * 16) : (f32x4){1.f, 1.f, 1.f, 1.f}; }
#pragma unroll
        for (int ai = 0; ai < 2; ++ai)
#pragma unroll
            for (int m = 0; m < 4; ++m) { const size_t off = (size_t)(rt + ai * HALF + wr * 64 + m * 16 + fr) * EP_D + col0;
#pragma unroll
                for (int bj = 0; bj < 2; ++bj)
#pragma unroll
                    for (int n = 0; n < 2; ++n) { const f32x4 bs = *(const f32x4*)(ip + off + bj * HALF + n * 16);
                        *(f32x4*)(op + off + bj * HALF + n * 16) = bs + gv[bj][n] * ((acc[ai][bj][m][n] + bv[bj][n]) * sv[bj][n]); } }
    }
};

template <class Epi, class Sched, bool ALIGN_EPI = false, bool SP2 = false>
__device__ __forceinline__ void gemm_phase(PG8_LAS unsigned char* lds, const Gemm g, const Sched& S, const Epi& E) {
    int tid_ = threadIdx.x; asm volatile("" : "+v"(tid_));
    const int tid = tid_, wid = __builtin_amdgcn_readfirstlane(tid >> 6), lane = tid & 63, wr = wid >> 2, wc = wid & 3, fr = lane & 15, fq = lane >> 4;
    const int K = g.K, nt = K / BK;
    unsigned voffA[2], voffB[2];
#pragma unroll
    for (int i = 0; i < 2; ++i) { int R, C; stage_rc(tid * 16 + i * 8192, R, C); const int Rb = Epi::PERM ? ((R & ~31) + perm32(R & 31)) : R;
        voffA[i] = (unsigned)(R * g.lda + C) * 2u; voffB[i] = (unsigned)(Rb * g.ldb + C) * 2u; }
    const size_t kstep = (size_t)(BK * 2);
    const size_t hstepA = (size_t)HALF * g.lda * 2, hstepB = (size_t)HALF * g.ldb * 2;
    const size_t tstepA = 2 * hstepA, tstepB = 2 * hstepB; const size_t akoff = (size_t)g.akoff * 2;
    const unsigned ldsw = (unsigned)wid * 1024u;
    const int aoff = lds_byte(wr * 64 + fr, fq * 8), boff = lds_byte(wc * 32 + fr, fq * 8);
#define PG8_SA(b, h) (((b) * 2 + (h)) * HTB)
#define PG8_SB(b, h) ((4 + (b) * 2 + (h)) * HTB)
#define PG8_STAGE(bufoff, gbase, voff) do { _Pragma("unroll") for (int _i = 0; _i < 2; ++_i) \
        __builtin_amdgcn_global_load_lds((const unsigned*)((const char*)(gbase) + (voff)[_i]), (PG8_LAS unsigned*)(lds + (bufoff) + ldsw + _i * 8192), 16, 0, 0); } while (0)
#define PG8_LDA(dst, b, h) do { _Pragma("unroll") for (int m = 0; m < 4; ++m) _Pragma("unroll") for (int k = 0; k < 2; ++k) dst[m][k] = *(const PG8_LAS bf16x8*)(lds + PG8_SA(b, h) + aoff + m * 2048 + k * 1024); } while (0)
#define PG8_LDB(dst, b, h) do { _Pragma("unroll") for (int n = 0; n < 2; ++n) _Pragma("unroll") for (int k = 0; k < 2; ++k) dst[n][k] = *(const PG8_LAS bf16x8*)(lds + PG8_SB(b, h) + boff + n * 2048 + k * 1024); } while (0)
#define PG8_MMA(ai, bj, At, Bt) do { __builtin_amdgcn_s_setprio(1); _Pragma("unroll") for (int m = 0; m < 4; ++m) _Pragma("unroll") for (int n = 0; n < 2; ++n) _Pragma("unroll") for (int k = 0; k < 2; ++k) \
        acc[ai][bj][m][n] = __builtin_amdgcn_mfma_f32_16x16x32_bf16(Bt[n][k], At[m][k], acc[ai][bj][m][n], 0, 0, 0); __builtin_amdgcn_s_setprio(0); } while (0)
#define PG8_WAIT_V(n) asm volatile("s_waitcnt vmcnt(" #n ")" ::: "memory")
#define PG8_WAIT_L(n) asm volatile("s_waitcnt lgkmcnt(" #n ")" ::: "memory")
#define PG8_BAR __builtin_amdgcn_s_barrier()
#define PG8_SCHED __builtin_amdgcn_sched_barrier(0)
    Unit cur, nxt; int ui = 0;
    if (!S.next(0, cur)) return;
    f32x4 acc[2][2][4][2];
#pragma unroll
    for (int a = 0; a < 2; ++a)
#pragma unroll
        for (int b = 0; b < 2; ++b)
#pragma unroll
            for (int m = 0; m < 4; ++m)
#pragma unroll
                for (int n = 0; n < 2; ++n) acc[a][b][m][n] = (f32x4){0.f, 0.f, 0.f, 0.f};
    bf16x8 At[4][2], B0[2][2], B1[2][2];
    const char* cA = (const char*)g.A + (size_t)cur.pm * tstepA + (size_t)cur.pn * akoff; const char* cB = (const char*)g.Bt + (size_t)cur.pn * tstepB;
    S.a_ready(cur);
    if constexpr (SP2) {
        PG8_STAGE(PG8_SB(0, 0), cB, voffB); PG8_STAGE(PG8_SB(0, 1), cB + hstepB, voffB); PG8_STAGE(PG8_SA(0, 0), cA, voffA); PG8_STAGE(PG8_SA(0, 1), cA + hstepA, voffA);
        if (wr == 1) PG8_BAR;
        PG8_WAIT_V(2); PG8_BAR;
        PG8_STAGE(PG8_SB(1, 0), cB + kstep, voffB); PG8_STAGE(PG8_SA(1, 0), cA + kstep, voffA); PG8_STAGE(PG8_SB(1, 1), cB + hstepB + kstep, voffB);
        PG8_WAIT_V(6); PG8_BAR;
    } else {
        PG8_STAGE(PG8_SB(0, 0), cB, voffB); PG8_STAGE(PG8_SA(0, 0), cA, voffA); PG8_STAGE(PG8_SB(0, 1), cB + hstepB, voffB); PG8_STAGE(PG8_SA(0, 1), cA + hstepA, voffA);
        if (wr == 1) PG8_BAR;
        PG8_WAIT_V(4); PG8_BAR;
        PG8_STAGE(PG8_SB(1, 0), cB + kstep, voffB); PG8_STAGE(PG8_SA(1, 0), cA + kstep, voffA); PG8_STAGE(PG8_SB(1, 1), cB + hstepB + kstep, voffB);
        PG8_WAIT_V(6); PG8_BAR;
    }
    for (;;) {
        const bool has_next = S.next(ui + 1, nxt);
        const char* nA = has_next ? (const char*)g.A + (size_t)nxt.pm * tstepA + (size_t)nxt.pn * akoff : cA; const char* nB = has_next ? (const char*)g.Bt + (size_t)nxt.pn * tstepB : cB;
        for (int t = 0; t < nt; t += 2) {
            const bool last = (t == nt - 2);
            const char* a1 = cA + (size_t)(t + 1) * kstep;
            const char* a2 = last ? nA : cA + (size_t)(t + 2) * kstep; const char* b2 = last ? nB : cB + (size_t)(t + 2) * kstep;
            const char* a3 = a2 + kstep; const char* b3 = b2 + kstep;
            if (last && has_next) S.a_ready(nxt);
            if constexpr (SP2) {
            PG8_LDB(B0, 0, 0); PG8_LDB(B1, 0, 1); PG8_SCHED; PG8_LDA(At, 0, 0); PG8_STAGE(PG8_SA(1, 1), a1 + hstepA, voffA);
            PG8_WAIT_V(8); PG8_WAIT_L(0); PG8_BAR; PG8_MMA(0, 0, At, B0); PG8_MMA(0, 1, At, B1); PG8_BAR; PG8_SCHED;
            PG8_LDA(At, 0, 1); PG8_STAGE(PG8_SB(0, 0), b2, voffB); PG8_STAGE(PG8_SB(0, 1), b2 + hstepB, voffB); PG8_STAGE(PG8_SA(0, 0), a2, voffA);
            PG8_WAIT_V(8); PG8_WAIT_L(0); PG8_BAR; PG8_MMA(1, 0, At, B0); PG8_MMA(1, 1, At, B1); PG8_BAR; PG8_SCHED;
            PG8_LDB(B0, 1, 0); PG8_LDB(B1, 1, 1); PG8_SCHED; PG8_LDA(At, 1, 0); PG8_STAGE(PG8_SA(0, 1), a2 + hstepA, voffA);
            PG8_WAIT_V(8); PG8_WAIT_L(0); PG8_BAR; PG8_MMA(0, 0, At, B0); PG8_MMA(0, 1, At, B1); PG8_BAR; PG8_SCHED;
            PG8_LDA(At, 1, 1); PG8_STAGE(PG8_SB(1, 0), b3, voffB); PG8_STAGE(PG8_SB(1, 1), b3 + hstepB, voffB); PG8_STAGE(PG8_SA(1, 0), a3, voffA);
            PG8_WAIT_V(8); PG8_WAIT_L(0); PG8_BAR; PG8_MMA(1, 0, At, B0); PG8_MMA(1, 1, At, B1); PG8_BAR; PG8_SCHED;
            } else {
            PG8_LDB(B0, 0, 0); PG8_SCHED; PG8_LDA(At, 0, 0); PG8_STAGE(PG8_SA(1, 1), a1 + hstepA, voffA);
            PG8_WAIT_L(8); PG8_BAR; PG8_WAIT_L(0); PG8_MMA(0, 0, At, B0); PG8_BAR; PG8_SCHED;
            PG8_LDB(B1, 0, 1); PG8_STAGE(PG8_SB(0, 0), b2, voffB);
            PG8_BAR; PG8_WAIT_L(0); PG8_MMA(0, 1, At, B1); PG8_BAR;
            PG8_LDA(At, 0, 1); PG8_STAGE(PG8_SA(0, 0), a2, voffA);
            PG8_BAR; PG8_WAIT_L(0); PG8_MMA(1, 0, At, B0); PG8_BAR; PG8_SCHED;
            PG8_STAGE(PG8_SB(0, 1), b2 + hstepB, voffB);
            PG8_WAIT_V(6); PG8_BAR; PG8_MMA(1, 1, At, B1); PG8_BAR;
            PG8_LDB(B0, 1, 0); PG8_SCHED; PG8_LDA(At, 1, 0); PG8_STAGE(PG8_SA(0, 1), a2 + hstepA, voffA);
            PG8_WAIT_L(8); PG8_BAR; PG8_WAIT_L(0); PG8_MMA(0, 0, At, B0); PG8_BAR; PG8_SCHED;
            PG8_LDB(B1, 1, 1); PG8_STAGE(PG8_SB(1, 0), b3, voffB);
            PG8_BAR; PG8_WAIT_L(0); PG8_MMA(0, 1, At, B1); PG8_BAR;
            PG8_LDA(At, 1, 1); PG8_STAGE(PG8_SA(1, 0), a3, voffA);
            PG8_BAR; PG8_WAIT_L(0); PG8_MMA(1, 0, At, B0); PG8_BAR; PG8_SCHED;
            PG8_STAGE(PG8_SB(1, 1), b3 + hstepB, voffB);
            PG8_WAIT_V(6); PG8_BAR; PG8_MMA(1, 1, At, B1); PG8_BAR;
            }
        }
        if constexpr (ALIGN_EPI) { if (wr == 0) PG8_BAR; }
        if constexpr (!Epi::AFTER_DRAIN) { E(acc, cur, wr, wc, fr, fq); S.done(cur); }
        if (!has_next) break;
#pragma unroll
        for (int a = 0; a < 2; ++a)
#pragma unroll
            for (int b = 0; b < 2; ++b)
#pragma unroll
                for (int m = 0; m < 4; ++m)
#pragma unroll
                    for (int n = 0; n < 2; ++n) acc[a][b][m][n] = (f32x4){0.f, 0.f, 0.f, 0.f};
        cur = nxt; cA = nA; cB = nB; ++ui;
        if constexpr (ALIGN_EPI) { if (wr == 1) PG8_BAR; }
    }
    PG8_WAIT_V(0);
    if constexpr (!ALIGN_EPI) { if (wr == 0) PG8_BAR; }
    PG8_BAR;
    if constexpr (Epi::AFTER_DRAIN) { E.fused(acc, cur, wr, wc, fr, fq, lds, wid, lane); S.done(cur); }
#undef PG8_SA
#undef PG8_SB
#undef PG8_STAGE
#undef PG8_LDA
#undef PG8_LDB
#undef PG8_MMA
#undef PG8_WAIT_V
#undef PG8_WAIT_L
#undef PG8_BAR
#undef PG8_SCHED
}
}

using pg8::bf16_t; using pg8::bf16x8; using pg8::f32x4; using pg8::u32x4;
typedef float f32x16 __attribute__((ext_vector_type(16)));
typedef unsigned u32x2 __attribute__((ext_vector_type(2)));
#define LAS __attribute__((address_space(3)))
constexpr int DM = 1024, NBATCH = 16, SEQ = 2048, LAT = NBATCH * SEQ, CTXL = 256, NCTX = NBATCH * CTXL, MTOT = LAT + NCTX, DFF = 2816, MODLD = 6 * DM, NMODB = 17;
constexpr float EPS = 1e-6f, LOG2E = 1.4426950408889634f;
constexpr int NTHREADS = 512, NWAVES = 8;
constexpr int LDS_BYTES = 139264;

constexpr size_t MiB = 1u << 20;
constexpr size_t WS_MOD = 0;
constexpr size_t WS_W = 2 * MiB;
constexpr size_t SZ_WGU = (size_t)2 * DFF * DM * 2, SZ_WDN = (size_t)DM * DFF * 2;
constexpr size_t WS_WGU = WS_W, WS_WDN = WS_WGU + 4 * SZ_WGU;
constexpr size_t WS_SWA_QKV = WS_WDN + 4 * SZ_WDN, WS_SWA_WO = WS_SWA_QKV + (size_t)1536 * DM * 2;
constexpr size_t WS_NA_QKV = WS_SWA_WO + (size_t)DM * DM * 2, WS_NA_WO = WS_NA_QKV + (size_t)3072 * DM * 2;
constexpr size_t WS_POOL = WS_NA_WO + (size_t)DM * DM * 2;
constexpr size_t WS_MLA_WA = WS_POOL + (size_t)DM * 256 * 2, WS_MLA_WUQ = WS_MLA_WA + (size_t)512 * DM * 2, WS_MLA_WUKV = WS_MLA_WUQ + (size_t)1536 * 256 * 2;
constexpr size_t WS_MLA_WO = WS_MLA_WUKV + (size_t)2048 * 128 * 2, WS_W_END = WS_MLA_WO + (size_t)DM * DM * 2;
constexpr size_t WS_HC = 86 * MiB;
constexpr size_t WS_RA = 102 * MiB;
constexpr size_t WS_RO = WS_RA + 72 * MiB;
constexpr size_t WS_RB = WS_RO + 72 * MiB;
constexpr size_t WS_END = 507 * MiB;
static_assert(WS_W_END <= WS_HC, "weights fit");
static_assert(WS_RB + (size_t)MTOT * 3072 * 2 <= WS_END && WS_RB + (size_t)MTOT * DFF * 2 <= WS_END, "big region");
constexpr size_t WS_PROJ = WS_RO, WS_QR = WS_PROJ + (size_t)MTOT * 512 * 2, WS_KV = WS_QR + (size_t)LAT * 1536 * 2, WS_KR = WS_KV + (size_t)MTOT * 2048 * 2;
static_assert(WS_KR + (size_t)MTOT * 512 * 2 <= WS_END, "mla region");

__device__ __forceinline__ unsigned f2bf(float f) { unsigned u = __builtin_bit_cast(unsigned, f); return (u + 0x7fffu + ((u >> 16) & 1u)) >> 16; }
__device__ __forceinline__ unsigned pk2(float lo, float hi) { return f2bf(lo) | (f2bf(hi) << 16); }
__device__ __forceinline__ float bflo(unsigned w) { return __builtin_bit_cast(float, w << 16); }
__device__ __forceinline__ float bfhi(unsigned w) { return __builtin_bit_cast(float, w & 0xffff0000u); }
__device__ __forceinline__ float wave_sum(float v) {
#pragma unroll
    for (int o = 1; o < 64; o <<= 1) v += __shfl_xor(v, o);
    return v;
}

struct Args { const float* in[31]; float* out; unsigned char* ws; int ph_lo, ph_hi; };
typedef const __attribute__((address_space(4))) Args* KArgs;

__device__ __forceinline__ void transpose_item(const float* W, int K, int N, bf16_t* WT, int drow0, int k0, int n0, LAS float* scr, int lane) {
#pragma unroll 8
    for (int i = 0; i < 32; ++i) { const int kk = 2 * i + (lane >> 5); scr[kk * 33 + (lane & 31)] = W[(size_t)(k0 + kk) * N + n0 + (lane & 31)]; }
    asm volatile("s_waitcnt lgkmcnt(0)" ::: "memory");
    const int c = lane & 7;
#pragma unroll
    for (int j = 0; j < 4; ++j) { const int n = (lane >> 3) + 8 * j; const LAS float* s = scr + (8 * c) * 33 + n;
        u32x4 o; o.x = pk2(s[0 * 33], s[1 * 33]); o.y = pk2(s[2 * 33], s[3 * 33]); o.z = pk2(s[4 * 33], s[5 * 33]); o.w = pk2(s[6 * 33], s[7 * 33]);
        *(u32x4*)(WT + (size_t)(drow0 + n) * K + k0 + 8 * c) = o; }
    asm volatile("s_waitcnt lgkmcnt(0)" ::: "memory");
}
__device__ __forceinline__ void transpose_job(const float* W, int K, int N, bf16_t* WT, int map, int item, LAS float* scr, int lane) {
    const int nblk = N / 32, kb = item / nblk, nb = item % nblk, k0 = 64 * kb, n0 = 32 * nb;
    int drow0 = n0;
    if (map == 1) { const bool up = n0 >= DFF; const int j = up ? n0 - DFF : n0; drow0 = (j >> 7) * 256 + (up ? 128 : 0) + (j & 127); }
    transpose_item(W, K, N, WT, drow0, k0, n0, scr, lane);
}
__device__ __forceinline__ void prologue_phase(const int TID, KArgs a, LAS unsigned char* lds) {
    const int tid = TID, lane = tid & 63, wave = tid >> 6;
    unsigned char* ws = a->ws;
    LAS float* scr = (LAS float*)(lds + wave * 16384);
    const int gw = blockIdx.x * NWAVES + wave, NGW = gridDim.x * NWAVES;
    constexpr int I_GU = (DM / 64) * (2 * DFF / 32), I_DN = (DFF / 64) * (DM / 32), I_SQ = (DM / 64) * (1536 / 32), I_SQ2 = (DM / 64) * (DM / 32), I_NQ = (DM / 64) * (3072 / 32);
    constexpr int I_PL = (256 / 64) * (256 / 32), I_WA = (DM / 64) * (416 / 32), I_UQ = (256 / 64) * (1536 / 32), I_UKV = (128 / 64) * (2048 / 32);
    constexpr int NITEMS = 4 * I_GU + 4 * I_DN + I_SQ + I_SQ2 + I_NQ + I_SQ2 + 4 * I_PL + I_WA + I_UQ + I_UKV + I_SQ2;
    for (int it = gw; it < NITEMS; it += NGW) {
        int r = it;
        if (r < 4 * I_GU) { const int l = r / I_GU; transpose_job(a->in[8] + (size_t)l * DM * 2 * DFF, DM, 2 * DFF, (bf16_t*)(ws + WS_WGU + l * SZ_WGU), 1, r % I_GU, scr, lane); continue; } r -= 4 * I_GU;
        if (r < 4 * I_DN) { const int l = r / I_DN; transpose_job(a->in[9] + (size_t)l * DFF * DM, DFF, DM, (bf16_t*)(ws + WS_WDN + l * SZ_WDN), 0, r % I_DN, scr, lane); continue; } r -= 4 * I_DN;
        if (r < I_SQ) { transpose_job(a->in[10], DM, 1536, (bf16_t*)(ws + WS_SWA_QKV), 0, r, scr, lane); continue; } r -= I_SQ;
        if (r < I_SQ2) { transpose_job(a->in[14], DM, DM, (bf16_t*)(ws + WS_SWA_WO), 0, r, scr, lane); continue; } r -= I_SQ2;
        if (r < I_NQ) { transpose_job(a->in[15], DM, 3072, (bf16_t*)(ws + WS_NA_QKV), 0, r, scr, lane); continue; } r -= I_NQ;
        if (r < I_SQ2) { transpose_job(a->in[19], DM, DM, (bf16_t*)(ws + WS_NA_WO), 0, r, scr, lane); continue; } r -= I_SQ2;
        if (r < 4 * I_PL) { const int g = r / I_PL; transpose_job(a->in[20] + (size_t)g * 65536, 256, 256, (bf16_t*)(ws + WS_POOL) + (size_t)g * 65536, 0, r % I_PL, scr, lane); continue; } r -= 4 * I_PL;
        if (r < I_WA) { transpose_job(a->in[23], DM, 416, (bf16_t*)(ws + WS_MLA_WA), 0, r, scr, lane); continue; } r -= I_WA;
        if (r < I_UQ) { transpose_job(a->in[26], 256, 1536, (bf16_t*)(ws + WS_MLA_WUQ), 0, r, scr, lane); continue; } r -= I_UQ;
        if (r < I_UKV) { transpose_job(a->in[27], 128, 2048, (bf16_t*)(ws + WS_MLA_WUKV), 0, r, scr, lane); continue; } r -= I_UKV;
        transpose_job(a->in[30], DM, DM, (bf16_t*)(ws + WS_MLA_WO), 0, r, scr, lane);
    }
    { u32x4* z = (u32x4*)(ws + WS_MLA_WA + (size_t)416 * DM * 2); const int nz = 96 * DM * 2 / 16;
      for (int i = blockIdx.x * NTHREADS + tid; i < nz; i += gridDim.x * NTHREADS) z[i] = (u32x4){0u, 0u, 0u, 0u}; }
    __syncthreads();
    if ((int)blockIdx.x < 384) {
        LAS float* cond = (LAS float*)lds;
        LAS float* red = (LAS float*)(lds + 81920);
        for (int i = tid; i < NMODB * DM; i += NTHREADS) { const int b = i / DM, k = i % DM; const float v = b < 16 ? a->in[1][b * DM + k] : a->in[3][k];
            cond[k * 20 + b] = v / (1.0f + __expf(-v)); }
        __syncthreads();
        const int col = tid & 63, kg = tid >> 6;
        for (int u = blockIdx.x; u < 384; u += gridDim.x) {
            const int l = u / 96, cb = u % 96;
            const float* w = a->in[4] + (size_t)l * DM * MODLD + cb * 64 + col;
            float acc[NMODB];
#pragma unroll
            for (int b = 0; b < NMODB; ++b) acc[b] = 0.f;
#pragma unroll 4
            for (int k = kg * 128; k < kg * 128 + 128; ++k) { const float wv = w[(size_t)k * MODLD]; const LAS float* cp = cond + k * 20;
#pragma unroll
                for (int b = 0; b < NMODB; ++b) acc[b] += cp[b] * wv; }
#pragma unroll
            for (int b = 0; b < NMODB; ++b) red[(kg * NMODB + b) * 64 + col] = acc[b];
            __syncthreads();
            for (int i = tid; i < NMODB * 64; i += NTHREADS) { const int b = i >> 6, c = i & 63; float s = 0.f;
#pragma unroll
                for (int g = 0; g < 8; ++g) s += red[(g * NMODB + b) * 64 + c];
                ((float*)(ws + WS_MOD))[((size_t)l * NMODB + b) * MODLD + cb * 64 + c] = s + a->in[5][l * MODLD + cb * 64 + c]; }
            __syncthreads();
        }
    }
}

__device__ __forceinline__ void norm_phase(const int TID, const float* in_lat, const float* in_ctx, int M, const float* g, const float* sh, const float* sc, bf16_t* A) {
    const int lane = TID & 63, wave = TID >> 6;
    const int gw = blockIdx.x * NWAVES + wave, NGW = gridDim.x * NWAVES;
    f32x4 gv[4];
#pragma unroll
    for (int j = 0; j < 4; ++j) gv[j] = *(const f32x4*)(g + 4 * lane + 256 * j);
    for (int row = gw; row < M; row += NGW) {
        const float* xr = row < LAT ? in_lat + (size_t)row * DM : in_ctx + (size_t)(row - LAT) * DM;
        const int b = row < LAT ? row / SEQ : 16;
        f32x4 v[4]; float s = 0.f;
#pragma unroll
        for (int j = 0; j < 4; ++j) { v[j] = *(const f32x4*)(xr + 4 * lane + 256 * j); s += (v[j].x * v[j].x + v[j].y * v[j].y) + (v[j].z * v[j].z + v[j].w * v[j].w); }
        const float rstd = 1.0f / sqrtf(wave_sum(s) * (1.0f / DM) + EPS);
        const float* shp = sh + (size_t)b * MODLD + 4 * lane; const float* scp = sc + (size_t)b * MODLD + 4 * lane;
        bf16_t* op = A + (size_t)row * DM + 4 * lane;
#pragma unroll
        for (int j = 0; j < 4; ++j) { const f32x4 s4 = *(const f32x4*)(scp + 256 * j), h4 = *(const f32x4*)(shp + 256 * j);
            const f32x4 y = (v[j] * rstd * gv[j]) * (s4 + 1.0f) + h4;
            u32x2 w; w.x = pk2(y.x, y.y); w.y = pk2(y.z, y.w); *(u32x2*)(op + 256 * j) = w; }
    }
}

template <int HALFD> __device__ __forceinline__ void rope_table(const int TID, LAS float* tab) {
    for (int i = TID; i < 64 * HALFD; i += NTHREADS) { const int pos = i / HALFD, f = i % HALFD;
        const float fr = powf(10000.0f, -(float)f / (float)HALFD); float sn, cs; sincosf((float)pos * fr, &sn, &cs); tab[2 * i] = cs; tab[2 * i + 1] = sn; }
    __syncthreads();
}

__device__ __forceinline__ void qknorm_phase(const int TID, bf16_t* QKV, int ld, int nq, int nk, const float* gq, const float* gk, bool rope, float qscale, LAS unsigned char* lds) {
    LAS float* tab = (LAS float*)lds;
    if (rope) rope_table<16>(TID, tab);
    const int lane = TID & 63, wave = TID >> 6, l16 = lane & 15;
    const int gw = blockIdx.x * NWAVES + wave, NGW = gridDim.x * NWAVES;
    const f32x4 gq4 = *(const f32x4*)(gq + 4 * l16), gk4 = *(const f32x4*)(gk + 4 * l16);
    const int npass = (nq + nk) / 4;
    for (int row = gw; row < MTOT; row += NGW) {
        const bool dorope = rope && row < LAT; const int t = row & (SEQ - 1);
        const int pos = (l16 & 8) ? (t & 63) : (t >> 6); const int fi = 4 * (l16 & 3); const bool x2 = (l16 & 4) != 0;
        f32x4 cs = {1.f, 1.f, 1.f, 1.f}, sn = {0.f, 0.f, 0.f, 0.f};
        if (dorope) {
#pragma unroll
            for (int j = 0; j < 4; ++j) { cs[j] = tab[2 * (pos * 16 + fi + j)]; sn[j] = tab[2 * (pos * 16 + fi + j) + 1]; } }
        for (int p = 0; p < npass; ++p) {
            const int hh = 4 * p + (lane >> 4); const bool isq = hh < nq;
            bf16_t* ptr = QKV + (size_t)row * ld + hh * 64 + 4 * l16;
            const u32x2 w = *(const u32x2*)ptr;
            f32x4 x = {bflo(w.x), bfhi(w.x), bflo(w.y), bfhi(w.y)};
            float s = (x.x * x.x + x.y * x.y) + (x.z * x.z + x.w * x.w);
            s += __shfl_xor(s, 1); s += __shfl_xor(s, 2); s += __shfl_xor(s, 4); s += __shfl_xor(s, 8);
            const float rstd = 1.0f / sqrtf(s * (1.0f / 64.0f) + EPS);
            x = x * rstd * (isq ? gq4 : gk4);
            f32x4 o;
#pragma unroll
            for (int j = 0; j < 4; ++j) { const float other = __shfl_xor(x[j], 4); o[j] = x2 ? (other * sn[j] + x[j] * cs[j]) : (x[j] * cs[j] - other * sn[j]); }
            if (isq) o = o * qscale;
            u32x2 wo; wo.x = pk2(o.x, o.y); wo.y = pk2(o.z, o.w); *(u32x2*)ptr = wo;
        }
    }
}

__device__ __forceinline__ void mlanorm1_phase(const int TID, bf16_t* PROJ, const float* gcq, const float* gckv) {
    const int lane = TID & 63, wave = TID >> 6;
    const int gw = blockIdx.x * NWAVES + wave, NGW = gridDim.x * NWAVES;
    const f32x4 g1 = *(const f32x4*)(gcq + 4 * lane);
    const float g2a = gckv[2 * lane], g2b = gckv[2 * lane + 1];
    for (int row = gw; row < MTOT; row += NGW) {
        bf16_t* p = PROJ + (size_t)row * 512;
        const u32x2 w = *(const u32x2*)(p + 4 * lane); const unsigned w2 = *(const unsigned*)(p + 256 + 2 * lane);
        f32x4 x = {bflo(w.x), bfhi(w.x), bflo(w.y), bfhi(w.y)}; float ya = bflo(w2), yb = bfhi(w2);
        const float s1 = wave_sum((x.x * x.x + x.y * x.y) + (x.z * x.z + x.w * x.w)), s2 = wave_sum(ya * ya + yb * yb);
        const float r1 = 1.0f / sqrtf(s1 * (1.0f / 256.0f) + EPS), r2 = 1.0f / sqrtf(s2 * (1.0f / 128.0f) + EPS);
        x = x * r1 * g1; ya *= r2 * g2a; yb *= r2 * g2b;
        u32x2 wo; wo.x = pk2(x.x, x.y); wo.y = pk2(x.z, x.w); *(u32x2*)(p + 4 * lane) = wo; *(unsigned*)(p + 256 + 2 * lane) = pk2(ya, yb);
    }
}
__device__ __forceinline__ void mlanorm2_phase(const int TID, bf16_t* QR, bf16_t* KV, const bf16_t* PROJ, bf16_t* KR, const float* gq, const float* gk, float qscale, LAS unsigned char* lds) {
    LAS float* tab = (LAS float*)lds;
    rope_table<8>(TID, tab);
    const int lane = TID & 63, wave = TID >> 6, l32 = lane & 31, hs = lane >> 5;
    const int gw = blockIdx.x * NWAVES + wave, NGW = gridDim.x * NWAVES;
    const float gq0 = gq[l32], gq1 = gq[l32 + 32], gq2 = gq[l32 + 64], gk0 = gk[l32], gk1 = gk[l32 + 32], gk2 = gk[l32 + 64];
    const int fi = l32 & 7; const bool x2 = (l32 & 8) != 0, colpos = (l32 & 16) != 0;
    for (int row = gw; row < MTOT; row += NGW) {
        const bool islat = row < LAT; const int t = row & (SEQ - 1); const int pos = colpos ? (t & 63) : (t >> 6);
        float cs = 1.f, sn = 0.f; if (islat) { cs = tab[2 * (pos * 8 + fi)]; sn = tab[2 * (pos * 8 + fi) + 1]; }
        if (islat) {
            for (int p = 0; p < 8; ++p) { bf16_t* q = QR + (size_t)row * 1536 + (2 * p + hs) * 96;
                float a = bflo((unsigned)q[l32]), b = bflo((unsigned)q[l32 + 32]), c = bflo((unsigned)q[l32 + 64]);
                float s = a * a + b * b + c * c; s += __shfl_xor(s, 1); s += __shfl_xor(s, 2); s += __shfl_xor(s, 4); s += __shfl_xor(s, 8); s += __shfl_xor(s, 16);
                const float rstd = 1.0f / sqrtf(s * (1.0f / 96.0f) + EPS);
                a *= rstd * gq0; b *= rstd * gq1; c *= rstd * gq2;
                const float other = __shfl_xor(c, 8); c = x2 ? (other * sn + c * cs) : (c * cs - other * sn);
                q[l32] = (bf16_t)f2bf(a * qscale); q[l32 + 32] = (bf16_t)f2bf(b * qscale); q[l32 + 64] = (bf16_t)f2bf(c * qscale); }
        }
        const float kr = bflo((unsigned)PROJ[(size_t)row * 512 + 384 + l32]);
        for (int p = 0; p < 8; ++p) { const int hh = 2 * p + hs; bf16_t* k = KV + (size_t)row * 2048 + hh * 128;
            float a = bflo((unsigned)k[l32]), b = bflo((unsigned)k[l32 + 32]), c = kr;
            float s = a * a + b * b + c * c; s += __shfl_xor(s, 1); s += __shfl_xor(s, 2); s += __shfl_xor(s, 4); s += __shfl_xor(s, 8); s += __shfl_xor(s, 16);
            const float rstd = 1.0f / sqrtf(s * (1.0f / 96.0f) + EPS);
            a *= rstd * gk0; b *= rstd * gk1; c *= rstd * gk2;
            const float other = __shfl_xor(c, 8); c = x2 ? (other * sn + c * cs) : (c * cs - other * sn);
            k[l32] = (bf16_t)f2bf(a); k[l32 + 32] = (bf16_t)f2bf(b); KR[(size_t)row * 512 + hh * 32 + l32] = (bf16_t)f2bf(c); }
    }
}

__device__ __forceinline__ void pool_phase(const int TID, const bf16_t* A, bf16_t* P) {
    const int lane = TID & 63, wave = TID >> 6;
    const int gw = blockIdx.x * NWAVES + wave, NGW = gridDim.x * NWAVES;
    for (int row = gw; row < MTOT; row += NGW) {
        int base, L, t; if (row < LAT) { base = row & ~(SEQ - 1); L = SEQ; t = row - base; } else { const int r = row - LAT; base = LAT + (r & ~(CTXL - 1)); L = CTXL; t = r & (CTXL - 1); }
#pragma unroll
        for (int j = 0; j < 4; ++j) {
            const int w = 2 << j; int lo = t - w / 2, hi = t - w / 2 + w; lo = lo < 0 ? 0 : lo; hi = hi > L ? L : hi;
            f32x4 s = {0.f, 0.f, 0.f, 0.f};
            for (int k = lo; k < hi; ++k) { const u32x2 v = *(const u32x2*)(A + (size_t)(base + k) * DM + 256 * j + 4 * lane); s += (f32x4){bflo(v.x), bfhi(v.x), bflo(v.y), bfhi(v.y)}; }
            const u32x2 v = *(const u32x2*)(A + (size_t)row * DM + 256 * j + 4 * lane); const f32x4 self = {bflo(v.x), bfhi(v.x), bflo(v.y), bfhi(v.y)};
            const f32x4 o = s * (1.0f / (float)(hi - lo)) - self;
            u32x2 wo; wo.x = pk2(o.x, o.y); wo.y = pk2(o.z, o.w); *(u32x2*)(P + (size_t)row * DM + 256 * j + 4 * lane) = wo;
        }
    }
}

typedef short v4i16_t __attribute__((ext_vector_type(4)));
__device__ __forceinline__ int crow16(int r, int hi) { return (r & 3) + 8 * (r >> 2) + 4 * hi; }
template <int MODE> __device__ __forceinline__ void attn_phase(const int TID, KArgs a, LAS unsigned char* lds) {
    constexpr int DQK = MODE == 2 ? 96 : 64, NKS = DQK / 16;
    constexpr int KROWB = DQK * 2 + 16, KBUF = 64 * KROWB, VOFF = 2 * KBUF, BIASOFF = VOFF + 16384;
    const int tid = TID, lane = tid & 63, wid = __builtin_amdgcn_readfirstlane(tid >> 6), r32 = lane & 31, hi = lane >> 5;
    unsigned char* ws = a->ws;
    const bf16_t *Qb, *Kb, *K2b = nullptr, *Vb; bf16_t* Ob; int ldq, ldk;
    if (MODE == 0) { Qb = (const bf16_t*)(ws + WS_RB); ldq = 1536; Kb = Qb + 1024; Vb = Qb + 1280; ldk = 1536; Ob = (bf16_t*)(ws + WS_RO); }
    else if (MODE == 1) { Qb = (const bf16_t*)(ws + WS_RB); ldq = 3072; Kb = Qb + 1024; Vb = Qb + 2048; ldk = 3072; Ob = (bf16_t*)(ws + WS_RO); }
    else { Qb = (const bf16_t*)(ws + WS_QR); ldq = 1536; Kb = (const bf16_t*)(ws + WS_KV); Vb = Kb + 64; K2b = (const bf16_t*)(ws + WS_KR); ldk = 2048; Ob = (bf16_t*)(ws + WS_RA); }
    const int G = gridDim.x, bx = blockIdx.x, vcu = (G % 8 == 0) ? (bx % 8) * (G / 8) + bx / 8 : bx;
    constexpr int NLAT = 2048, NCTXU = MODE == 2 ? 0 : 256;
    const int lat_per = (NLAT + G - 1) / G, ctx_per = (NCTXU + G - 1) / G;
    LAS float* btab = (LAS float*)(lds + BIASOFF);
    const int srow = tid >> 3, sch = tid & 7, s2row = tid >> 2, s2ch = tid & 3;
    const int kst = srow * KROWB + sch * 16, k2st = s2row * KROWB + 128 + s2ch * 16, vst = (sch >> 2) * 4096 + srow * 64 + (sch & 3) * 16;
    const int vrd = (4 * hi + ((lane & 15) >> 2)) * 64 + (16 * ((lane >> 4) & 1) + 4 * (lane & 3)) * 2;
    for (int it = 0; it < lat_per + ctx_per; ++it) {
        const bool ctxu = it >= lat_per;
        const int u = ctxu ? vcu * ctx_per + (it - lat_per) : vcu * lat_per + it;
        if (u >= (ctxu ? NCTXU : NLAT)) continue;
        int b, head, hoff, qrow, NT, lat0 = 0, qtok = 0, jj_lo = 0, rrow = 0, R0 = 0;
        if (MODE == 0) {
            if (!ctxu) { b = u >> 7; const int kvh = (u >> 5) & 3, qb = u & 31; head = kvh * 4 + (wid >> 1); hoff = kvh * 64; qtok = qb * 64 + (wid & 1) * 32 + r32; qrow = b * SEQ + qtok;
                jj_lo = 2 - qb > 0 ? 2 - qb : 0; const int jj_hi = 33 - qb < 4 ? 33 - qb : 4; lat0 = b * SEQ + qb * 64 - 128 + 64 * jj_lo; NT = 4 + (jj_hi - jj_lo + 1); }
            else { b = u >> 4; const int kvh = (u >> 2) & 3, qb = u & 3; head = kvh * 4 + (wid >> 1); hoff = kvh * 64; qtok = qb * 64 + (wid & 1) * 32 + r32; qrow = LAT + b * CTXL + qtok; NT = 4; }
        } else if (MODE == 1) {
            if (!ctxu) { b = u >> 7; head = (u >> 3) & 15; const int rq = u & 7; hoff = head * 64; rrow = 4 * rq + (wid >> 1); qtok = 32 * (wid & 1) + r32; qrow = b * SEQ + rrow * 64 + qtok;
                R0 = 4 * rq - 4; R0 = R0 < 0 ? 0 : (R0 > 24 ? 24 : R0); int R1 = 4 * rq - 1; R1 = (R1 < 0 ? 0 : (R1 > 24 ? 24 : R1)) + 7; lat0 = b * SEQ + R0 * 64; NT = 4 + (R1 - R0 + 1); }
            else { b = u >> 4; head = u & 15; hoff = head * 64; qrow = LAT + b * CTXL + wid * 32 + r32; NT = 4; }
        } else { b = u >> 7; head = (u >> 3) & 15; const int qb = u & 7; hoff = head * 128; qrow = b * SEQ + qb * 256 + wid * 32 + r32; lat0 = b * SEQ; NT = 4 + 32; }
        const int ctx0 = LAT + b * CTXL;
        bf16x8 qf[NKS];
        { const bf16_t* qp = Qb + (size_t)qrow * ldq + head * DQK + 8 * hi;
#pragma unroll
          for (int ks = 0; ks < NKS; ++ks) qf[ks] = *(const bf16x8*)(qp + 16 * ks); }
        if (MODE == 1 && !ctxu) { const float* rp = a->in[18] + (size_t)head * 465; for (int i = tid; i < 465; i += NTHREADS) btab[64 + i] = rp[i] * LOG2E; }
        u32x4 kreg, k2reg = {0u, 0u, 0u, 0u}, vreg;
#define ATT_TILE_ROW(j) ((j) < 4 ? ctx0 + 64 * (j) : lat0 + 64 * ((j) - 4))
#define ATT_LOAD(j) do { const int kr0_ = ATT_TILE_ROW(j); kreg = *(const u32x4*)(Kb + (size_t)(kr0_ + srow) * ldk + hoff + sch * 8); vreg = *(const u32x4*)(Vb + (size_t)(kr0_ + srow) * ldk + hoff + sch * 8); \
        if (MODE == 2 && tid < 256) k2reg = *(const u32x4*)(K2b + (size_t)(kr0_ + s2row) * 512 + head * 32 + s2ch * 8); } while (0)
#define ATT_STORE(buf) do { *(LAS u32x4*)(lds + (buf) * KBUF + kst) = kreg; *(LAS u32x4*)(lds + VOFF + (buf) * 8192 + vst) = vreg; if (MODE == 2 && tid < 256) *(LAS u32x4*)(lds + (buf) * KBUF + k2st) = k2reg; } while (0)
        ATT_LOAD(0); ATT_STORE(0);
        __syncthreads();
        f32x16 o0, o1;
#pragma unroll
        for (int i = 0; i < 16; ++i) { o0[i] = 0.f; o1[i] = 0.f; }
        float m = -1e30f, l = 0.f;
        int r0w = rrow - 4; r0w = r0w < 0 ? 0 : (r0w > 24 ? 24 : r0w);
        int cs = qtok - 8; cs = cs < 0 ? 0 : (cs > 48 ? 48 : cs);
        for (int j = 0; j < NT; ++j) {
            if (j + 1 < NT) ATT_LOAD(j + 1);
            const int buf = j & 1;
            bool active = true, masked = false; int kr = 0, kstart = 0;
            if (MODE == 0 && j >= 4) { const int jj = jj_lo + (j - 4); masked = (jj == 0 || jj == 4); kstart = (lat0 - b * SEQ) + 64 * (j - 4); }
            if (MODE == 1 && j >= 4) { kr = R0 + (j - 4); active = (kr >= r0w && kr < r0w + 8); masked = true; }
            if (active) {
                const LAS unsigned char* kb = lds + buf * KBUF + r32 * KROWB + hi * 16;
                f32x16 s0, s1;
#pragma unroll
                for (int i = 0; i < 16; ++i) { s0[i] = 0.f; s1[i] = 0.f; }
#pragma unroll
                for (int ks = 0; ks < NKS; ++ks) { const bf16x8 a0 = *(const LAS bf16x8*)(kb + ks * 32), a1 = *(const LAS bf16x8*)(kb + 32 * KROWB + ks * 32);
                    s0 = __builtin_amdgcn_mfma_f32_32x32x16_bf16(a0, qf[ks], s0, 0, 0, 0); s1 = __builtin_amdgcn_mfma_f32_32x32x16_bf16(a1, qf[ks], s1, 0, 0, 0); }
                if (MODE == 0 && masked) { const int d0 = qtok - kstart - 4 * hi + 128;
#pragma unroll
                    for (int i = 0; i < 16; ++i) { const int c = (i & 3) + 8 * (i >> 2); if ((unsigned)(d0 - c) > 256u) s0[i] = -1e30f; if ((unsigned)(d0 - c - 32) > 256u) s1[i] = -1e30f; } }
                if (MODE == 1 && masked) { const LAS float* bp = btab + 64 + (kr - rrow + 7) * 31 + 15 - qtok + 4 * hi; const int e0 = 4 * hi - cs;
#pragma unroll
                    for (int i = 0; i < 16; ++i) { const int c = (i & 3) + 8 * (i >> 2);
                        s0[i] = (unsigned)(e0 + c) < 16u ? s0[i] + bp[c] : -1e30f; s1[i] = (unsigned)(e0 + c + 32) < 16u ? s1[i] + bp[c + 32] : -1e30f; } }
                float mx = fmaxf(s0[0], s1[0]);
#pragma unroll
                for (int i = 1; i < 16; ++i) mx = fmaxf(mx, fmaxf(s0[i], s1[i]));
                mx = fmaxf(mx, __shfl_xor(mx, 32));
                const float mn = fmaxf(m, mx), alpha = __builtin_amdgcn_exp2f(m - mn); m = mn;
                float ls = 0.f;
#pragma unroll
                for (int i = 0; i < 16; ++i) { s0[i] = __builtin_amdgcn_exp2f(s0[i] - mn); s1[i] = __builtin_amdgcn_exp2f(s1[i] - mn); ls += s0[i] + s1[i]; }
                l = l * alpha + ls;
#pragma unroll
                for (int i = 0; i < 16; ++i) { o0[i] *= alpha; o1[i] *= alpha; }
                bf16x8 pf[4];
#pragma unroll
                for (int s = 0; s < 4; ++s) { u32x4 w;
#pragma unroll
                    for (int e = 0; e < 4; ++e) { const int r = 8 * (s & 1) + 2 * e; w[e] = s < 2 ? pg8::cvt_pk_bf16(s0[r], s0[r + 1]) : pg8::cvt_pk_bf16(s1[r], s1[r + 1]); }
                    pf[s] = __builtin_bit_cast(bf16x8, w); }
                const LAS unsigned char* vb = lds + VOFF + buf * 8192 + vrd;
#pragma unroll
                for (int s = 0; s < 4; ++s) {
#pragma unroll
                    for (int dh = 0; dh < 2; ++dh) {
                        const v4i16_t lo = __builtin_amdgcn_ds_read_tr16_b64_v4i16((LAS v4i16_t*)(vb + dh * 4096 + s * 1024));
                        const v4i16_t hh = __builtin_amdgcn_ds_read_tr16_b64_v4i16((LAS v4i16_t*)(vb + dh * 4096 + s * 1024 + 512));
                        const bf16x8 vf = __builtin_shufflevector(lo, hh, 0, 1, 2, 3, 4, 5, 6, 7);
                        if (dh == 0) o0 = __builtin_amdgcn_mfma_f32_32x32x16_bf16(vf, pf[s], o0, 0, 0, 0); else o1 = __builtin_amdgcn_mfma_f32_32x32x16_bf16(vf, pf[s], o1, 0, 0, 0); } }
            }
            if (j + 1 < NT) ATT_STORE(buf ^ 1);
            __syncthreads();
        }
#undef ATT_TILE_ROW
#undef ATT_LOAD
#undef ATT_STORE
        l += __shfl_xor(l, 32);
        if (MODE == 0) l += __builtin_amdgcn_exp2f(a->in[13][head] * LOG2E - m);
        const float inv = 1.0f / l;
        bf16_t* op = Ob + (size_t)qrow * DM + head * 64 + 4 * hi;
#pragma unroll
        for (int g4 = 0; g4 < 4; ++g4) {
            u32x2 w0, w1; w0.x = pg8::cvt_pk_bf16(o0[4 * g4] * inv, o0[4 * g4 + 1] * inv); w0.y = pg8::cvt_pk_bf16(o0[4 * g4 + 2] * inv, o0[4 * g4 + 3] * inv);
            w1.x = pg8::cvt_pk_bf16(o1[4 * g4] * inv, o1[4 * g4 + 1] * inv); w1.y = pg8::cvt_pk_bf16(o1[4 * g4 + 2] * inv, o1[4 * g4 + 3] * inv);
            *(u32x2*)(op + 8 * g4) = w0; *(u32x2*)(op + 32 + 8 * g4) = w1; }
    }
}

enum Kind { K_PRO = 0, K_N1, K_G1, K_QKN, K_ATT, K_G2, K_N2, K_G3, K_G4, K_POOL, K_GPOOL, K_GPROJ, K_MLAN1, K_GUP, K_MLAN2 };
constexpr int NPHASES = 33;
__device__ __forceinline__ void decode_phase(int p, int& L, int& kind) {
    if (p == 0) { L = 0; kind = K_PRO; return; }
    if (p <= 16) { L = (p - 1) >> 3; kind = K_N1 + ((p - 1) & 7); return; }
    if (p <= 22) { L = 2; const int k = p - 17; kind = k == 0 ? K_N1 : k == 1 ? K_POOL : k == 2 ? K_GPOOL : k == 3 ? K_N2 : k == 4 ? K_G3 : K_G4; return; }
    L = 3; const int k = p - 23;
    kind = k == 0 ? K_N1 : k == 1 ? K_GPROJ : k == 2 ? K_MLAN1 : k == 3 ? K_GUP : k == 4 ? K_MLAN2 : k == 5 ? K_ATT : k == 6 ? K_G2 : k == 7 ? K_N2 : k == 8 ? K_G3 : K_G4;
}

__global__ void __launch_bounds__(NTHREADS) fwd_kernel(Args a_by_value) {
    extern __shared__ __attribute__((aligned(16))) unsigned char lds_raw[];
    LAS unsigned char* lds = (LAS unsigned char*)lds_raw;
    cg::grid_group grid = cg::this_grid();
    const int ph_lo = a_by_value.ph_lo, ph_hi = a_by_value.ph_hi;
    for (int p = ph_lo; p < ph_hi; ++p) {
        int L, kind; decode_phase(p, L, kind);
        KArgs a = (KArgs)__builtin_amdgcn_kernarg_segment_ptr(); asm volatile("" : "+s"(a));
        unsigned char* ws = a->ws;
        const float* MOD = (const float*)(ws + WS_MOD);
        float* HC = (float*)(ws + WS_HC);
        bf16_t* RA = (bf16_t*)(ws + WS_RA); bf16_t* RO = (bf16_t*)(ws + WS_RO); bf16_t* RB = (bf16_t*)(ws + WS_RB);
        int TID = threadIdx.x; asm volatile("" : "+v"(TID));
        const float* modL = MOD + (size_t)L * NMODB * MODLD;
        const int Mffn = L == 3 ? LAT : MTOT;
        if (kind == K_PRO) {
            prologue_phase(TID, a, lds);
        } else if (kind == K_N1 || kind == K_N2) {
            const bool first = kind == K_N1;
            const float* il = (L == 0 && first) ? a->in[0] : a->out; const float* ic = (L == 0 && first) ? a->in[2] : HC;
            norm_phase(TID, il, ic, first ? MTOT : Mffn, (first ? a->in[6] : a->in[7]) + L * DM, modL + (first ? 0 : 3 * DM), modL + (first ? DM : 4 * DM), RA);
        } else if (kind == K_G1 || kind == K_GPROJ || kind == K_GUP) {
            const int nrep = kind == K_GUP ? 2 : 1;
            for (int rep = 0; rep < nrep; ++rep) {
                pg8::Gemm g; pg8::EpiStore E;
                if (kind == K_G1) { const int N = L == 0 ? 1536 : 3072; g = pg8::Gemm{RA, (const bf16_t*)(ws + (L == 0 ? WS_SWA_QKV : WS_NA_QKV)), MTOT, N, DM, DM, DM, 0}; E = pg8::EpiStore{RB, N}; }
                else if (kind == K_GPROJ) { g = pg8::Gemm{RA, (const bf16_t*)(ws + WS_MLA_WA), MTOT, 512, DM, DM, DM, 0}; E = pg8::EpiStore{(bf16_t*)(ws + WS_PROJ), 512}; }
                else if (rep == 0) { g = pg8::Gemm{(const bf16_t*)(ws + WS_PROJ), (const bf16_t*)(ws + WS_MLA_WUQ), LAT, 1536, 256, 512, 256, 0}; E = pg8::EpiStore{(bf16_t*)(ws + WS_QR), 1536}; }
                else { g = pg8::Gemm{(const bf16_t*)(ws + WS_PROJ) + 256, (const bf16_t*)(ws + WS_MLA_WUKV), MTOT, 2048, 128, 512, 128, 0}; E = pg8::EpiStore{(bf16_t*)(ws + WS_KV), 2048}; }
                pg8::StaticOrder S; S.init(g.M, g.N, (int)gridDim.x, (int)blockIdx.x);
                pg8::gemm_phase<pg8::EpiStore, pg8::StaticOrder, true, true>(lds, g, S, E);
            }
        } else if (kind == K_G3) {
            pg8::Gemm g{RA, (const bf16_t*)(ws + WS_WGU + (size_t)L * SZ_WGU), Mffn, 2 * DFF, DM, DM, DM, 0};
            pg8::EpiSwiglu E{RB, DFF};
            pg8::StaticOrder S; S.init(g.M, g.N, (int)gridDim.x, (int)blockIdx.x);
            pg8::gemm_phase<pg8::EpiSwiglu, pg8::StaticOrder, true, true>(lds, g, S, E);
        } else if (kind == K_G2 || kind == K_GPOOL || kind == K_G4) {
            pg8::Gemm g; pg8::EpiResid E;
            E.first = (L == 0 && kind == K_G2) ? 1 : 0; E.pool = kind == K_GPOOL ? 1 : 0; E.mod_byte = (unsigned)WS_MOD; E.hc_byte = (unsigned)WS_HC;
            E.gate_off = L * NMODB * MODLD + (kind == K_G4 ? 5 * DM : 2 * DM);
            if (kind == K_G2) { const size_t wo = L == 0 ? WS_SWA_WO : L == 1 ? WS_NA_WO : WS_MLA_WO; g = pg8::Gemm{L == 3 ? RA : RO, (const bf16_t*)(ws + wo), Mffn, DM, DM, DM, DM, 0}; }
            else if (kind == K_GPOOL) { g = pg8::Gemm{RO, (const bf16_t*)(ws + WS_POOL), MTOT, DM, 256, DM, 256, 256}; }
            else { g = pg8::Gemm{RB, (const bf16_t*)(ws + WS_WDN + (size_t)L * SZ_WDN), Mffn, DM, DFF, DFF, DFF, 0}; }
            pg8::StaticOrder S; S.init(g.M, g.N, (int)gridDim.x, (int)blockIdx.x);
            pg8::gemm_phase<pg8::EpiResid, pg8::StaticOrder, true, true>(lds, g, S, E);
        } else if (kind == K_QKN) {
            if (L == 0) qknorm_phase(TID, RB, 1536, 16, 4, a->in[11], a->in[12], true, 0.125f * LOG2E, lds);
            else qknorm_phase(TID, RB, 3072, 16, 16, a->in[16], a->in[17], false, 0.125f * LOG2E, lds);
        } else if (kind == K_ATT) {
            if (L == 0) attn_phase<0>(TID, a, lds); else if (L == 1) attn_phase<1>(TID, a, lds); else attn_phase<2>(TID, a, lds);
        } else if (kind == K_POOL) {
            pool_phase(TID, RA, RO);
        } else if (kind == K_MLAN1) {
            mlanorm1_phase(TID, (bf16_t*)(ws + WS_PROJ), a->in[24], a->in[25]);
        } else if (kind == K_MLAN2) {
            mlanorm2_phase(TID, (bf16_t*)(ws + WS_QR), (bf16_t*)(ws + WS_KV), (const bf16_t*)(ws + WS_PROJ), (bf16_t*)(ws + WS_KR), a->in[28], a->in[29], 0.10206207261596577f * LOG2E, lds);
        }
        if (p + 1 < ph_hi) grid.sync();
    }
}

#ifndef MK_PER_PHASE
#define MK_PER_PHASE 0
#endif
extern "C" void kernel_launch(void* const* d_in, const int* in_sizes, int n_in, void* d_out, int out_size, void* d_ws, size_t ws_size, hipStream_t stream) {
    static int grid = 0;
    if (grid == 0) {
        if (n_in != 31 || in_sizes[0] != LAT * DM || out_size != LAT * DM || ws_size < WS_END) { fprintf(stderr, "kernel_launch: unexpected shapes (n_in %d, in0 %d, out %d, ws %zu < %zu)\n", n_in, n_in > 0 ? in_sizes[0] : -1, out_size, ws_size, (size_t)WS_END); grid = -1; return; }
        int dev = 0, cus = 0, per_cu = 0;
        if (hipGetDevice(&dev) != hipSuccess || hipDeviceGetAttribute(&cus, hipDeviceAttributeMultiprocessorCount, dev) != hipSuccess) { fprintf(stderr, "kernel_launch: device query failed\n"); grid = -1; return; }
        if (hipFuncSetAttribute((const void*)fwd_kernel, hipFuncAttributeMaxDynamicSharedMemorySize, LDS_BYTES) != hipSuccess) { fprintf(stderr, "kernel_launch: hipFuncSetAttribute failed\n"); grid = -1; return; }
        if (hipOccupancyMaxActiveBlocksPerMultiprocessor(&per_cu, (const void*)fwd_kernel, NTHREADS, LDS_BYTES) != hipSuccess || per_cu < 1) { fprintf(stderr, "kernel_launch: occupancy query says %d blocks per CU\n", per_cu); per_cu = 1; }
        (void)hipGetLastError();
        grid = cus * (per_cu > 1 ? 1 : per_cu);
    }
    if (grid < 0) return;
    Args a{};
    for (int i = 0; i < 31; ++i) a.in[i] = (const float*)d_in[i];
    a.out = (float*)d_out; a.ws = (unsigned char*)d_ws;
#if MK_PER_PHASE
    for (int p = 0; p < NPHASES; ++p) { a.ph_lo = p; a.ph_hi = p + 1; hipLaunchKernelGGL(fwd_kernel, dim3(grid), dim3(NTHREADS), LDS_BYTES, stream, a); }
#else
    a.ph_lo = 0; a.ph_hi = NPHASES;
    void* args[] = {&a};
    hipError_t e = hipLaunchCooperativeKernel((const void*)fwd_kernel, dim3(grid), dim3(NTHREADS), args, LDS_BYTES, stream);
    if (e != hipSuccess) fprintf(stderr, "kernel_launch: cooperative launch failed: %s (grid %d)\n", hipGetErrorString(e), grid);
#endif
}
```

```cpp
#include <hip/hip_runtime.h>
#include <hip/hip_cooperative_groups.h>
#include <cstdio>
#include <cstdint>
#include <cmath>
namespace cg = cooperative_groups;

namespace pg8 {
#define PG8_LAS __attribute__((address_space(3)))
typedef unsigned short bf16_t;
typedef short bf16x8 __attribute__((ext_vector_type(8)));
typedef float f32x4 __attribute__((ext_vector_type(4)));
typedef unsigned u32x4 __attribute__((ext_vector_type(4)));
constexpr int BM = 256, BK = 64, HALF = 128, HTB = HALF * BK * 2  , STAGE_BYTES = 8 * HTB, NXCD = 8, WGM = 8;

__host__ __device__ __forceinline__ int lds_byte(int r, int c) { const int st = (r >> 4) * 2 + (c >> 5), rr = r & 15, cc = c & 31, ob = rr * 64 + cc * 2; return st * 1024 + (ob ^ (((ob >> 9) & 1) << 5)); }
__host__ __device__ __forceinline__ void stage_rc(int b, int& R, int& C) { const int st = b / 1024, sb = b % 1024, swz = sb ^ (((sb >> 9) & 1) << 5); R = (st >> 1) * 16 + swz / 64; C = (st & 1) * 32 + (swz % 64) / 2; }
__host__ __device__ __forceinline__ int perm32(int rho) { const int n = rho >> 4, i = rho & 15; return 8 * (i >> 2) + 4 * n + (i & 3); }

struct Unit { int pm, pn; };
struct Gemm { const bf16_t* A; const bf16_t* Bt; int M, N, K, lda, ldb, akoff; };

struct StaticOrder {
    int nM, nN, nwg, G, c;
    __host__ __device__ void init(int M, int N, int G_, int c_) { nM = M / BM; nN = N / BM; nwg = nM * nN; G = G_; c = c_; }
    __host__ __device__ bool next(int i, Unit& u) const {
        const long L = (long)i * G + c; if (L >= nwg) return false;
        int wgid = (int)L; { const int q = nwg / NXCD, r = nwg % NXCD, xcd = wgid % NXCD, off = wgid / NXCD; wgid = (xcd < r ? xcd * (q + 1) : r * (q + 1) + (xcd - r) * q) + off; }
        const int nig = WGM * nN, gid = wgid / nig, fm = gid * WGM, gsz = (nM - fm) < WGM ? (nM - fm) : WGM;
        u.pm = fm + ((wgid % nig) % gsz); u.pn = (wgid % nig) / gsz; return true;
    }
    __device__ __forceinline__ void a_ready(const Unit&) const {}
    __device__ __forceinline__ void done(const Unit&) const {}
};

__device__ __forceinline__ unsigned cvt_pk_bf16(float lo, float hi) { unsigned r; asm volatile("v_cvt_pk_bf16_f32 %0, %1, %2" : "=v"(r) : "v"(lo), "v"(hi)); return r; }

struct EpiStore {
    static constexpr bool PERM = true, AFTER_DRAIN = false;
    bf16_t* O; int ldc;
    __device__ __forceinline__ void operator()(const f32x4 (&acc)[2][2][4][2], const Unit& u, int wr, int wc, int fr, int fq) const {
        const int row0 = u.pm * BM + wr * 64 + fr, col0 = u.pn * BM + wc * 32 + 8 * fq;
#pragma unroll
        for (int ai = 0; ai < 2; ++ai)
#pragma unroll
            for (int m = 0; m < 4; ++m) { bf16_t* rowp = O + (size_t)(row0 + ai * HALF + m * 16) * ldc + col0;
#pragma unroll
                for (int bj = 0; bj < 2; ++bj) { const f32x4 v0 = acc[ai][bj][m][0], v1 = acc[ai][bj][m][1];
                    u32x4 w; w.x = cvt_pk_bf16(v0[0], v0[1]); w.y = cvt_pk_bf16(v0[2], v0[3]); w.z = cvt_pk_bf16(v1[0], v1[1]); w.w = cvt_pk_bf16(v1[2], v1[3]);
                    *(u32x4*)(rowp + bj * HALF) = w; } }
    }
};
__device__ __forceinline__ float silu_mul(float g, float u) { return g * u * __builtin_amdgcn_rcpf(1.0f + __builtin_amdgcn_exp2f(-1.4426950408889634f * g)); }
struct EpiSwiglu {
    static constexpr bool PERM = true, AFTER_DRAIN = false;
    bf16_t* O; int ldc;
    __device__ __forceinline__ void operator()(const f32x4 (&acc)[2][2][4][2], const Unit& u, int wr, int wc, int fr, int fq) const {
        const int row0 = u.pm * BM + wr * 64 + fr, col0 = u.pn * HALF + wc * 32 + 8 * fq;
#pragma unroll
        for (int ai = 0; ai < 2; ++ai)
#pragma unroll
            for (int m = 0; m < 4; ++m) { bf16_t* rowp = O + (size_t)(row0 + ai * HALF + m * 16) * ldc + col0;
                const f32x4 g0 = acc[ai][0][m][0], g1 = acc[ai][0][m][1], u0 = acc[ai][1][m][0], u1 = acc[ai][1][m][1];
                u32x4 w; w.x = cvt_pk_bf16(silu_mul(g0[0], u0[0]), silu_mul(g0[1], u0[1])); w.y = cvt_pk_bf16(silu_mul(g0[2], u0[2]), silu_mul(g0[3], u0[3]));
                w.z = cvt_pk_bf16(silu_mul(g1[0], u1[0]), silu_mul(g1[1], u1[1])); w.w = cvt_pk_bf16(silu_mul(g1[2], u1[2]), silu_mul(g1[3], u1[3]));
                *(u32x4*)rowp = w; }
    }
};
constexpr int EP_LAT = 32768, EP_SEQ = 2048, EP_D = 1024, EP_MODLD = 6144;
struct EpiArgs { const float* in[31]; float* out; unsigned char* ws; int ph_lo, ph_hi; };
struct EpiResid {
    static constexpr bool PERM = false, AFTER_DRAIN = false;
    int first;
    int gate_off;
    int pool;
    unsigned mod_byte, hc_byte;
    __device__ __forceinline__ void operator()(const f32x4 (&acc)[2][2][4][2], const Unit& u, int wr, int wc, int fr, int fq) const {
        const __attribute__((address_space(4))) EpiArgs* a = (const __attribute__((address_space(4))) EpiArgs*)__builtin_amdgcn_kernarg_segment_ptr(); asm volatile("" : "+s"(a));
        unsigned char* ws = a->ws; float* HCp = (float*)(ws + hc_byte);
        const float* in_lat = first ? a->in[0] : a->out; const float* in_ctx = first ? a->in[2] : HCp; float* out_lat = a->out; float* out_ctx = HCp;
        const float* gate = (const float*)(ws + mod_byte) + gate_off; const float* bias = pool ? a->in[21] : nullptr; const float* cscale = pool ? a->in[22] : nullptr;
        const int rt = u.pm * BM; const bool isl = rt < EP_LAT; const int b = isl ? rt / EP_SEQ : 16;
        const float* ip = isl ? in_lat : in_ctx - (size_t)EP_LAT * EP_D; float* op = isl ? out_lat : out_ctx - (size_t)EP_LAT * EP_D;
        const int col0 = u.pn * BM + wc * 32 + 4 * fq; const float* gp = gate + (size_t)b * EP_MODLD + col0;
        f32x4 gv[2][2], bv[2][2], sv[2][2];
#pragma unroll
        for (int bj = 0; bj < 2; ++bj)
#pragma unroll
            for (int n = 0; n < 2; ++n) { gv[bj][n] = *(const f32x4*)(gp + bj * HALF + n * 16);
                bv[bj][n] = bias ? *(const f32x4*)(bias + col0 + bj * HALF + n * 16) : (f32x4){0.f, 0.f, 0.f, 0.f};
                sv[bj][n] = cscale ? *(const f32x4*)(cscale + col0 + bj * HALF + n * 16) : (f32x4){1.f, 1.f, 1.f, 1.f}; }
#pragma unroll
        for (int ai = 0; ai < 2; ++ai)
#pragma unroll
            for (int m = 0; m < 4; ++m) { const size_t off = (size_t)(rt + ai * HALF + wr * 64 + m * 16 + fr) * EP_D + col0;
#pragma unroll
                for (int bj = 0; bj < 2; ++bj)
#pragma unroll
                    for (int n = 0; n < 2; ++n) { const f32x4 bs = *(const f32x4*)(ip + off + bj * HALF + n * 16);
                        *(f32x4*)(op + off + bj * HALF + n * 16) = bs + gv[bj][n] * ((acc[ai][bj][m][n] + bv[bj][n]) * sv[bj][n]); } }
    }
};

template <class Epi, class Sched, bool ALIGN_EPI = false, bool SP2 = false>
__device__ __forceinline__ void gemm_phase(PG8_LAS unsigned char* lds, const Gemm g, const Sched& S, const Epi& E) {
    int tid_ = threadIdx.x; asm volatile("" : "+v"(tid_));
    const int tid = tid_, wid = __builtin_amdgcn_readfirstlane(tid >> 6), lane = tid & 63, wr = wid >> 2, wc = wid & 3, fr = lane & 15, fq = lane >> 4;
    const int K = g.K, nt = K / BK;
    unsigned voffA[2], voffB[2];
#pragma unroll
    for (int i = 0; i < 2; ++i) { int R, C; stage_rc(tid * 16 + i * 8192, R, C); const int Rb = Epi::PERM ? ((R & ~31) + perm32(R & 31)) : R;
        voffA[i] = (unsigned)(R * g.lda + C) * 2u; voffB[i] = (unsigned)(Rb * g.ldb + C) * 2u; }
    const size_t kstep = (size_t)(BK * 2);
    const size_t hstepA = (size_t)HALF * g.lda * 2, hstepB = (size_t)HALF * g.ldb * 2;
    const size_t tstepA = 2 * hstepA, tstepB = 2 * hstepB; const size_t akoff = (size_t)g.akoff * 2;
    const unsigned ldsw = (unsigned)wid * 1024u;
    const int aoff = lds_byte(wr * 64 + fr, fq * 8), boff = lds_byte(wc * 32 + fr, fq * 8);
#define PG8_SA(b, h) (((b) * 2 + (h)) * HTB)
#define PG8_SB(b, h) ((4 + (b) * 2 + (h)) * HTB)
#define PG8_STAGE(bufoff, gbase, voff) do { _Pragma("unroll") for (int _i = 0; _i < 2; ++_i) \
        __builtin_amdgcn_global_load_lds((const unsigned*)((const char*)(gbase) + (voff)[_i]), (PG8_LAS unsigned*)(lds + (bufoff) + ldsw + _i * 8192), 16, 0, 0); } while (0)
#define PG8_LDA(dst, b, h) do { _Pragma("unroll") for (int m = 0; m < 4; ++m) _Pragma("unroll") for (int k = 0; k < 2; ++k) dst[m][k] = *(const PG8_LAS bf16x8*)(lds + PG8_SA(b, h) + aoff + m * 2048 + k * 1024); } while (0)
#define PG8_LDB(dst, b, h) do { _Pragma("unroll") for (int n = 0; n < 2; ++n) _Pragma("unroll") for (int k = 0; k < 2; ++k) dst[n][k] = *(const PG8_LAS bf16x8*)(lds + PG8_SB(b, h) + boff + n * 2048 + k * 1024); } while (0)
#define PG8_MMA(ai, bj, At, Bt) do { __builtin_amdgcn_s_setprio(1); _Pragma("unroll") for (int m = 0; m < 4; ++m) _Pragma("unroll") for (int n = 0; n < 2; ++n) _Pragma("unroll") for (int k = 0; k < 2; ++k) \
        acc[ai][bj][m][n] = __builtin_amdgcn_mfma_f32_16x16x32_bf16(Bt[n][k], At[m][k], acc[ai][bj][m][n], 0, 0, 0); __builtin_amdgcn_s_setprio(0); } while (0)
#define PG8_WAIT_V(n) asm volatile("s_waitcnt vmcnt(" #n ")" ::: "memory")
#define PG8_WAIT_L(n) asm volatile("s_waitcnt lgkmcnt(" #n ")" ::: "memory")
#define PG8_BAR __builtin_amdgcn_s_barrier()
#define PG8_SCHED __builtin_amdgcn_sched_barrier(0)
    Unit cur, nxt; int ui = 0;
    if (!S.next(0, cur)) return;
    f32x4 acc[2][2][4][2];
#pragma unroll
    for (int a = 0; a < 2; ++a)
#pragma unroll
        for (int b = 0; b < 2; ++b)
#pragma unroll
            for (int m = 0; m < 4; ++m)
#pragma unroll
                for (int n = 0; n < 2; ++n) acc[a][b][m][n] = (f32x4){0.f, 0.f, 0.f, 0.f};
    bf16x8 At[4][2], B0[2][2], B1[2][2];
    const char* cA = (const char*)g.A + (size_t)cur.pm * tstepA + (size_t)cur.pn * akoff; const char* cB = (const char*)g.Bt + (size_t)cur.pn * tstepB;
    S.a_ready(cur);
    if constexpr (SP2) {
        PG8_STAGE(PG8_SB(0, 0), cB, voffB); PG8_STAGE(PG8_SB(0, 1), cB + hstepB, voffB); PG8_STAGE(PG8_SA(0, 0), cA, voffA); PG8_STAGE(PG8_SA(0, 1), cA + hstepA, voffA);
        if (wr == 1) PG8_BAR;
        PG8_WAIT_V(2); PG8_BAR;
        PG8_STAGE(PG8_SB(1, 0), cB + kstep, voffB); PG8_STAGE(PG8_SA(1, 0), cA + kstep, voffA); PG8_STAGE(PG8_SB(1, 1), cB + hstepB + kstep, voffB);
        PG8_WAIT_V(6); PG8_BAR;
    } else {
        PG8_STAGE(PG8_SB(0, 0), cB, voffB); PG8_STAGE(PG8_SA(0, 0), cA, voffA); PG8_STAGE(PG8_SB(0, 1), cB + hstepB, voffB); PG8_STAGE(PG8_SA(0, 1), cA + hstepA, voffA);
        if (wr == 1) PG8_BAR;
        PG8_WAIT_V(4); PG8_BAR;
        PG8_STAGE(PG8_SB(1, 0), cB + kstep, voffB); PG8_STAGE(PG8_SA(1, 0), cA + kstep, voffA); PG8_STAGE(PG8_SB(1, 1), cB + hstepB + kstep, voffB);
        PG8_WAIT_V(6); PG8_BAR;
    }
    for (;;) {
        const bool has_next = S.next(ui + 1, nxt);
        const char* nA = has_next ? (const char*)g.A + (size_t)nxt.pm * tstepA + (size_t)nxt.pn * akoff : cA; const char* nB = has_next ? (const char*)g.Bt + (size_t)nxt.pn * tstepB : cB;
        for (int t = 0; t < nt; t += 2) {
            const bool last = (t == nt - 2);
            const char* a1 = cA + (size_t)(t + 1) * kstep;
            const char* a2 = last ? nA : cA + (size_t)(t + 2) * kstep; const char* b2 = last ? nB : cB + (size_t)(t + 2) * kstep;
            const char* a3 = a2 + kstep; const char* b3 = b2 + kstep;
            if (last && has_next) S.a_ready(nxt);
            if constexpr (SP2) {
            PG8_LDB(B0, 0, 0); PG8_LDB(B1, 0, 1); PG8_SCHED; PG8_LDA(At, 0, 0); PG8_STAGE(PG8_SA(1, 1), a1 + hstepA, voffA);
            PG8_WAIT_V(8); PG8_WAIT_L(0); PG8_BAR; PG8_MMA(0, 0, At, B0); PG8_MMA(0, 1, At, B1); PG8_BAR; PG8_SCHED;
            PG8_LDA(At, 0, 1); PG8_STAGE(PG8_SB(0, 0), b2, voffB); PG8_STAGE(PG8_SB(0, 1), b2 + hstepB, voffB); PG8_STAGE(PG8_SA(0, 0), a2, voffA);
            PG8_WAIT_V(8); PG8_WAIT_L(0); PG8_BAR; PG8_MMA(1, 0, At, B0); PG8_MMA(1, 1, At, B1); PG8_BAR; PG8_SCHED;
            PG8_LDB(B0, 1, 0); PG8_LDB(B1, 1, 1); PG8_SCHED; PG8_LDA(At, 1, 0); PG8_STAGE(PG8_SA(0, 1), a2 + hstepA, voffA);
            PG8_WAIT_V(8); PG8_WAIT_L(0); PG8_BAR; PG8_MMA(0, 0, At, B0); PG8_MMA(0, 1, At, B1); PG8_BAR; PG8_SCHED;
            PG8_LDA(At, 1, 1); PG8_STAGE(PG8_SB(1, 0), b3, voffB); PG8_STAGE(PG8_SB(1, 1), b3 + hstepB, voffB); PG8_STAGE(PG8_SA(1, 0), a3, voffA);
            PG8_WAIT_V(8); PG8_WAIT_L(0); PG8_BAR; PG8_MMA(1, 0, At, B0); PG8_MMA(1, 1, At, B1); PG8_BAR; PG8_SCHED;
            } else {
            PG8_LDB(B0, 0, 0); PG8_SCHED; PG8_LDA(At, 0, 0); PG8_STAGE(PG8_SA(1, 1), a1 + hstepA, voffA);
            PG8_WAIT_L(8); PG8_BAR; PG8_WAIT_L(0); PG8_MMA(0, 0, At, B0); PG8_BAR; PG8_SCHED;
            PG8_LDB(B1, 0, 1); PG8_STAGE(PG8_SB(0, 0), b2, voffB);
            PG8_BAR; PG8_WAIT_L(0); PG8_MMA(0, 1, At, B1); PG8_BAR;
            PG8_LDA(At, 0, 1); PG8_STAGE(PG8_SA(0, 0), a2, voffA);
            PG8_BAR; PG8_WAIT_L(0); PG8_MMA(1, 0, At, B0); PG8_BAR; PG8_SCHED;
            PG8_STAGE(PG8_SB(0, 1), b2 + hstepB, voffB);
            PG8_WAIT_V(6); PG8_BAR; PG8_MMA(1, 1, At, B1); PG8_BAR;
            PG8_LDB(B0, 1, 0); PG8_SCHED; PG8_LDA(At, 1, 0); PG8_STAGE(PG8_SA(0, 1), a2 + hstepA, voffA);
            PG8_WAIT_L(8); PG8_BAR; PG8_WAIT_L(0); PG8_MMA(0, 0, At, B0); PG8_BAR; PG8_SCHED;
            PG8_LDB(B1, 1, 1); PG8_STAGE(PG8_SB(1, 0), b3, voffB);
            PG8_BAR; PG8_WAIT_L(0); PG8_MMA(0, 1, At, B1); PG8_BAR;
            PG8_LDA(At, 1, 1); PG8_STAGE(PG8_SA(1, 0), a3, voffA);
            PG8_BAR; PG8_WAIT_L(0); PG8_MMA(1, 0, At, B0); PG8_BAR; PG8_SCHED;
            PG8_STAGE(PG8_SB(1, 1), b3 + hstepB, voffB);
            PG8_WAIT_V(6); PG8_BAR; PG8_MMA(1, 1, At, B1); PG8_BAR;
            }
        }
        if constexpr (ALIGN_EPI) { if (wr == 0) PG8_BAR; }
        if constexpr (!Epi::AFTER_DRAIN) { E(acc, cur, wr, wc, fr, fq); S.done(cur); }
        if (!has_next) break;
#pragma unroll
        for (int a = 0; a < 2; ++a)
#pragma unroll
            for (int b = 0; b < 2; ++b)
#pragma unroll
                for (int m = 0; m < 4; ++m)
#pragma unroll
                    for (int n = 0; n < 2; ++n) acc[a][b][m][n] = (f32x4){0.f, 0.f, 0.f, 0.f};
        cur = nxt; cA = nA; cB = nB; ++ui;
        if constexpr (ALIGN_EPI) { if (wr == 1) PG8_BAR; }
    }
    PG8_WAIT_V(0);
    if constexpr (!ALIGN_EPI) { if (wr == 0) PG8_BAR; }
    PG8_BAR;
    if constexpr (Epi::AFTER_DRAIN) { E.fused(acc, cur, wr, wc, fr, fq, lds, wid, lane); S.done(cur); }
#undef PG8_SA
#undef PG8_SB
#undef PG8_STAGE
#undef PG8_LDA
#undef PG8_LDB
#undef PG8_MMA
#undef PG8_WAIT_V
#undef PG8_WAIT_L
#undef PG8_BAR
#undef PG8_SCHED
}
}

using pg8::bf16_t; using pg8::bf16x8; using pg8::f32x4; using pg8::u32x4;
typedef float f32x16 __attribute__((ext_vector_type(16)));
typedef unsigned u32x2 __attribute__((ext_vector_type(2)));
#define LAS __attribute__((address_space(3)))
constexpr int DM = 1024, NBATCH = 16, SEQ = 2048, LAT = NBATCH * SEQ, CTXL = 256, NCTX = NBATCH * CTXL, MTOT = LAT + NCTX, DFF = 2816, MODLD = 6 * DM, NMODB = 17;
constexpr float EPS = 1e-6f, LOG2E = 1.4426950408889634f;
constexpr int NTHREADS = 512, NWAVES = 8;
constexpr int LDS_BYTES = 139264;

constexpr size_t MiB = 1u << 20;
constexpr size_t WS_MOD = 0;
constexpr size_t WS_CTL = 1835008;
constexpr size_t WS_W = 2 * MiB;
constexpr size_t SZ_WGU = (size_t)2 * DFF * DM * 2, SZ_WDN = (size_t)DM * DFF * 2;
constexpr size_t WS_WGU = WS_W, WS_WDN = WS_WGU + 4 * SZ_WGU;
constexpr size_t WS_SWA_QKV = WS_WDN + 4 * SZ_WDN, WS_SWA_WO = WS_SWA_QKV + (size_t)1536 * DM * 2;
constexpr size_t WS_NA_QKV = WS_SWA_WO + (size_t)DM * DM * 2, WS_NA_WO = WS_NA_QKV + (size_t)3072 * DM * 2;
constexpr size_t WS_POOL = WS_NA_WO + (size_t)DM * DM * 2;
constexpr size_t WS_MLA_WA = WS_POOL + (size_t)DM * 256 * 2, WS_MLA_WUQ = WS_MLA_WA + (size_t)512 * DM * 2, WS_MLA_WUKV = WS_MLA_WUQ + (size_t)1536 * 256 * 2;
constexpr size_t WS_MLA_WO = WS_MLA_WUKV + (size_t)2048 * 128 * 2, WS_W_END = WS_MLA_WO + (size_t)DM * DM * 2;
constexpr size_t WS_HC = 86 * MiB;
constexpr size_t WS_RA = 102 * MiB;
constexpr size_t WS_RO = WS_RA + 72 * MiB;
constexpr size_t WS_RB = WS_RO + 72 * MiB;
constexpr size_t WS_END = 507 * MiB;
static_assert(WS_W_END <= WS_HC, "weights fit");
static_assert(WS_RB + (size_t)MTOT * 3072 * 2 <= WS_END && WS_RB + (size_t)MTOT * DFF * 2 <= WS_END, "big region");
constexpr size_t WS_PROJ = WS_RO, WS_QR = WS_PROJ + (size_t)MTOT * 512 * 2, WS_KV = WS_QR + (size_t)LAT * 1536 * 2, WS_KR = WS_KV + (size_t)MTOT * 2048 * 2;
static_assert(WS_KR + (size_t)MTOT * 512 * 2 <= WS_END, "mla region");

__device__ __forceinline__ unsigned f2bf(float f) { unsigned u = __builtin_bit_cast(unsigned, f); return (u + 0x7fffu + ((u >> 16) & 1u)) >> 16; }
__device__ __forceinline__ unsigned pk2(float lo, float hi) { return f2bf(lo) | (f2bf(hi) << 16); }
__device__ __forceinline__ float bflo(unsigned w) { return __builtin_bit_cast(float, w << 16); }
__device__ __forceinline__ float bfhi(unsigned w) { return __builtin_bit_cast(float, w & 0xffff0000u); }
__device__ __forceinline__ float wave_sum(float v) {
#pragma unroll
    for (int o = 1; o < 64; o <<= 1) v += __shfl_xor(v, o);
    return v;
}

struct Args { const float* in[31]; float* out; unsigned char* ws; int ph_lo, ph_hi; };
typedef const __attribute__((address_space(4))) Args* KArgs;

__device__ __forceinline__ void transpose_item(const float* W, int K, int N, bf16_t* WT, int drow0, int k0, int n0, LAS float* scr, int lane) {
#pragma unroll 8
    for (int i = 0; i < 32; ++i) { const int kk = 2 * i + (lane >> 5); scr[kk * 33 + (lane & 31)] = W[(size_t)(k0 + kk) * N + n0 + (lane & 31)]; }
    asm volatile("s_waitcnt lgkmcnt(0)" ::: "memory");
    const int c = lane & 7;
#pragma unroll
    for (int j = 0; j < 4; ++j) { const int n = (lane >> 3) + 8 * j; const LAS float* s = scr + (8 * c) * 33 + n;
        u32x4 o; o.x = pk2(s[0 * 33], s[1 * 33]); o.y = pk2(s[2 * 33], s[3 * 33]); o.z = pk2(s[4 * 33], s[5 * 33]); o.w = pk2(s[6 * 33], s[7 * 33]);
        *(u32x4*)(WT + (size_t)(drow0 + n) * K + k0 + 8 * c) = o; }
    asm volatile("s_waitcnt lgkmcnt(0)" ::: "memory");
}
__device__ __forceinline__ void transpose_job(const float* W, int K, int N, bf16_t* WT, int map, int item, LAS float* scr, int lane) {
    const int nblk = N / 32, kb = item / nblk, nb = item % nblk, k0 = 64 * kb, n0 = 32 * nb;
    int drow0 = n0;
    if (map == 1) { const bool up = n0 >= DFF; const int j = up ? n0 - DFF : n0; drow0 = (j >> 7) * 256 + (up ? 128 : 0) + (j & 127); }
    transpose_item(W, K, N, WT, drow0, k0, n0, scr, lane);
}
__device__ __forceinline__ void prologue_phase(const int TID, KArgs a, LAS unsigned char* lds) {
    const int tid = TID, lane = tid & 63, wave = tid >> 6;
    unsigned char* ws = a->ws;
    LAS float* scr = (LAS float*)(lds + wave * 16384);
    const int gw = blockIdx.x * NWAVES + wave, NGW = gridDim.x * NWAVES;
    constexpr int I_GU = (DM / 64) * (2 * DFF / 32), I_DN = (DFF / 64) * (DM / 32), I_SQ = (DM / 64) * (1536 / 32), I_SQ2 = (DM / 64) * (DM / 32), I_NQ = (DM / 64) * (3072 / 32);
    constexpr int I_PL = (256 / 64) * (256 / 32), I_WA = (DM / 64) * (416 / 32), I_UQ = (256 / 64) * (1536 / 32), I_UKV = (128 / 64) * (2048 / 32);
    constexpr int NITEMS = 4 * I_GU + 4 * I_DN + I_SQ + I_SQ2 + I_NQ + I_SQ2 + 4 * I_PL + I_WA + I_UQ + I_UKV + I_SQ2;
    for (int it = gw; it < NITEMS; it += NGW) {
        int r = it;
        if (r < 4 * I_GU) { const int l = r / I_GU; transpose_job(a->in[8] + (size_t)l * DM * 2 * DFF, DM, 2 * DFF, (bf16_t*)(ws + WS_WGU + l * SZ_WGU), 1, r % I_GU, scr, lane); continue; } r -= 4 * I_GU;
        if (r < 4 * I_DN) { const int l = r / I_DN; transpose_job(a->in[9] + (size_t)l * DFF * DM, DFF, DM, (bf16_t*)(ws + WS_WDN + l * SZ_WDN), 0, r % I_DN, scr, lane); continue; } r -= 4 * I_DN;
        if (r < I_SQ) { transpose_job(a->in[10], DM, 1536, (bf16_t*)(ws + WS_SWA_QKV), 0, r, scr, lane); continue; } r -= I_SQ;
        if (r < I_SQ2) { transpose_job(a->in[14], DM, DM, (bf16_t*)(ws + WS_SWA_WO), 0, r, scr, lane); continue; } r -= I_SQ2;
        if (r < I_NQ) { transpose_job(a->in[15], DM, 3072, (bf16_t*)(ws + WS_NA_QKV), 0, r, scr, lane); continue; } r -= I_NQ;
        if (r < I_SQ2) { transpose_job(a->in[19], DM, DM, (bf16_t*)(ws + WS_NA_WO), 0, r, scr, lane); continue; } r -= I_SQ2;
        if (r < 4 * I_PL) { const int g = r / I_PL; transpose_job(a->in[20] + (size_t)g * 65536, 256, 256, (bf16_t*)(ws + WS_POOL) + (size_t)g * 65536, 0, r % I_PL, scr, lane); continue; } r -= 4 * I_PL;
        if (r < I_WA) { transpose_job(a->in[23], DM, 416, (bf16_t*)(ws + WS_MLA_WA), 0, r, scr, lane); continue; } r -= I_WA;
        if (r < I_UQ) { transpose_job(a->in[26], 256, 1536, (bf16_t*)(ws + WS_MLA_WUQ), 0, r, scr, lane); continue; } r -= I_UQ;
        if (r < I_UKV) { transpose_job(a->in[27], 128, 2048, (bf16_t*)(ws + WS_MLA_WUKV), 0, r, scr, lane); continue; } r -= I_UKV;
        transpose_job(a->in[30], DM, DM, (bf16_t*)(ws + WS_MLA_WO), 0, r, scr, lane);
    }
    { u32x4* z = (u32x4*)(ws + WS_MLA_WA + (size_t)416 * DM * 2); const int nz = 96 * DM * 2 / 16;
      for (int i = blockIdx.x * NTHREADS + tid; i < nz; i += gridDim.x * NTHREADS) z[i] = (u32x4){0u, 0u, 0u, 0u}; }
    __syncthreads();
    if ((int)blockIdx.x < 384) {
        LAS float* cond = (LAS float*)lds;
        LAS float* red = (LAS float*)(lds + 81920);
        for (int i = tid; i < NMODB * DM; i += NTHREADS) { const int b = i / DM, k = i % DM; const float v = b < 16 ? a->in[1][b * DM + k] : a->in[3][k];
            cond[k * 20 + b] = v / (1.0f + __expf(-v)); }
        __syncthreads();
        const int col = tid & 63, kg = tid >> 6;
        for (int u = blockIdx.x; u < 384; u += gridDim.x) {
            const int l = u / 96, cb = u % 96;
            const float* w = a->in[4] + (size_t)l * DM * MODLD + cb * 64 + col;
            float acc[NMODB];
#pragma unroll
            for (int b = 0; b < NMODB; ++b) acc[b] = 0.f;
#pragma unroll 4
            for (int k = kg * 128; k < kg * 128 + 128; ++k) { const float wv = w[(size_t)k * MODLD]; const LAS float* cp = cond + k * 20;
#pragma unroll
                for (int b = 0; b < NMODB; ++b) acc[b] += cp[b] * wv; }
#pragma unroll
            for (int b = 0; b < NMODB; ++b) red[(kg * NMODB + b) * 64 + col] = acc[b];
            __syncthreads();
            for (int i = tid; i < NMODB * 64; i += NTHREADS) { const int b = i >> 6, c = i & 63; float s = 0.f;
#pragma unroll
                for (int g = 0; g < 8; ++g) s += red[(g * NMODB + b) * 64 + c];
                ((float*)(ws + WS_MOD))[((size_t)l * NMODB + b) * MODLD + cb * 64 + c] = s + a->in[5][l * MODLD + cb * 64 + c]; }
            __syncthreads();
        }
    }
}

__device__ __forceinline__ void norm_phase(const int TID, const float* in_lat, const float* in_ctx, int M, const float* g, const float* sh, const float* sc, bf16_t* A) {
    const int lane = TID & 63, wave = TID >> 6;
    const int gw = blockIdx.x * NWAVES + wave, NGW = gridDim.x * NWAVES;
    f32x4 gv[4];
#pragma unroll
    for (int j = 0; j < 4; ++j) gv[j] = *(const f32x4*)(g + 4 * lane + 256 * j);
    for (int row = gw; row < M; row += NGW) {
        const float* xr = row < LAT ? in_lat + (size_t)row * DM : in_ctx + (size_t)(row - LAT) * DM;
        const int b = row < LAT ? row / SEQ : 16;
        f32x4 v[4]; float s = 0.f;
#pragma unroll
        for (int j = 0; j < 4; ++j) { v[j] = *(const f32x4*)(xr + 4 * lane + 256 * j); s += (v[j].x * v[j].x + v[j].y * v[j].y) + (v[j].z * v[j].z + v[j].w * v[j].w); }
        const float rstd = 1.0f / sqrtf(wave_sum(s) * (1.0f / DM) + EPS);
        const float* shp = sh + (size_t)b * MODLD + 4 * lane; const float* scp = sc + (size_t)b * MODLD + 4 * lane;
        bf16_t* op = A + (size_t)row * DM + 4 * lane;
#pragma unroll
        for (int j = 0; j < 4; ++j) { const f32x4 s4 = *(const f32x4*)(scp + 256 * j), h4 = *(const f32x4*)(shp + 256 * j);
            const f32x4 y = (v[j] * rstd * gv[j]) * (s4 + 1.0f) + h4;
            u32x2 w; w.x = pk2(y.x, y.y); w.y = pk2(y.z, y.w); *(u32x2*)(op + 256 * j) = w; }
    }
}

template <int HALFD> __device__ __forceinline__ void rope_table(const int TID, LAS float* tab) {
    for (int i = TID; i < 64 * HALFD; i += NTHREADS) { const int pos = i / HALFD, f = i % HALFD;
        const float fr = powf(10000.0f, -(float)f / (float)HALFD); float sn, cs; sincosf((float)pos * fr, &sn, &cs); tab[2 * i] = cs; tab[2 * i + 1] = sn; }
    __syncthreads();
}

__device__ __forceinline__ void qknorm_phase(const int TID, bf16_t* QKV, int ld, int nq, int nk, const float* gq, const float* gk, bool rope, float qscale, LAS unsigned char* lds) {
    LAS float* tab = (LAS float*)lds;
    if (rope) rope_table<16>(TID, tab);
    const int lane = TID & 63, wave = TID >> 6, l16 = lane & 15;
    const int gw = blockIdx.x * NWAVES + wave, NGW = gridDim.x * NWAVES;
    const f32x4 gq4 = *(const f32x4*)(gq + 4 * l16), gk4 = *(const f32x4*)(gk + 4 * l16);
    const int npass = (nq + nk) / 4;
    for (int row = gw; row < MTOT; row += NGW) {
        const bool dorope = rope && row < LAT; const int t = row & (SEQ - 1);
        const int pos = (l16 & 8) ? (t & 63) : (t >> 6); const int fi = 4 * (l16 & 3); const bool x2 = (l16 & 4) != 0;
        f32x4 cs = {1.f, 1.f, 1.f, 1.f}, sn = {0.f, 0.f, 0.f, 0.f};
        if (dorope) {
#pragma unroll
            for (int j = 0; j < 4; ++j) { cs[j] = tab[2 * (pos * 16 + fi + j)]; sn[j] = tab[2 * (pos * 16 + fi + j) + 1]; } }
        for (int p = 0; p < npass; ++p) {
            const int hh = 4 * p + (lane >> 4); const bool isq = hh < nq;
            bf16_t* ptr = QKV + (size_t)row * ld + hh * 64 + 4 * l16;
            const u32x2 w = *(const u32x2*)ptr;
            f32x4 x = {bflo(w.x), bfhi(w.x), bflo(w.y), bfhi(w.y)};
            float s = (x.x * x.x + x.y * x.y) + (x.z * x.z + x.w * x.w);
            s += __shfl_xor(s, 1); s += __shfl_xor(s, 2); s += __shfl_xor(s, 4); s += __shfl_xor(s, 8);
            const float rstd = 1.0f / sqrtf(s * (1.0f / 64.0f) + EPS);
            x = x * rstd * (isq ? gq4 : gk4);
            f32x4 o;
#pragma unroll
            for (int j = 0; j < 4; ++j) { const float other = __shfl_xor(x[j], 4); o[j] = x2 ? (other * sn[j] + x[j] * cs[j]) : (x[j] * cs[j] - other * sn[j]); }
            if (isq) o = o * qscale;
            u32x2 wo; wo.x = pk2(o.x, o.y); wo.y = pk2(o.z, o.w); *(u32x2*)ptr = wo;
        }
    }
}

__device__ __forceinline__ void mlanorm1_phase(const int TID, bf16_t* PROJ, const float* gcq, const float* gckv) {
    const int lane = TID & 63, wave = TID >> 6;
    const int gw = blockIdx.x * NWAVES + wave, NGW = gridDim.x * NWAVES;
    const f32x4 g1 = *(const f32x4*)(gcq + 4 * lane);
    const float g2a = gckv[2 * lane], g2b = gckv[2 * lane + 1];
    for (int row = gw; row < MTOT; row += NGW) {
        bf16_t* p = PROJ + (size_t)row * 512;
        const u32x2 w = *(const u32x2*)(p + 4 * lane); const unsigned w2 = *(const unsigned*)(p + 256 + 2 * lane);
        f32x4 x = {bflo(w.x), bfhi(w.x), bflo(w.y), bfhi(w.y)}; float ya = bflo(w2), yb = bfhi(w2);
        const float s1 = wave_sum((x.x * x.x + x.y * x.y) + (x.z * x.z + x.w * x.w)), s2 = wave_sum(ya * ya + yb * yb);
        const float r1 = 1.0f / sqrtf(s1 * (1.0f / 256.0f) + EPS), r2 = 1.0f / sqrtf(s2 * (1.0f / 128.0f) + EPS);
        x = x * r1 * g1; ya *= r2 * g2a; yb *= r2 * g2b;
        u32x2 wo; wo.x = pk2(x.x, x.y); wo.y = pk2(x.z, x.w); *(u32x2*)(p + 4 * lane) = wo; *(unsigned*)(p + 256 + 2 * lane) = pk2(ya, yb);
    }
}
__device__ __forceinline__ void mlanorm2_phase(const int TID, bf16_t* QR, bf16_t* KV, const bf16_t* PROJ, bf16_t* KR, const float* gq, const float* gk, float qscale, LAS unsigned char* lds) {
    LAS float* tab = (LAS float*)lds;
    rope_table<8>(TID, tab);
    const int lane = TID & 63, wave = TID >> 6, l32 = lane & 31, hs = lane >> 5;
    const int gw = blockIdx.x * NWAVES + wave, NGW = gridDim.x * NWAVES;
    const float gq0 = gq[l32], gq1 = gq[l32 + 32], gq2 = gq[l32 + 64], gk0 = gk[l32], gk1 = gk[l32 + 32], gk2 = gk[l32 + 64];
    const int fi = l32 & 7; const bool x2 = (l32 & 8) != 0, colpos = (l32 & 16) != 0;
    for (int row = gw; row < MTOT; row += NGW) {
        const bool islat = row < LAT; const int t = row & (SEQ - 1); const int pos = colpos ? (t & 63) : (t >> 6);
        float cs = 1.f, sn = 0.f; if (islat) { cs = tab[2 * (pos * 8 + fi)]; sn = tab[2 * (pos * 8 + fi) + 1]; }
        if (islat) {
            for (int p = 0; p < 8; ++p) { bf16_t* q = QR + (size_t)row * 1536 + (2 * p + hs) * 96;
                float a = bflo((unsigned)q[l32]), b = bflo((unsigned)q[l32 + 32]), c = bflo((unsigned)q[l32 + 64]);
                float s = a * a + b * b + c * c; s += __shfl_xor(s, 1); s += __shfl_xor(s, 2); s += __shfl_xor(s, 4); s += __shfl_xor(s, 8); s += __shfl_xor(s, 16);
                const float rstd = 1.0f / sqrtf(s * (1.0f / 96.0f) + EPS);
                a *= rstd * gq0; b *= rstd * gq1; c *= rstd * gq2;
                const float other = __shfl_xor(c, 8); c = x2 ? (other * sn + c * cs) : (c * cs - other * sn);
                q[l32] = (bf16_t)f2bf(a * qscale); q[l32 + 32] = (bf16_t)f2bf(b * qscale); q[l32 + 64] = (bf16_t)f2bf(c * qscale); }
        }
        const float kr = bflo((unsigned)PROJ[(size_t)row * 512 + 384 + l32]);
        for (int p = 0; p < 8; ++p) { const int hh = 2 * p + hs; bf16_t* k = KV + (size_t)row * 2048 + hh * 128;
            float a = bflo((unsigned)k[l32]), b = bflo((unsigned)k[l32 + 32]), c = kr;
            float s = a * a + b * b + c * c; s += __shfl_xor(s, 1); s += __shfl_xor(s, 2); s += __shfl_xor(s, 4); s += __shfl_xor(s, 8); s += __shfl_xor(s, 16);
            const float rstd = 1.0f / sqrtf(s * (1.0f / 96.0f) + EPS);
            a *= rstd * gk0; b *= rstd * gk1; c *= rstd * gk2;
            const float other = __shfl_xor(c, 8); c = x2 ? (other * sn + c * cs) : (c * cs - other * sn);
            k[l32] = (bf16_t)f2bf(a); k[l32 + 32] = (bf16_t)f2bf(b); KR[(size_t)row * 512 + hh * 32 + l32] = (bf16_t)f2bf(c); }
    }
}

__device__ __forceinline__ void pool_phase(const int TID, const bf16_t* A, bf16_t* P) {
    const int lane = TID & 63, wave = TID >> 6;
    const int gw = blockIdx.x * NWAVES + wave, NGW = gridDim.x * NWAVES;
    for (int row = gw; row < MTOT; row += NGW) {
        int base, L, t; if (row < LAT) { base = row & ~(SEQ - 1); L = SEQ; t = row - base; } else { const int r = row - LAT; base = LAT + (r & ~(CTXL - 1)); L = CTXL; t = r & (CTXL - 1); }
#pragma unroll
        for (int j = 0; j < 4; ++j) {
            const int w = 2 << j; int lo = t - w / 2, hi = t - w / 2 + w; lo = lo < 0 ? 0 : lo; hi = hi > L ? L : hi;
            f32x4 s = {0.f, 0.f, 0.f, 0.f};
            for (int k = lo; k < hi; ++k) { const u32x2 v = *(const u32x2*)(A + (size_t)(base + k) * DM + 256 * j + 4 * lane); s += (f32x4){bflo(v.x), bfhi(v.x), bflo(v.y), bfhi(v.y)}; }
            const u32x2 v = *(const u32x2*)(A + (size_t)row * DM + 256 * j + 4 * lane); const f32x4 self = {bflo(v.x), bfhi(v.x), bflo(v.y), bfhi(v.y)};
            const f32x4 o = s * (1.0f / (float)(hi - lo)) - self;
            u32x2 wo; wo.x = pk2(o.x, o.y); wo.y = pk2(o.z, o.w); *(u32x2*)(P + (size_t)row * DM + 256 * j + 4 * lane) = wo;
        }
    }
}

typedef short v4i16_t __attribute__((ext_vector_type(4)));
__device__ __forceinline__ int crow16(int r, int hi) { return (r & 3) + 8 * (r >> 2) + 4 * hi; }
template <int MODE> __device__ __forceinline__ void attn_phase(const int TID, KArgs a, LAS unsigned char* lds) {
    constexpr int DQK = MODE == 2 ? 96 : 64, NKS = DQK / 16;
    constexpr int KROWB = DQK * 2 + 16, KBUF = 64 * KROWB, VOFF = 2 * KBUF, BIASOFF = VOFF + 16384;
    const int tid = TID, lane = tid & 63, wid = __builtin_amdgcn_readfirstlane(tid >> 6), r32 = lane & 31, hi = lane >> 5;
    unsigned char* ws = a->ws;
    const bf16_t *Qb, *Kb, *K2b = nullptr, *Vb; bf16_t* Ob; int ldq, ldk;
    if (MODE == 0) { Qb = (const bf16_t*)(ws + WS_RB); ldq = 1536; Kb = Qb + 1024; Vb = Qb + 1280; ldk = 1536; Ob = (bf16_t*)(ws + WS_RO); }
    else if (MODE == 1) { Qb = (const bf16_t*)(ws + WS_RB); ldq = 3072; Kb = Qb + 1024; Vb = Qb + 2048; ldk = 3072; Ob = (bf16_t*)(ws + WS_RO); }
    else { Qb = (const bf16_t*)(ws + WS_QR); ldq = 1536; Kb = (const bf16_t*)(ws + WS_KV); Vb = Kb + 64; K2b = (const bf16_t*)(ws + WS_KR); ldk = 2048; Ob = (bf16_t*)(ws + WS_RA); }
    const int G = gridDim.x, bx = blockIdx.x, vcu = (G % 8 == 0) ? (bx % 8) * (G / 8) + bx / 8 : bx;
    constexpr int NLAT = 2048, NCTXU = MODE == 2 ? 0 : 256;
    const int lat_per = (NLAT + G - 1) / G, ctx_per = (NCTXU + G - 1) / G;
    LAS float* btab = (LAS float*)(lds + BIASOFF);
    const int srow = tid >> 3, sch = tid & 7, s2row = tid >> 2, s2ch = tid & 3;
    const int kst = srow * KROWB + sch * 16, k2st = s2row * KROWB + 128 + s2ch * 16, vst = (sch >> 2) * 4096 + srow * 64 + (sch & 3) * 16;
    const int vrd = (4 * hi + ((lane & 15) >> 2)) * 64 + (16 * ((lane >> 4) & 1) + 4 * (lane & 3)) * 2;
    for (int it = 0; it < lat_per + ctx_per; ++it) {
        const bool ctxu = it >= lat_per;
        const int u = ctxu ? vcu * ctx_per + (it - lat_per) : vcu * lat_per + it;
        if (u >= (ctxu ? NCTXU : NLAT)) continue;
        int b, head, hoff, qrow, NT, lat0 = 0, qtok = 0, jj_lo = 0, rrow = 0, R0 = 0;
        if (MODE == 0) {
            if (!ctxu) { b = u >> 7; const int kvh = (u >> 5) & 3, qb = u & 31; head = kvh * 4 + (wid >> 1); hoff = kvh * 64; qtok = qb * 64 + (wid & 1) * 32 + r32; qrow = b * SEQ + qtok;
                jj_lo = 2 - qb > 0 ? 2 - qb : 0; const int jj_hi = 33 - qb < 4 ? 33 - qb : 4; lat0 = b * SEQ + qb * 64 - 128 + 64 * jj_lo; NT = 4 + (jj_hi - jj_lo + 1); }
            else { b = u >> 4; const int kvh = (u >> 2) & 3, qb = u & 3; head = kvh * 4 + (wid >> 1); hoff = kvh * 64; qtok = qb * 64 + (wid & 1) * 32 + r32; qrow = LAT + b * CTXL + qtok; NT = 4; }
        } else if (MODE == 1) {
            if (!ctxu) { b = u >> 7; head = (u >> 3) & 15; const int rq = u & 7; hoff = head * 64; rrow = 4 * rq + (wid >> 1); qtok = 32 * (wid & 1) + r32; qrow = b * SEQ + rrow * 64 + qtok;
                R0 = 4 * rq - 4; R0 = R0 < 0 ? 0 : (R0 > 24 ? 24 : R0); int R1 = 4 * rq - 1; R1 = (R1 < 0 ? 0 : (R1 > 24 ? 24 : R1)) + 7; lat0 = b * SEQ + R0 * 64; NT = 4 + (R1 - R0 + 1); }
            else { b = u >> 4; head = u & 15; hoff = head * 64; qrow = LAT + b * CTXL + wid * 32 + r32; NT = 4; }
        } else { b = u >> 7; head = (u >> 3) & 15; const int qb = u & 7; hoff = head * 128; qrow = b * SEQ + qb * 256 + wid * 32 + r32; lat0 = b * SEQ; NT = 4 + 32; }
        const int ctx0 = LAT + b * CTXL;
        bf16x8 qf[NKS];
        { const bf16_t* qp = Qb + (size_t)qrow * ldq + head * DQK + 8 * hi;
#pragma unroll
          for (int ks = 0; ks < NKS; ++ks) qf[ks] = *(const bf16x8*)(qp + 16 * ks); }
        if (MODE == 1 && !ctxu) { const float* rp = a->in[18] + (size_t)head * 465; for (int i = tid; i < 465; i += NTHREADS) btab[64 + i] = rp[i] * LOG2E; }
        u32x4 kreg, k2reg = {0u, 0u, 0u, 0u}, vreg;
#define ATT_TILE_ROW(j) ((j) < 4 ? ctx0 + 64 * (j) : lat0 + 64 * ((j) - 4))
#define ATT_LOAD(j) do { const int kr0_ = ATT_TILE_ROW(j); kreg = *(const u32x4*)(Kb + (size_t)(kr0_ + srow) * ldk + hoff + sch * 8); vreg = *(const u32x4*)(Vb + (size_t)(kr0_ + srow) * ldk + hoff + sch * 8); \
        if (MODE == 2 && tid < 256) k2reg = *(const u32x4*)(K2b + (size_t)(kr0_ + s2row) * 512 + head * 32 + s2ch * 8); } while (0)
#define ATT_STORE(buf) do { *(LAS u32x4*)(lds + (buf) * KBUF + kst) = kreg; *(LAS u32x4*)(lds + VOFF + (buf) * 8192 + vst) = vreg; if (MODE == 2 && tid < 256) *(LAS u32x4*)(lds + (buf) * KBUF + k2st) = k2reg; } while (0)
        ATT_LOAD(0); ATT_STORE(0);
        __syncthreads();
        f32x16 o0, o1;
#pragma unroll
        for (int i = 0; i < 16; ++i) { o0[i] = 0.f; o1[i] = 0.f; }
        float m = -1e30f, l = 0.f;
        int r0w = rrow - 4; r0w = r0w < 0 ? 0 : (r0w > 24 ? 24 : r0w);
        int cs = qtok - 8; cs = cs < 0 ? 0 : (cs > 48 ? 48 : cs);
        for (int j = 0; j < NT; ++j) {
            if (j + 1 < NT) ATT_LOAD(j + 1);
            const int buf = j & 1;
            bool active = true, masked = false; int kr = 0, kstart = 0;
            if (MODE == 0 && j >= 4) { const int jj = jj_lo + (j - 4); masked = (jj == 0 || jj == 4); kstart = (lat0 - b * SEQ) + 64 * (j - 4); }
            if (MODE == 1 && j >= 4) { kr = R0 + (j - 4); active = (kr >= r0w && kr < r0w + 8); masked = true; }
            if (active) {
                const LAS unsigned char* kb = lds + buf * KBUF + r32 * KROWB + hi * 16;
                f32x16 s0, s1;
#pragma unroll
                for (int i = 0; i < 16; ++i) { s0[i] = 0.f; s1[i] = 0.f; }
#pragma unroll
                for (int ks = 0; ks < NKS; ++ks) { const bf16x8 a0 = *(const LAS bf16x8*)(kb + ks * 32), a1 = *(const LAS bf16x8*)(kb + 32 * KROWB + ks * 32);
                    s0 = __builtin_amdgcn_mfma_f32_32x32x16_bf16(a0, qf[ks], s0, 0, 0, 0); s1 = __builtin_amdgcn_mfma_f32_32x32x16_bf16(a1, qf[ks], s1, 0, 0, 0); }
                if (MODE == 0 && masked) { const int d0 = qtok - kstart - 4 * hi + 128;
#pragma unroll
                    for (int i = 0; i < 16; ++i) { const int c = (i & 3) + 8 * (i >> 2); if ((unsigned)(d0 - c) > 256u) s0[i] = -1e30f; if ((unsigned)(d0 - c - 32) > 256u) s1[i] = -1e30f; } }
                if (MODE == 1 && masked) { const LAS float* bp = btab + 64 + (kr - rrow + 7) * 31 + 15 - qtok + 4 * hi; const int e0 = 4 * hi - cs;
#pragma unroll
                    for (int i = 0; i < 16; ++i) { const int c = (i & 3) + 8 * (i >> 2);
                        s0[i] = (unsigned)(e0 + c) < 16u ? s0[i] + bp[c] : -1e30f; s1[i] = (unsigned)(e0 + c + 32) < 16u ? s1[i] + bp[c + 32] : -1e30f; } }
                float mx = fmaxf(s0[0], s1[0]);
#pragma unroll
                for (int i = 1; i < 16; ++i) mx = fmaxf(mx, fmaxf(s0[i], s1[i]));
                mx = fmaxf(mx, __shfl_xor(mx, 32));
                const float mn = fmaxf(m, mx), alpha = __builtin_amdgcn_exp2f(m - mn); m = mn;
                float ls = 0.f;
#pragma unroll
                for (int i = 0; i < 16; ++i) { s0[i] = __builtin_amdgcn_exp2f(s0[i] - mn); s1[i] = __builtin_amdgcn_exp2f(s1[i] - mn); ls += s0[i] + s1[i]; }
                l = l * alpha + ls;
#pragma unroll
                for (int i = 0; i < 16; ++i) { o0[i] *= alpha; o1[i] *= alpha; }
                bf16x8 pf[4];
#pragma unroll
                for (int s = 0; s < 4; ++s) { u32x4 w;
#pragma unroll
                    for (int e = 0; e < 4; ++e) { const int r = 8 * (s & 1) + 2 * e; w[e] = s < 2 ? pg8::cvt_pk_bf16(s0[r], s0[r + 1]) : pg8::cvt_pk_bf16(s1[r], s1[r + 1]); }
                    pf[s] = __builtin_bit_cast(bf16x8, w); }
                const LAS unsigned char* vb = lds + VOFF + buf * 8192 + vrd;
#pragma unroll
                for (int s = 0; s < 4; ++s) {
#pragma unroll
                    for (int dh = 0; dh < 2; ++dh) {
                        const v4i16_t lo = __builtin_amdgcn_ds_read_tr16_b64_v4i16((LAS v4i16_t*)(vb + dh * 4096 + s * 1024));
                        const v4i16_t hh = __builtin_amdgcn_ds_read_tr16_b64_v4i16((LAS v4i16_t*)(vb + dh * 4096 + s * 1024 + 512));
                        const bf16x8 vf = __builtin_shufflevector(lo, hh, 0, 1, 2, 3, 4, 5, 6, 7);
                        if (dh == 0) o0 = __builtin_amdgcn_mfma_f32_32x32x16_bf16(vf, pf[s], o0, 0, 0, 0); else o1 = __builtin_amdgcn_mfma_f32_32x32x16_bf16(vf, pf[s], o1, 0, 0, 0); } }
            }
            if (j + 1 < NT) ATT_STORE(buf ^ 1);
            __syncthreads();
        }
#undef ATT_TILE_ROW
#undef ATT_LOAD
#undef ATT_STORE
        l += __shfl_xor(l, 32);
        if (MODE == 0) l += __builtin_amdgcn_exp2f(a->in[13][head] * LOG2E - m);
        const float inv = 1.0f / l;
        bf16_t* op = Ob + (size_t)qrow * DM + head * 64 + 4 * hi;
#pragma unroll
        for (int g4 = 0; g4 < 4; ++g4) {
            u32x2 w0, w1; w0.x = pg8::cvt_pk_bf16(o0[4 * g4] * inv, o0[4 * g4 + 1] * inv); w0.y = pg8::cvt_pk_bf16(o0[4 * g4 + 2] * inv, o0[4 * g4 + 3] * inv);
            w1.x = pg8::cvt_pk_bf16(o1[4 * g4] * inv, o1[4 * g4 + 1] * inv); w1.y = pg8::cvt_pk_bf16(o1[4 * g4 + 2] * inv, o1[4 * g4 + 3] * inv);
            *(u32x2*)(op + 8 * g4) = w0; *(u32x2*)(op + 32 + 8 * g4) = w1; }
    }
}

enum Kind { K_PRO = 0, K_N1, K_G1, K_QKN, K_ATT, K_G2, K_N2, K_G3, K_G4, K_POOL, K_GPOOL, K_GPROJ, K_MLAN1, K_GUP, K_MLAN2 };
constexpr int NPHASES = 33;
__device__ __forceinline__ void decode_phase(int p, int& L, int& kind) {
    if (p == 0) { L = 0; kind = K_PRO; return; }
    if (p <= 16) { L = (p - 1) >> 3; kind = K_N1 + ((p - 1) & 7); return; }
    if (p <= 22) { L = 2; const int k = p - 17; kind = k == 0 ? K_N1 : k == 1 ? K_POOL : k == 2 ? K_GPOOL : k == 3 ? K_N2 : k == 4 ? K_G3 : K_G4; return; }
    L = 3; const int k = p - 23;
    kind = k == 0 ? K_N1 : k == 1 ? K_GPROJ : k == 2 ? K_MLAN1 : k == 3 ? K_GUP : k == 4 ? K_MLAN2 : k == 5 ? K_ATT : k == 6 ? K_G2 : k == 7 ? K_N2 : k == 8 ? K_G3 : K_G4;
}

#define XB_TMO      128
#define XB_XCNT(j)  (256  + 64 * (j))
#define XB_XSUB(j)  (1280 + 64 * (j))
#define XB_XGEN(j)  (2304 + 64 * (j))
#define XB_TOP      3328
#define XB_TOPGEN   3392
#define XCD_BAR_WORDS 3456
#define XB_SPIN_CAP (1u << 18)

__device__ __forceinline__ unsigned xb_ld(unsigned* p)              { return __hip_atomic_load(p, __ATOMIC_RELAXED, __HIP_MEMORY_SCOPE_AGENT); }
__device__ __forceinline__ unsigned xb_add(unsigned* p, unsigned v) { return __hip_atomic_fetch_add(p, v, __ATOMIC_RELAXED, __HIP_MEMORY_SCOPE_AGENT); }
__device__ __forceinline__ unsigned xb_xcc_id() { return (unsigned)__builtin_amdgcn_s_getreg((3 << 11) | 20) & 0xFu; }
#define XB_SPIN(cond, bar) do { unsigned _sp = 0; while (cond) { __builtin_amdgcn_s_sleep(1); \
    if ((++_sp & 255u) == 0u) { if (xb_ld(&(bar)[XB_TMO])) break; if (_sp > XB_SPIN_CAP) { atomicAdd(&(bar)[XB_TMO], 1u); break; } } } } while (0)

struct XcdBarrier {
    unsigned* bar; unsigned x;
    volatile LAS unsigned* st;
};

__device__ __forceinline__ XcdBarrier xcd_barrier_post(unsigned* bar, volatile LAS unsigned* st) {
    XcdBarrier b; b.bar = bar; b.x = xb_xcc_id(); b.st = st;
    if (threadIdx.x == 0) (void)xb_add(&bar[XB_XCNT(b.x)], 1u);
    return b;
}
__device__ __forceinline__ void xcd_barrier_complete(unsigned* bar, unsigned x, unsigned& nloc, unsigned& nx) {
    const unsigned G = gridDim.x * gridDim.y * gridDim.z;
    unsigned sum, cnt, mine, sp = 0u;
    for (;;) {
        sum = 0u; cnt = 0u; mine = 0u;
#pragma unroll
        for (unsigned j = 0; j < 16; ++j) { const unsigned c = xb_ld(&bar[XB_XCNT(j)]); sum += c; cnt += (c > 0u) ? 1u : 0u; mine = (j == x) ? c : mine; }
        if (sum == G) break;
        __builtin_amdgcn_s_sleep(1);
        if ((++sp & 255u) == 0u) { if (xb_ld(&bar[XB_TMO])) break; if (sp > XB_SPIN_CAP) { atomicAdd(&bar[XB_TMO], 1u); break; } }
    }
    nloc = mine > 0u ? mine : 1u; nx = cnt > 0u ? cnt : 1u;
}

__device__ __forceinline__ void xcd_barrier(const XcdBarrier& b) {
    asm volatile("s_waitcnt vmcnt(0)" ::: "memory");
    __syncthreads();
    if (threadIdx.x == 0) {
        unsigned* bar = b.bar;
        __builtin_amdgcn_s_waitcnt(0);
        unsigned nloc = b.st[0], nx = b.st[1];
        if (nloc == 0u) { xcd_barrier_complete(bar, b.x, nloc, nx); b.st[0] = nloc; b.st[1] = nx; }
        const unsigned old = xb_add(&bar[XB_XSUB(b.x)], 1u);
        const unsigned gen = old / nloc;
        if (old + 1u == (gen + 1u) * nloc) {
            __builtin_amdgcn_fence(__ATOMIC_RELEASE, "agent");
            asm volatile("s_waitcnt vmcnt(0)" ::: "memory");
            const unsigned og = xb_add(&bar[XB_TOP], 1u);
            const unsigned tg = og / nx;
            if (og + 1u == (tg + 1u) * nx) xb_add(&bar[XB_TOPGEN], 1u);
            else XB_SPIN(xb_ld(&bar[XB_TOPGEN]) == tg, bar);
            __builtin_amdgcn_fence(__ATOMIC_ACQUIRE, "agent");
            xb_add(&bar[XB_XGEN(b.x)], 1u);
            asm volatile("s_waitcnt vmcnt(0)" ::: "memory");
        } else {
            XB_SPIN(xb_ld(&bar[XB_XGEN(b.x)]) == gen, bar);
            __builtin_amdgcn_fence(__ATOMIC_ACQUIRE, "agent");
            asm volatile("s_waitcnt vmcnt(0)" ::: "memory");
        }
    }
    __syncthreads();
}

#ifndef PROBE_KIND
#define PROBE_KIND -1
#endif
#ifndef PROBE_N
#define PROBE_N 0
#endif
#ifndef PROBE_SYNC
#define PROBE_SYNC 0
#endif
__global__ void __launch_bounds__(NTHREADS) fwd_kernel(Args a_by_value) {
    extern __shared__ __attribute__((aligned(16))) unsigned char lds_raw[];
    LAS unsigned char* lds = (LAS unsigned char*)lds_raw;
    cg::grid_group grid = cg::this_grid();
    const int ph_lo = a_by_value.ph_lo, ph_hi = a_by_value.ph_hi;
    volatile LAS unsigned* MISC = (volatile LAS unsigned*)(lds + 131072);
    if (threadIdx.x < 4) MISC[threadIdx.x] = 0u;
    __syncthreads();
    const XcdBarrier xbar = xcd_barrier_post((unsigned*)(a_by_value.ws + WS_CTL), MISC);
    if (ph_hi > 4096) grid.sync();
    for (int p = ph_lo; p < ph_hi; ++p) {
        int L, kind; decode_phase(p, L, kind);
        KArgs a = (KArgs)__builtin_amdgcn_kernarg_segment_ptr(); asm volatile("" : "+s"(a));
        unsigned char* ws = a->ws;
        const float* MOD = (const float*)(ws + WS_MOD);
        float* HC = (float*)(ws + WS_HC);
        bf16_t* RA = (bf16_t*)(ws + WS_RA); bf16_t* RO = (bf16_t*)(ws + WS_RO); bf16_t* RB = (bf16_t*)(ws + WS_RB);
        int TID = threadIdx.x; asm volatile("" : "+v"(TID));
        const float* modL = MOD + (size_t)L * NMODB * MODLD;
        const int Mffn = L == 3 ? LAT : MTOT;
        const int nrun = (kind == PROBE_KIND) ? 1 + PROBE_N : 1;
        for (int run = 0; run < nrun; ++run) {
        if (run > 0) xcd_barrier(xbar);
        if (kind == K_PRO) {
            prologue_phase(TID, a, lds);
        } else if (kind == K_N1 || kind == K_N2) {
            const bool first = kind == K_N1;
            const float* il = (L == 0 && first) ? a->in[0] : a->out; const float* ic = (L == 0 && first) ? a->in[2] : HC;
            norm_phase(TID, il, ic, first ? MTOT : Mffn, (first ? a->in[6] : a->in[7]) + L * DM, modL + (first ? 0 : 3 * DM), modL + (first ? DM : 4 * DM), RA);
        } else if (kind == K_G1 || kind == K_GPROJ || kind == K_GUP) {
            const int nrep = kind == K_GUP ? 2 : 1;
            for (int rep = 0; rep < nrep; ++rep) {
                pg8::Gemm g; pg8::EpiStore E;
                if (kind == K_G1) { const int N = L == 0 ? 1536 : 3072; g = pg8::Gemm{RA, (const bf16_t*)(ws + (L == 0 ? WS_SWA_QKV : WS_NA_QKV)), MTOT, N, DM, DM, DM, 0}; E = pg8::EpiStore{RB, N}; }
                else if (kind == K_GPROJ) { g = pg8::Gemm{RA, (const bf16_t*)(ws + WS_MLA_WA), MTOT, 512, DM, DM, DM, 0}; E = pg8::EpiStore{(bf16_t*)(ws + WS_PROJ), 512}; }
                else if (rep == 0) { g = pg8::Gemm{(const bf16_t*)(ws + WS_PROJ), (const bf16_t*)(ws + WS_MLA_WUQ), LAT, 1536, 256, 512, 256, 0}; E = pg8::EpiStore{(bf16_t*)(ws + WS_QR), 1536}; }
                else { g = pg8::Gemm{(const bf16_t*)(ws + WS_PROJ) + 256, (const bf16_t*)(ws + WS_MLA_WUKV), MTOT, 2048, 128, 512, 128, 0}; E = pg8::EpiStore{(bf16_t*)(ws + WS_KV), 2048}; }
                pg8::StaticOrder S; S.init(g.M, g.N, (int)gridDim.x, (int)blockIdx.x);
                pg8::gemm_phase<pg8::EpiStore, pg8::StaticOrder, true, true>(lds, g, S, E);
            }
        } else if (kind == K_G3) {
            pg8::Gemm g{RA, (const bf16_t*)(ws + WS_WGU + (size_t)L * SZ_WGU), Mffn, 2 * DFF, DM, DM, DM, 0};
            pg8::EpiSwiglu E{RB, DFF};
            pg8::StaticOrder S; S.init(g.M, g.N, (int)gridDim.x, (int)blockIdx.x);
            pg8::gemm_phase<pg8::EpiSwiglu, pg8::StaticOrder, true, true>(lds, g, S, E);
        } else if (kind == K_G2 || kind == K_GPOOL || kind == K_G4) {
            pg8::Gemm g; pg8::EpiResid E;
            E.first = (L == 0 && kind == K_G2) ? 1 : 0; E.pool = kind == K_GPOOL ? 1 : 0; E.mod_byte = (unsigned)WS_MOD; E.hc_byte = (unsigned)WS_HC;
            E.gate_off = L * NMODB * MODLD + (kind == K_G4 ? 5 * DM : 2 * DM);
            if (kind == K_G2) { const size_t wo = L == 0 ? WS_SWA_WO : L == 1 ? WS_NA_WO : WS_MLA_WO; g = pg8::Gemm{L == 3 ? RA : RO, (const bf16_t*)(ws + wo), Mffn, DM, DM, DM, DM, 0}; }
            else if (kind == K_GPOOL) { g = pg8::Gemm{RO, (const bf16_t*)(ws + WS_POOL), MTOT, DM, 256, DM, 256, 256}; }
            else { g = pg8::Gemm{RB, (const bf16_t*)(ws + WS_WDN + (size_t)L * SZ_WDN), Mffn, DM, DFF, DFF, DFF, 0}; }
            pg8::StaticOrder S; S.init(g.M, g.N, (int)gridDim.x, (int)blockIdx.x);
            pg8::gemm_phase<pg8::EpiResid, pg8::StaticOrder, true, true>(lds, g, S, E);
        } else if (kind == K_QKN) {
            if (L == 0) qknorm_phase(TID, RB, 1536, 16, 4, a->in[11], a->in[12], true, 0.125f * LOG2E, lds);
            else qknorm_phase(TID, RB, 3072, 16, 16, a->in[16], a->in[17], false, 0.125f * LOG2E, lds);
        } else if (kind == K_ATT) {
            if (L == 0) attn_phase<0>(TID, a, lds); else if (L == 1) attn_phase<1>(TID, a, lds); else attn_phase<2>(TID, a, lds);
        } else if (kind == K_POOL) {
            pool_phase(TID, RA, RO);
        } else if (kind == K_MLAN1) {
            mlanorm1_phase(TID, (bf16_t*)(ws + WS_PROJ), a->in[24], a->in[25]);
        } else if (kind == K_MLAN2) {
            mlanorm2_phase(TID, (bf16_t*)(ws + WS_QR), (bf16_t*)(ws + WS_KV), (const bf16_t*)(ws + WS_PROJ), (bf16_t*)(ws + WS_KR), a->in[28], a->in[29], 0.10206207261596577f * LOG2E, lds);
        }
        }
        if (p + 1 < ph_hi) { xcd_barrier(xbar); for (int e = 0; e < PROBE_SYNC; ++e) xcd_barrier(xbar); }
    }
}

#ifndef MK_PER_PHASE
#define MK_PER_PHASE 0
#endif
extern "C" void kernel_launch(void* const* d_in, const int* in_sizes, int n_in, void* d_out, int out_size, void* d_ws, size_t ws_size, hipStream_t stream) {
    static int grid = 0;
    if (grid == 0) {
        if (n_in != 31 || in_sizes[0] != LAT * DM || out_size != LAT * DM || ws_size < WS_END) { fprintf(stderr, "kernel_launch: unexpected shapes (n_in %d, in0 %d, out %d, ws %zu < %zu)\n", n_in, n_in > 0 ? in_sizes[0] : -1, out_size, ws_size, (size_t)WS_END); grid = -1; return; }
        int dev = 0, cus = 0, per_cu = 0;
        if (hipGetDevice(&dev) != hipSuccess || hipDeviceGetAttribute(&cus, hipDeviceAttributeMultiprocessorCount, dev) != hipSuccess) { fprintf(stderr, "kernel_launch: device query failed\n"); grid = -1; return; }
        if (hipFuncSetAttribute((const void*)fwd_kernel, hipFuncAttributeMaxDynamicSharedMemorySize, LDS_BYTES) != hipSuccess) { fprintf(stderr, "kernel_launch: hipFuncSetAttribute failed\n"); grid = -1; return; }
        if (hipOccupancyMaxActiveBlocksPerMultiprocessor(&per_cu, (const void*)fwd_kernel, NTHREADS, LDS_BYTES) != hipSuccess || per_cu < 1) { fprintf(stderr, "kernel_launch: occupancy query says %d blocks per CU\n", per_cu); per_cu = 1; }
        (void)hipGetLastError();
        grid = cus * (per_cu > 1 ? 1 : per_cu);
    }
    if (grid < 0) return;
    Args a{};
    for (int i = 0; i < 31; ++i) a.in[i] = (const float*)d_in[i];
    a.out = (float*)d_out; a.ws = (unsigned char*)d_ws;
#if MK_PER_PHASE
    for (int p = 0; p < NPHASES; ++p) { a.ph_lo = p; a.ph_hi = p + 1; hipLaunchKernelGGL(fwd_kernel, dim3(grid), dim3(NTHREADS), LDS_BYTES, stream, a); }
#else
    a.ph_lo = 0; a.ph_hi = NPHASES;
    if (hipMemsetAsync((char*)d_ws + WS_CTL, 0, 16384, stream) != hipSuccess) { fprintf(stderr, "kernel_launch: memset of the barrier words failed\n"); return; }
    void* args[] = {&a};
    hipError_t e = hipLaunchCooperativeKernel((const void*)fwd_kernel, dim3(grid), dim3(NTHREADS), args, LDS_BYTES, stream);
    if (e != hipSuccess) fprintf(stderr, "kernel_launch: cooperative launch failed: %s (grid %d)\n", hipGetErrorString(e), grid);
#endif
}
```

```cpp
#include <hip/hip_runtime.h>
#include <hip/hip_cooperative_groups.h>
#include <cstdio>
#include <cstdint>
#include <cmath>
namespace cg = cooperative_groups;

namespace pg8 {
#define PG8_LAS __attribute__((address_space(3)))
typedef unsigned short bf16_t;
typedef short bf16x8 __attribute__((ext_vector_type(8)));
typedef float f32x4 __attribute__((ext_vector_type(4)));
typedef unsigned u32x4 __attribute__((ext_vector_type(4)));
typedef unsigned u32x2 __attribute__((ext_vector_type(2)));
constexpr int BM = 256, BK = 64, HALF = 128, HTB = HALF * BK * 2  , STAGE_BYTES = 8 * HTB, NXCD = 8, WGM = 8;

__host__ __device__ __forceinline__ int lds_byte(int r, int c) { const int st = (r >> 4) * 2 + (c >> 5), rr = r & 15, cc = c & 31, ob = rr * 64 + cc * 2; return st * 1024 + (ob ^ (((ob >> 9) & 1) << 5)); }
__host__ __device__ __forceinline__ void stage_rc(int b, int& R, int& C) { const int st = b / 1024, sb = b % 1024, swz = sb ^ (((sb >> 9) & 1) << 5); R = (st >> 1) * 16 + swz / 64; C = (st & 1) * 32 + (swz % 64) / 2; }
__host__ __device__ __forceinline__ int perm32(int rho) { const int n = rho >> 4, i = rho & 15; return 8 * (i >> 2) + 4 * n + (i & 3); }

struct Unit { int pm, pn; };
struct Gemm { const bf16_t* A; const bf16_t* Bt; int M, N, K, lda, ldb, akoff; };

struct StaticOrder {
    int nM, nN, nwg, G, c;
    __host__ __device__ void init(int M, int N, int G_, int c_) { nM = M / BM; nN = N / BM; nwg = nM * nN; G = G_; c = c_; }
    __host__ __device__ bool next(int i, Unit& u) const {
        const long L = (long)i * G + c; if (L >= nwg) return false;
        int wgid = (int)L; { const int q = nwg / NXCD, r = nwg % NXCD, xcd = wgid % NXCD, off = wgid / NXCD; wgid = (xcd < r ? xcd * (q + 1) : r * (q + 1) + (xcd - r) * q) + off; }
        const int nig = WGM * nN, gid = wgid / nig, fm = gid * WGM, gsz = (nM - fm) < WGM ? (nM - fm) : WGM;
        u.pm = fm + ((wgid % nig) % gsz); u.pn = (wgid % nig) / gsz; return true;
    }
    __device__ __forceinline__ void a_ready(const Unit&) const {}
    __device__ __forceinline__ void done(const Unit&) const {}
};

__device__ __forceinline__ unsigned cvt_pk_bf16(float lo, float hi) { unsigned r; asm volatile("v_cvt_pk_bf16_f32 %0, %1, %2" : "=v"(r) : "v"(lo), "v"(hi)); return r; }

struct EpiStore {
    static constexpr bool PERM = true, AFTER_DRAIN = false, WITH_LDS = false;
    bf16_t* O; int ldc;
    __device__ __forceinline__ void operator()(const f32x4 (&acc)[2][2][4][2], const Unit& u, int wr, int wc, int fr, int fq) const {
        const int row0 = u.pm * BM + wr * 64 + fr, col0 = u.pn * BM + wc * 32 + 8 * fq;
#pragma unroll
        for (int ai = 0; ai < 2; ++ai)
#pragma unroll
            for (int m = 0; m < 4; ++m) { bf16_t* rowp = O + (size_t)(row0 + ai * HALF + m * 16) * ldc + col0;
#pragma unroll
                for (int bj = 0; bj < 2; ++bj) { const f32x4 v0 = acc[ai][bj][m][0], v1 = acc[ai][bj][m][1];
                    u32x4 w; w.x = cvt_pk_bf16(v0[0], v0[1]); w.y = cvt_pk_bf16(v0[2], v0[3]); w.z = cvt_pk_bf16(v1[0], v1[1]); w.w = cvt_pk_bf16(v1[2], v1[3]);
                    *(u32x4*)(rowp + bj * HALF) = w; } }
    }
};
__device__ __forceinline__ float silu_mul(float g, float u) { return g * u * __builtin_amdgcn_rcpf(1.0f + __builtin_amdgcn_exp2f(-1.4426950408889634f * g)); }
struct EpiSwiglu {
    static constexpr bool PERM = true, AFTER_DRAIN = false, WITH_LDS = false;
    bf16_t* O; int ldc;
    __device__ __forceinline__ void operator()(const f32x4 (&acc)[2][2][4][2], const Unit& u, int wr, int wc, int fr, int fq) const {
        const int row0 = u.pm * BM + wr * 64 + fr, col0 = u.pn * HALF + wc * 32 + 8 * fq;
#pragma unroll
        for (int ai = 0; ai < 2; ++ai)
#pragma unroll
            for (int m = 0; m < 4; ++m) { bf16_t* rowp = O + (size_t)(row0 + ai * HALF + m * 16) * ldc + col0;
                const f32x4 g0 = acc[ai][0][m][0], g1 = acc[ai][0][m][1], u0 = acc[ai][1][m][0], u1 = acc[ai][1][m][1];
                u32x4 w; w.x = cvt_pk_bf16(silu_mul(g0[0], u0[0]), silu_mul(g0[1], u0[1])); w.y = cvt_pk_bf16(silu_mul(g0[2], u0[2]), silu_mul(g0[3], u0[3]));
                w.z = cvt_pk_bf16(silu_mul(g1[0], u1[0]), silu_mul(g1[1], u1[1])); w.w = cvt_pk_bf16(silu_mul(g1[2], u1[2]), silu_mul(g1[3], u1[3]));
                *(u32x4*)rowp = w; }
    }
};
constexpr int EP_LAT = 32768, EP_SEQ = 2048, EP_D = 1024, EP_MODLD = 6144;
struct EpiArgs { const float* in[31]; float* out; unsigned char* ws; int ph_lo, ph_hi; };
struct EpiResid {
    static constexpr bool PERM = false, AFTER_DRAIN = false, WITH_LDS = true;
    int first;
    int gate_off;
    int pool;
    int donorm, g_in, g_off, nmod_off;
    unsigned mod_byte, hc_byte, cnt_byte; size_t a_byte, xbuf_byte;
    __device__ __forceinline__ void run(f32x4 (&acc)[2][2][4][2], const Unit& u, int wr, int wc, int fr, int fq, PG8_LAS unsigned char* sl, int wid, int lane) const {
        const __attribute__((address_space(4))) EpiArgs* a = (const __attribute__((address_space(4))) EpiArgs*)__builtin_amdgcn_kernarg_segment_ptr(); asm volatile("" : "+s"(a));
        unsigned char* ws = a->ws; float* HCp = (float*)(ws + hc_byte);
        const float* in_lat = first ? a->in[0] : a->out; const float* in_ctx = first ? a->in[2] : HCp; float* out_lat = a->out; float* out_ctx = HCp;
        const float* MODp = (const float*)(ws + mod_byte);
        const float* gate = MODp + gate_off; const float* bias = pool ? a->in[21] : nullptr; const float* cscale = pool ? a->in[22] : nullptr;
        const int rt = u.pm * BM; const bool isl = rt < EP_LAT; const int b = isl ? rt / EP_SEQ : 16;
        const float* ip = isl ? in_lat : in_ctx - (size_t)EP_LAT * EP_D; float* op = isl ? out_lat : out_ctx - (size_t)EP_LAT * EP_D;
        const int col0 = u.pn * BM + wc * 32 + 4 * fq; const float* gp = gate + (size_t)b * EP_MODLD + col0;
        {
        f32x4 gv[2][2], bv[2][2], sv[2][2];
#pragma unroll
        for (int bj = 0; bj < 2; ++bj)
#pragma unroll
            for (int n = 0; n < 2; ++n) { gv[bj][n] = *(const f32x4*)(gp + bj * HALF + n * 16);
                bv[bj][n] = bias ? *(const f32x4*)(bias + col0 + bj * HALF + n * 16) : (f32x4){0.f, 0.f, 0.f, 0.f};
                sv[bj][n] = cscale ? *(const f32x4*)(cscale + col0 + bj * HALF + n * 16) : (f32x4){1.f, 1.f, 1.f, 1.f}; }
#pragma unroll
        for (int ai = 0; ai < 2; ++ai)
#pragma unroll
            for (int m = 0; m < 4; ++m) { const size_t off = (size_t)(rt + ai * HALF + wr * 64 + m * 16 + fr) * EP_D + col0;
#pragma unroll
                for (int bj = 0; bj < 2; ++bj)
#pragma unroll
                    for (int n = 0; n < 2; ++n) { const f32x4 bs = *(const f32x4*)(ip + off + bj * HALF + n * 16);
                        const f32x4 h = bs + gv[bj][n] * ((acc[ai][bj][m][n] + bv[bj][n]) * sv[bj][n]);
                        if (!donorm) *(f32x4*)(op + off + bj * HALF + n * 16) = h; acc[ai][bj][m][n] = h; } }
        }
        if (!donorm) return;
        PG8_LAS float* P = (PG8_LAS float*)sl; PG8_LAS float* S = P + 1024;
#pragma unroll
        for (int ai = 0; ai < 2; ++ai)
#pragma unroll
            for (int m = 0; m < 4; ++m) { float s = 0.f;
#pragma unroll
                for (int bj = 0; bj < 2; ++bj)
#pragma unroll
                    for (int n = 0; n < 2; ++n) { const f32x4 x = acc[ai][bj][m][n]; s += (x[0] * x[0] + x[1] * x[1]) + (x[2] * x[2] + x[3] * x[3]); }
                s += __shfl_xor(s, 16); s += __shfl_xor(s, 32);
                if (fq == 0) P[(ai * HALF + wr * 64 + m * 16 + fr) * 4 + wc] = s; }
        asm volatile("s_waitcnt lgkmcnt(0)" ::: "memory"); __builtin_amdgcn_s_barrier(); asm volatile("" ::: "memory");
        const int tid = wid * 64 + lane;
        float* xb = (float*)(ws + xbuf_byte) + ((size_t)u.pm * BM) * 4;
        unsigned* cnt = (unsigned*)(ws + cnt_byte) + 16 * u.pm;
        if (tid < BM) { const float s = (P[tid * 4] + P[tid * 4 + 1]) + (P[tid * 4 + 2] + P[tid * 4 + 3]);
            __hip_atomic_store(xb + tid * 4 + u.pn, s, __ATOMIC_RELAXED, __HIP_MEMORY_SCOPE_AGENT); }
        asm volatile("s_waitcnt vmcnt(0)" ::: "memory");
        if (wid < 4 && lane == 0) __hip_atomic_fetch_add(cnt, 1u, __ATOMIC_RELAXED, __HIP_MEMORY_SCOPE_AGENT);
#pragma unroll
        for (int ai = 0; ai < 2; ++ai)
#pragma unroll
            for (int m = 0; m < 4; ++m) { const size_t off = (size_t)(rt + ai * HALF + wr * 64 + m * 16 + fr) * EP_D + col0;
#pragma unroll
                for (int bj = 0; bj < 2; ++bj)
#pragma unroll
                    for (int n = 0; n < 2; ++n) *(f32x4*)(op + off + bj * HALF + n * 16) = acc[ai][bj][m][n]; }
        if (wid == 0) { unsigned sp = 0u;
            while ((unsigned)__builtin_amdgcn_readfirstlane(__hip_atomic_load(cnt, __ATOMIC_RELAXED, __HIP_MEMORY_SCOPE_AGENT)) < 16u) { __builtin_amdgcn_s_sleep(2); if (++sp > (1u << 22)) break; }
            __builtin_amdgcn_fence(__ATOMIC_ACQUIRE, "agent"); }
        asm volatile("s_waitcnt lgkmcnt(0)" ::: "memory"); __builtin_amdgcn_s_barrier(); asm volatile("" ::: "memory");
        if (tid < BM) { float t = 0.f;
#pragma unroll
            for (int k = 0; k < 4; ++k) t += __hip_atomic_load(xb + tid * 4 + k, __ATOMIC_RELAXED, __HIP_MEMORY_SCOPE_AGENT);
            S[tid] = 1.0f / sqrtf(t * (1.0f / EP_D) + 1e-6f); }
        asm volatile("s_waitcnt lgkmcnt(0)" ::: "memory"); __builtin_amdgcn_s_barrier(); asm volatile("" ::: "memory");
        bf16_t* Ap = (bf16_t*)(ws + a_byte);
        const float* gnp = a->in[g_in] + g_off + col0; const float* shp = MODp + nmod_off + (size_t)b * EP_MODLD + col0; const float* scp = shp + 1024;
        f32x4 wv[2][2], hv[2][2];
#pragma unroll
        for (int bj = 0; bj < 2; ++bj)
#pragma unroll
            for (int n = 0; n < 2; ++n) { wv[bj][n] = *(const f32x4*)(gnp + bj * HALF + n * 16) * (*(const f32x4*)(scp + bj * HALF + n * 16) + 1.0f); hv[bj][n] = *(const f32x4*)(shp + bj * HALF + n * 16); }
#pragma unroll
        for (int ai = 0; ai < 2; ++ai)
#pragma unroll
            for (int m = 0; m < 4; ++m) { const int rl = ai * HALF + wr * 64 + m * 16 + fr; const float rs = S[rl]; bf16_t* arow = Ap + (size_t)(rt + rl) * EP_D + col0;
#pragma unroll
                for (int bj = 0; bj < 2; ++bj)
#pragma unroll
                    for (int n = 0; n < 2; ++n) { const f32x4 y = (acc[ai][bj][m][n] * rs) * wv[bj][n] + hv[bj][n];
                        u32x2 w; w.x = cvt_pk_bf16(y[0], y[1]); w.y = cvt_pk_bf16(y[2], y[3]); *(u32x2*)(arow + bj * HALF + n * 16) = w; } }
    }
};
struct PanelOrder {
    int nM, G, x, y;
    __device__ void init(int M, int N, int G_, int c_) { nM = M / BM; G = G_; x = c_ & 7; y = c_ >> 3; (void)N; }
    __device__ bool next(int i, Unit& u) const {
        const int ppr = G / 4, base = i * ppr; if (base >= nM) return false;
        int rem = nM - base; rem = rem > ppr ? ppr : rem;
        const int per_x = (rem + 7) / 8, q = y >> 2; if (q >= per_x) return false;
        const int pm = base + x * per_x + q; if (pm >= nM) return false;
        u.pm = pm; u.pn = y & 3; return true;
    }
    __device__ __forceinline__ void a_ready(const Unit&) const {}
    __device__ __forceinline__ void done(const Unit&) const {}
};

template <class Epi, class Sched, bool ALIGN_EPI = false, bool SP2 = false>
__device__ __forceinline__ void gemm_phase(PG8_LAS unsigned char* lds, const Gemm g, const Sched& S, const Epi& E) {
    int tid_ = threadIdx.x; asm volatile("" : "+v"(tid_));
    const int tid = tid_, wid = __builtin_amdgcn_readfirstlane(tid >> 6), lane = tid & 63, wr = wid >> 2, wc = wid & 3, fr = lane & 15, fq = lane >> 4;
    const int K = g.K, nt = K / BK;
    unsigned voffA[2], voffB[2];
#pragma unroll
    for (int i = 0; i < 2; ++i) { int R, C; stage_rc(tid * 16 + i * 8192, R, C); const int Rb = Epi::PERM ? ((R & ~31) + perm32(R & 31)) : R;
        voffA[i] = (unsigned)(R * g.lda + C) * 2u; voffB[i] = (unsigned)(Rb * g.ldb + C) * 2u; }
    const size_t kstep = (size_t)(BK * 2);
    const size_t hstepA = (size_t)HALF * g.lda * 2, hstepB = (size_t)HALF * g.ldb * 2;
    const size_t tstepA = 2 * hstepA, tstepB = 2 * hstepB; const size_t akoff = (size_t)g.akoff * 2;
    const unsigned ldsw = (unsigned)wid * 1024u;
    const int aoff = lds_byte(wr * 64 + fr, fq * 8), boff = lds_byte(wc * 32 + fr, fq * 8);
#define PG8_SA(b, h) (((b) * 2 + (h)) * HTB)
#define PG8_SB(b, h) ((4 + (b) * 2 + (h)) * HTB)
#define PG8_STAGE(bufoff, gbase, voff) do { _Pragma("unroll") for (int _i = 0; _i < 2; ++_i) \
        __builtin_amdgcn_global_load_lds((const unsigned*)((const char*)(gbase) + (voff)[_i]), (PG8_LAS unsigned*)(lds + (bufoff) + ldsw + _i * 8192), 16, 0, 0); } while (0)
#define PG8_LDA(dst, b, h) do { _Pragma("unroll") for (int m = 0; m < 4; ++m) _Pragma("unroll") for (int k = 0; k < 2; ++k) dst[m][k] = *(const PG8_LAS bf16x8*)(lds + PG8_SA(b, h) + aoff + m * 2048 + k * 1024); } while (0)
#define PG8_LDB(dst, b, h) do { _Pragma("unroll") for (int n = 0; n < 2; ++n) _Pragma("unroll") for (int k = 0; k < 2; ++k) dst[n][k] = *(const PG8_LAS bf16x8*)(lds + PG8_SB(b, h) + boff + n * 2048 + k * 1024); } while (0)
#define PG8_MMA(ai, bj, At, Bt) do { __builtin_amdgcn_s_setprio(1); _Pragma("unroll") for (int m = 0; m < 4; ++m) _Pragma("unroll") for (int n = 0; n < 2; ++n) _Pragma("unroll") for (int k = 0; k < 2; ++k) \
        acc[ai][bj][m][n] = __builtin_amdgcn_mfma_f32_16x16x32_bf16(Bt[n][k], At[m][k], acc[ai][bj][m][n], 0, 0, 0); __builtin_amdgcn_s_setprio(0); } while (0)
#define PG8_WAIT_V(n) asm volatile("s_waitcnt vmcnt(" #n ")" ::: "memory")
#define PG8_WAIT_L(n) asm volatile("s_waitcnt lgkmcnt(" #n ")" ::: "memory")
#define PG8_BAR __builtin_amdgcn_s_barrier()
#define PG8_SCHED __builtin_amdgcn_sched_barrier(0)
    Unit cur, nxt; int ui = 0;
    if (!S.next(0, cur)) return;
    f32x4 acc[2][2][4][2];
#pragma unroll
    for (int a = 0; a < 2; ++a)
#pragma unroll
        for (int b = 0; b < 2; ++b)
#pragma unroll
            for (int m = 0; m < 4; ++m)
#pragma unroll
                for (int n = 0; n < 2; ++n) acc[a][b][m][n] = (f32x4){0.f, 0.f, 0.f, 0.f};
    bf16x8 At[4][2], B0[2][2], B1[2][2];
    const char* cA = (const char*)g.A + (size_t)cur.pm * tstepA + (size_t)cur.pn * akoff; const char* cB = (const char*)g.Bt + (size_t)cur.pn * tstepB;
    S.a_ready(cur);
    if constexpr (SP2) {
        PG8_STAGE(PG8_SB(0, 0), cB, voffB); PG8_STAGE(PG8_SB(0, 1), cB + hstepB, voffB); PG8_STAGE(PG8_SA(0, 0), cA, voffA); PG8_STAGE(PG8_SA(0, 1), cA + hstepA, voffA);
        if (wr == 1) PG8_BAR;
        PG8_WAIT_V(2); PG8_BAR;
        PG8_STAGE(PG8_SB(1, 0), cB + kstep, voffB); PG8_STAGE(PG8_SA(1, 0), cA + kstep, voffA); PG8_STAGE(PG8_SB(1, 1), cB + hstepB + kstep, voffB);
        PG8_WAIT_V(6); PG8_BAR;
    } else {
        PG8_STAGE(PG8_SB(0, 0), cB, voffB); PG8_STAGE(PG8_SA(0, 0), cA, voffA); PG8_STAGE(PG8_SB(0, 1), cB + hstepB, voffB); PG8_STAGE(PG8_SA(0, 1), cA + hstepA, voffA);
        if (wr == 1) PG8_BAR;
        PG8_WAIT_V(4); PG8_BAR;
        PG8_STAGE(PG8_SB(1, 0), cB + kstep, voffB); PG8_STAGE(PG8_SA(1, 0), cA + kstep, voffA); PG8_STAGE(PG8_SB(1, 1), cB + hstepB + kstep, voffB);
        PG8_WAIT_V(6); PG8_BAR;
    }
    for (;;) {
        const bool has_next = S.next(ui + 1, nxt);
        const char* nA = has_next ? (const char*)g.A + (size_t)nxt.pm * tstepA + (size_t)nxt.pn * akoff : cA; const char* nB = has_next ? (const char*)g.Bt + (size_t)nxt.pn * tstepB : cB;
        for (int t = 0; t < nt; t += 2) {
            const bool last = (t == nt - 2);
            const char* a1 = cA + (size_t)(t + 1) * kstep;
            const char* a2 = last ? nA : cA + (size_t)(t + 2) * kstep; const char* b2 = last ? nB : cB + (size_t)(t + 2) * kstep;
            const char* a3 = a2 + kstep; const char* b3 = b2 + kstep;
            if (last && has_next) S.a_ready(nxt);
            if constexpr (SP2) {
            PG8_LDB(B0, 0, 0); PG8_LDB(B1, 0, 1); PG8_SCHED; PG8_LDA(At, 0, 0); PG8_STAGE(PG8_SA(1, 1), a1 + hstepA, voffA);
            PG8_WAIT_V(8); PG8_WAIT_L(0); PG8_BAR; PG8_MMA(0, 0, At, B0); PG8_MMA(0, 1, At, B1); PG8_BAR; PG8_SCHED;
            PG8_LDA(At, 0, 1); PG8_STAGE(PG8_SB(0, 0), b2, voffB); PG8_STAGE(PG8_SB(0, 1), b2 + hstepB, voffB); PG8_STAGE(PG8_SA(0, 0), a2, voffA);
            PG8_WAIT_V(8); PG8_WAIT_L(0); PG8_BAR; PG8_MMA(1, 0, At, B0); PG8_MMA(1, 1, At, B1); PG8_BAR; PG8_SCHED;
            PG8_LDB(B0, 1, 0); PG8_LDB(B1, 1, 1); PG8_SCHED; PG8_LDA(At, 1, 0); PG8_STAGE(PG8_SA(0, 1), a2 + hstepA, voffA);
            PG8_WAIT_V(8); PG8_WAIT_L(0); PG8_BAR; PG8_MMA(0, 0, At, B0); PG8_MMA(0, 1, At, B1); PG8_BAR; PG8_SCHED;
            PG8_LDA(At, 1, 1); PG8_STAGE(PG8_SB(1, 0), b3, voffB); PG8_STAGE(PG8_SB(1, 1), b3 + hstepB, voffB); PG8_STAGE(PG8_SA(1, 0), a3, voffA);
            PG8_WAIT_V(8); PG8_WAIT_L(0); PG8_BAR; PG8_MMA(1, 0, At, B0); PG8_MMA(1, 1, At, B1); PG8_BAR; PG8_SCHED;
            } else {
            PG8_LDB(B0, 0, 0); PG8_SCHED; PG8_LDA(At, 0, 0); PG8_STAGE(PG8_SA(1, 1), a1 + hstepA, voffA);
            PG8_WAIT_L(8); PG8_BAR; PG8_WAIT_L(0); PG8_MMA(0, 0, At, B0); PG8_BAR; PG8_SCHED;
            PG8_LDB(B1, 0, 1); PG8_STAGE(PG8_SB(0, 0), b2, voffB);
            PG8_BAR; PG8_WAIT_L(0); PG8_MMA(0, 1, At, B1); PG8_BAR;
            PG8_LDA(At, 0, 1); PG8_STAGE(PG8_SA(0, 0), a2, voffA);
            PG8_BAR; PG8_WAIT_L(0); PG8_MMA(1, 0, At, B0); PG8_BAR; PG8_SCHED;
            PG8_STAGE(PG8_SB(0, 1), b2 + hstepB, voffB);
            PG8_WAIT_V(6); PG8_BAR; PG8_MMA(1, 1, At, B1); PG8_BAR;
            PG8_LDB(B0, 1, 0); PG8_SCHED; PG8_LDA(At, 1, 0); PG8_STAGE(PG8_SA(0, 1), a2 + hstepA, voffA);
            PG8_WAIT_L(8); PG8_BAR; PG8_WAIT_L(0); PG8_MMA(0, 0, At, B0); PG8_BAR; PG8_SCHED;
            PG8_LDB(B1, 1, 1); PG8_STAGE(PG8_SB(1, 0), b3, voffB);
            PG8_BAR; PG8_WAIT_L(0); PG8_MMA(0, 1, At, B1); PG8_BAR;
            PG8_LDA(At, 1, 1); PG8_STAGE(PG8_SA(1, 0), a3, voffA);
            PG8_BAR; PG8_WAIT_L(0); PG8_MMA(1, 0, At, B0); PG8_BAR; PG8_SCHED;
            PG8_STAGE(PG8_SB(1, 1), b3 + hstepB, voffB);
            PG8_WAIT_V(6); PG8_BAR; PG8_MMA(1, 1, At, B1); PG8_BAR;
            }
        }
        if constexpr (ALIGN_EPI) { if (wr == 0) PG8_BAR; }
        if constexpr (!Epi::AFTER_DRAIN) { if constexpr (Epi::WITH_LDS) E.run(acc, cur, wr, wc, fr, fq, lds + 131072 + 64, wid, lane); else E(acc, cur, wr, wc, fr, fq); S.done(cur); }
        if (!has_next) break;
#pragma unroll
        for (int a = 0; a < 2; ++a)
#pragma unroll
            for (int b = 0; b < 2; ++b)
#pragma unroll
                for (int m = 0; m < 4; ++m)
#pragma unroll
                    for (int n = 0; n < 2; ++n) acc[a][b][m][n] = (f32x4){0.f, 0.f, 0.f, 0.f};
        cur = nxt; cA = nA; cB = nB; ++ui;
        if constexpr (ALIGN_EPI) { if (wr == 1) PG8_BAR; }
    }
    PG8_WAIT_V(0);
    if constexpr (!ALIGN_EPI) { if (wr == 0) PG8_BAR; }
    PG8_BAR;
    if constexpr (Epi::AFTER_DRAIN) { E.fused(acc, cur, wr, wc, fr, fq, lds, wid, lane); S.done(cur); }
#undef PG8_SA
#undef PG8_SB
#undef PG8_STAGE
#undef PG8_LDA
#undef PG8_LDB
#undef PG8_MMA
#undef PG8_WAIT_V
#undef PG8_WAIT_L
#undef PG8_BAR
#undef PG8_SCHED
}
}

using pg8::bf16_t; using pg8::bf16x8; using pg8::f32x4; using pg8::u32x4;
typedef float f32x16 __attribute__((ext_vector_type(16)));
typedef unsigned u32x2 __attribute__((ext_vector_type(2)));
#define LAS __attribute__((address_space(3)))
constexpr int DM = 1024, NBATCH = 16, SEQ = 2048, LAT = NBATCH * SEQ, CTXL = 256, NCTX = NBATCH * CTXL, MTOT = LAT + NCTX, DFF = 2816, MODLD = 6 * DM, NMODB = 17;
constexpr float EPS = 1e-6f, LOG2E = 1.4426950408889634f;
constexpr int NTHREADS = 512, NWAVES = 8;
constexpr int LDS_BYTES = 139264;

constexpr size_t MiB = 1u << 20;
constexpr size_t WS_MOD = 0;
constexpr size_t WS_CTL = 1835008;
constexpr size_t WS_CNT = WS_CTL + 16384;
constexpr size_t CTL_ZERO_BYTES = 16384 + 7 * 144 * 64;
static_assert(WS_CNT + 7 * 144 * 64 <= 2 * MiB, "control words");
constexpr size_t WS_W = 2 * MiB;
constexpr size_t SZ_WGU = (size_t)2 * DFF * DM * 2, SZ_WDN = (size_t)DM * DFF * 2;
constexpr size_t WS_WGU = WS_W, WS_WDN = WS_WGU + 4 * SZ_WGU;
constexpr size_t WS_SWA_QKV = WS_WDN + 4 * SZ_WDN, WS_SWA_WO = WS_SWA_QKV + (size_t)1536 * DM * 2;
constexpr size_t WS_NA_QKV = WS_SWA_WO + (size_t)DM * DM * 2, WS_NA_WO = WS_NA_QKV + (size_t)3072 * DM * 2;
constexpr size_t WS_POOL = WS_NA_WO + (size_t)DM * DM * 2;
constexpr size_t WS_MLA_WA = WS_POOL + (size_t)DM * 256 * 2, WS_MLA_WUQ = WS_MLA_WA + (size_t)512 * DM * 2, WS_MLA_WUKV = WS_MLA_WUQ + (size_t)1536 * 256 * 2;
constexpr size_t WS_MLA_WO = WS_MLA_WUKV + (size_t)2048 * 128 * 2, WS_W_END = WS_MLA_WO + (size_t)DM * DM * 2;
constexpr size_t WS_HC = 86 * MiB;
constexpr size_t WS_RA = 102 * MiB;
constexpr size_t WS_RO = WS_RA + 72 * MiB;
constexpr size_t WS_RB = WS_RO + 72 * MiB;
constexpr size_t WS_XBUF = 507 * MiB;
constexpr size_t WS_END = WS_XBUF + (size_t)7 * MTOT * 16;
static_assert(WS_END <= 512 * MiB, "workspace");
static_assert(WS_W_END <= WS_HC, "weights fit");
static_assert(WS_RB + (size_t)MTOT * 3072 * 2 <= WS_XBUF && WS_RB + (size_t)MTOT * DFF * 2 <= WS_XBUF, "big region");
constexpr size_t WS_PROJ = WS_RO, WS_QR = WS_PROJ + (size_t)MTOT * 512 * 2, WS_KV = WS_QR + (size_t)LAT * 1536 * 2, WS_KR = WS_KV + (size_t)MTOT * 2048 * 2;
static_assert(WS_KR + (size_t)MTOT * 512 * 2 <= WS_XBUF, "mla region");

__device__ __forceinline__ unsigned f2bf(float f) { unsigned u = __builtin_bit_cast(unsigned, f); return (u + 0x7fffu + ((u >> 16) & 1u)) >> 16; }
__device__ __forceinline__ unsigned pk2(float lo, float hi) { return f2bf(lo) | (f2bf(hi) << 16); }
__device__ __forceinline__ float bflo(unsigned w) { return __builtin_bit_cast(float, w << 16); }
__device__ __forceinline__ float bfhi(unsigned w) { return __builtin_bit_cast(float, w & 0xffff0000u); }
__device__ __forceinline__ float wave_sum(float v) {
#pragma unroll
    for (int o = 1; o < 64; o <<= 1) v += __shfl_xor(v, o);
    return v;
}

struct Args { const float* in[31]; float* out; unsigned char* ws; int ph_lo, ph_hi; };
typedef const __attribute__((address_space(4))) Args* KArgs;

__device__ __forceinline__ void transpose_item(const float* W, int K, int N, bf16_t* WT, int drow0, int k0, int n0, LAS float* scr, int lane) {
#pragma unroll 8
    for (int i = 0; i < 32; ++i) { const int kk = 2 * i + (lane >> 5); scr[kk * 33 + (lane & 31)] = W[(size_t)(k0 + kk) * N + n0 + (lane & 31)]; }
    asm volatile("s_waitcnt lgkmcnt(0)" ::: "memory");
    const int c = lane & 7;
#pragma unroll
    for (int j = 0; j < 4; ++j) { const int n = (lane >> 3) + 8 * j; const LAS float* s = scr + (8 * c) * 33 + n;
        u32x4 o; o.x = pk2(s[0 * 33], s[1 * 33]); o.y = pk2(s[2 * 33], s[3 * 33]); o.z = pk2(s[4 * 33], s[5 * 33]); o.w = pk2(s[6 * 33], s[7 * 33]);
        *(u32x4*)(WT + (size_t)(drow0 + n) * K + k0 + 8 * c) = o; }
    asm volatile("s_waitcnt lgkmcnt(0)" ::: "memory");
}
__device__ __forceinline__ void transpose_job(const float* W, int K, int N, bf16_t* WT, int map, int item, LAS float* scr, int lane) {
    const int nblk = N / 32, kb = item / nblk, nb = item % nblk, k0 = 64 * kb, n0 = 32 * nb;
    int drow0 = n0;
    if (map == 1) { const bool up = n0 >= DFF; const int j = up ? n0 - DFF : n0; drow0 = (j >> 7) * 256 + (up ? 128 : 0) + (j & 127); }
    transpose_item(W, K, N, WT, drow0, k0, n0, scr, lane);
}
__device__ __forceinline__ void prologue_phase(const int TID, KArgs a, LAS unsigned char* lds) {
    const int tid = TID, lane = tid & 63, wave = tid >> 6;
    unsigned char* ws = a->ws;
    LAS float* scr = (LAS float*)(lds + wave * 16384);
    const int gw = blockIdx.x * NWAVES + wave, NGW = gridDim.x * NWAVES;
    constexpr int I_GU = (DM / 64) * (2 * DFF / 32), I_DN = (DFF / 64) * (DM / 32), I_SQ = (DM / 64) * (1536 / 32), I_SQ2 = (DM / 64) * (DM / 32), I_NQ = (DM / 64) * (3072 / 32);
    constexpr int I_PL = (256 / 64) * (256 / 32), I_WA = (DM / 64) * (416 / 32), I_UQ = (256 / 64) * (1536 / 32), I_UKV = (128 / 64) * (2048 / 32);
    constexpr int NITEMS = 4 * I_GU + 4 * I_DN + I_SQ + I_SQ2 + I_NQ + I_SQ2 + 4 * I_PL + I_WA + I_UQ + I_UKV + I_SQ2;
    for (int it = gw; it < NITEMS; it += NGW) {
        int r = it;
        if (r < 4 * I_GU) { const int l = r / I_GU; transpose_job(a->in[8] + (size_t)l * DM * 2 * DFF, DM, 2 * DFF, (bf16_t*)(ws + WS_WGU + l * SZ_WGU), 1, r % I_GU, scr, lane); continue; } r -= 4 * I_GU;
        if (r < 4 * I_DN) { const int l = r / I_DN; transpose_job(a->in[9] + (size_t)l * DFF * DM, DFF, DM, (bf16_t*)(ws + WS_WDN + l * SZ_WDN), 0, r % I_DN, scr, lane); continue; } r -= 4 * I_DN;
        if (r < I_SQ) { transpose_job(a->in[10], DM, 1536, (bf16_t*)(ws + WS_SWA_QKV), 0, r, scr, lane); continue; } r -= I_SQ;
        if (r < I_SQ2) { transpose_job(a->in[14], DM, DM, (bf16_t*)(ws + WS_SWA_WO), 0, r, scr, lane); continue; } r -= I_SQ2;
        if (r < I_NQ) { transpose_job(a->in[15], DM, 3072, (bf16_t*)(ws + WS_NA_QKV), 0, r, scr, lane); continue; } r -= I_NQ;
        if (r < I_SQ2) { transpose_job(a->in[19], DM, DM, (bf16_t*)(ws + WS_NA_WO), 0, r, scr, lane); continue; } r -= I_SQ2;
        if (r < 4 * I_PL) { const int g = r / I_PL; transpose_job(a->in[20] + (size_t)g * 65536, 256, 256, (bf16_t*)(ws + WS_POOL) + (size_t)g * 65536, 0, r % I_PL, scr, lane); continue; } r -= 4 * I_PL;
        if (r < I_WA) { transpose_job(a->in[23], DM, 416, (bf16_t*)(ws + WS_MLA_WA), 0, r, scr, lane); continue; } r -= I_WA;
        if (r < I_UQ) { transpose_job(a->in[26], 256, 1536, (bf16_t*)(ws + WS_MLA_WUQ), 0, r, scr, lane); continue; } r -= I_UQ;
        if (r < I_UKV) { transpose_job(a->in[27], 128, 2048, (bf16_t*)(ws + WS_MLA_WUKV), 0, r, scr, lane); continue; } r -= I_UKV;
        transpose_job(a->in[30], DM, DM, (bf16_t*)(ws + WS_MLA_WO), 0, r, scr, lane);
    }
    { u32x4* z = (u32x4*)(ws + WS_MLA_WA + (size_t)416 * DM * 2); const int nz = 96 * DM * 2 / 16;
      for (int i = blockIdx.x * NTHREADS + tid; i < nz; i += gridDim.x * NTHREADS) z[i] = (u32x4){0u, 0u, 0u, 0u}; }
    __syncthreads();
    if ((int)blockIdx.x < 384) {
        LAS float* cond = (LAS float*)lds;
        LAS float* red = (LAS float*)(lds + 81920);
        for (int i = tid; i < NMODB * DM; i += NTHREADS) { const int b = i / DM, k = i % DM; const float v = b < 16 ? a->in[1][b * DM + k] : a->in[3][k];
            cond[k * 20 + b] = v / (1.0f + __expf(-v)); }
        __syncthreads();
        const int col = tid & 63, kg = tid >> 6;
        for (int u = blockIdx.x; u < 384; u += gridDim.x) {
            const int l = u / 96, cb = u % 96;
            const float* w = a->in[4] + (size_t)l * DM * MODLD + cb * 64 + col;
            float acc[NMODB];
#pragma unroll
            for (int b = 0; b < NMODB; ++b) acc[b] = 0.f;
#pragma unroll 4
            for (int k = kg * 128; k < kg * 128 + 128; ++k) { const float wv = w[(size_t)k * MODLD]; const LAS float* cp = cond + k * 20;
#pragma unroll
                for (int b = 0; b < NMODB; ++b) acc[b] += cp[b] * wv; }
#pragma unroll
            for (int b = 0; b < NMODB; ++b) red[(kg * NMODB + b) * 64 + col] = acc[b];
            __syncthreads();
            for (int i = tid; i < NMODB * 64; i += NTHREADS) { const int b = i >> 6, c = i & 63; float s = 0.f;
#pragma unroll
                for (int g = 0; g < 8; ++g) s += red[(g * NMODB + b) * 64 + c];
                ((float*)(ws + WS_MOD))[((size_t)l * NMODB + b) * MODLD + cb * 64 + c] = s + a->in[5][l * MODLD + cb * 64 + c]; }
            __syncthreads();
        }
    }
}

__device__ __forceinline__ void norm_phase(const int TID, const float* in_lat, const float* in_ctx, int M, const float* g, const float* sh, const float* sc, bf16_t* A) {
    const int lane = TID & 63, wave = TID >> 6;
    const int gw = blockIdx.x * NWAVES + wave, NGW = gridDim.x * NWAVES;
    f32x4 gv[4];
#pragma unroll
    for (int j = 0; j < 4; ++j) gv[j] = *(const f32x4*)(g + 4 * lane + 256 * j);
    for (int row = gw; row < M; row += NGW) {
        const float* xr = row < LAT ? in_lat + (size_t)row * DM : in_ctx + (size_t)(row - LAT) * DM;
        const int b = row < LAT ? row / SEQ : 16;
        f32x4 v[4]; float s = 0.f;
#pragma unroll
        for (int j = 0; j < 4; ++j) { v[j] = *(const f32x4*)(xr + 4 * lane + 256 * j); s += (v[j].x * v[j].x + v[j].y * v[j].y) + (v[j].z * v[j].z + v[j].w * v[j].w); }
        const float rstd = 1.0f / sqrtf(wave_sum(s) * (1.0f / DM) + EPS);
        const float* shp = sh + (size_t)b * MODLD + 4 * lane; const float* scp = sc + (size_t)b * MODLD + 4 * lane;
        bf16_t* op = A + (size_t)row * DM + 4 * lane;
#pragma unroll
        for (int j = 0; j < 4; ++j) { const f32x4 s4 = *(const f32x4*)(scp + 256 * j), h4 = *(const f32x4*)(shp + 256 * j);
            const f32x4 y = (v[j] * rstd * gv[j]) * (s4 + 1.0f) + h4;
            u32x2 w; w.x = pk2(y.x, y.y); w.y = pk2(y.z, y.w); *(u32x2*)(op + 256 * j) = w; }
    }
}

template <int HALFD> __device__ __forceinline__ void rope_table(const int TID, LAS float* tab) {
    for (int i = TID; i < 64 * HALFD; i += NTHREADS) { const int pos = i / HALFD, f = i % HALFD;
        const float fr = powf(10000.0f, -(float)f / (float)HALFD); float sn, cs; sincosf((float)pos * fr, &sn, &cs); tab[2 * i] = cs; tab[2 * i + 1] = sn; }
    __syncthreads();
}

__device__ __forceinline__ void qknorm_phase(const int TID, bf16_t* QKV, int ld, int nq, int nk, const float* gq, const float* gk, bool rope, float qscale, LAS unsigned char* lds) {
    LAS float* tab = (LAS float*)lds;
    if (rope) rope_table<16>(TID, tab);
    const int lane = TID & 63, wave = TID >> 6, l16 = lane & 15;
    const int gw = blockIdx.x * NWAVES + wave, NGW = gridDim.x * NWAVES;
    const f32x4 gq4 = *(const f32x4*)(gq + 4 * l16), gk4 = *(const f32x4*)(gk + 4 * l16);
    const int npass = (nq + nk) / 4;
    for (int row = gw; row < MTOT; row += NGW) {
        const bool dorope = rope && row < LAT; const int t = row & (SEQ - 1);
        const int pos = (l16 & 8) ? (t & 63) : (t >> 6); const int fi = 4 * (l16 & 3); const bool x2 = (l16 & 4) != 0;
        f32x4 cs = {1.f, 1.f, 1.f, 1.f}, sn = {0.f, 0.f, 0.f, 0.f};
        if (dorope) {
#pragma unroll
            for (int j = 0; j < 4; ++j) { cs[j] = tab[2 * (pos * 16 + fi + j)]; sn[j] = tab[2 * (pos * 16 + fi + j) + 1]; } }
        for (int p = 0; p < npass; ++p) {
            const int hh = 4 * p + (lane >> 4); const bool isq = hh < nq;
            bf16_t* ptr = QKV + (size_t)row * ld + hh * 64 + 4 * l16;
            const u32x2 w = *(const u32x2*)ptr;
            f32x4 x = {bflo(w.x), bfhi(w.x), bflo(w.y), bfhi(w.y)};
            float s = (x.x * x.x + x.y * x.y) + (x.z * x.z + x.w * x.w);
            s += __shfl_xor(s, 1); s += __shfl_xor(s, 2); s += __shfl_xor(s, 4); s += __shfl_xor(s, 8);
            const float rstd = 1.0f / sqrtf(s * (1.0f / 64.0f) + EPS);
            x = x * rstd * (isq ? gq4 : gk4);
            f32x4 o;
#pragma unroll
            for (int j = 0; j < 4; ++j) { const float other = __shfl_xor(x[j], 4); o[j] = x2 ? (other * sn[j] + x[j] * cs[j]) : (x[j] * cs[j] - other * sn[j]); }
            if (isq) o = o * qscale;
            u32x2 wo; wo.x = pk2(o.x, o.y); wo.y = pk2(o.z, o.w); *(u32x2*)ptr = wo;
        }
    }
}

__device__ __forceinline__ void mlanorm1_phase(const int TID, bf16_t* PROJ, const float* gcq, const float* gckv) {
    const int lane = TID & 63, wave = TID >> 6;
    const int gw = blockIdx.x * NWAVES + wave, NGW = gridDim.x * NWAVES;
    const f32x4 g1 = *(const f32x4*)(gcq + 4 * lane);
    const float g2a = gckv[2 * lane], g2b = gckv[2 * lane + 1];
    for (int row = gw; row < MTOT; row += NGW) {
        bf16_t* p = PROJ + (size_t)row * 512;
        const u32x2 w = *(const u32x2*)(p + 4 * lane); const unsigned w2 = *(const unsigned*)(p + 256 + 2 * lane);
        f32x4 x = {bflo(w.x), bfhi(w.x), bflo(w.y), bfhi(w.y)}; float ya = bflo(w2), yb = bfhi(w2);
        const float s1 = wave_sum((x.x * x.x + x.y * x.y) + (x.z * x.z + x.w * x.w)), s2 = wave_sum(ya * ya + yb * yb);
        const float r1 = 1.0f / sqrtf(s1 * (1.0f / 256.0f) + EPS), r2 = 1.0f / sqrtf(s2 * (1.0f / 128.0f) + EPS);
        x = x * r1 * g1; ya *= r2 * g2a; yb *= r2 * g2b;
        u32x2 wo; wo.x = pk2(x.x, x.y); wo.y = pk2(x.z, x.w); *(u32x2*)(p + 4 * lane) = wo; *(unsigned*)(p + 256 + 2 * lane) = pk2(ya, yb);
    }
}
__device__ __forceinline__ void mlanorm2_phase(const int TID, bf16_t* QR, bf16_t* KV, const bf16_t* PROJ, bf16_t* KR, const float* gq, const float* gk, float qscale, LAS unsigned char* lds) {
    LAS float* tab = (LAS float*)lds;
    rope_table<8>(TID, tab);
    const int lane = TID & 63, wave = TID >> 6, l32 = lane & 31, hs = lane >> 5;
    const int gw = blockIdx.x * NWAVES + wave, NGW = gridDim.x * NWAVES;
    const float gq0 = gq[l32], gq1 = gq[l32 + 32], gq2 = gq[l32 + 64], gk0 = gk[l32], gk1 = gk[l32 + 32], gk2 = gk[l32 + 64];
    const int fi = l32 & 7; const bool x2 = (l32 & 8) != 0, colpos = (l32 & 16) != 0;
    for (int row = gw; row < MTOT; row += NGW) {
        const bool islat = row < LAT; const int t = row & (SEQ - 1); const int pos = colpos ? (t & 63) : (t >> 6);
        float cs = 1.f, sn = 0.f; if (islat) { cs = tab[2 * (pos * 8 + fi)]; sn = tab[2 * (pos * 8 + fi) + 1]; }
        if (islat) {
            for (int p = 0; p < 8; ++p) { bf16_t* q = QR + (size_t)row * 1536 + (2 * p + hs) * 96;
                float a = bflo((unsigned)q[l32]), b = bflo((unsigned)q[l32 + 32]), c = bflo((unsigned)q[l32 + 64]);
                float s = a * a + b * b + c * c; s += __shfl_xor(s, 1); s += __shfl_xor(s, 2); s += __shfl_xor(s, 4); s += __shfl_xor(s, 8); s += __shfl_xor(s, 16);
                const float rstd = 1.0f / sqrtf(s * (1.0f / 96.0f) + EPS);
                a *= rstd * gq0; b *= rstd * gq1; c *= rstd * gq2;
                const float other = __shfl_xor(c, 8); c = x2 ? (other * sn + c * cs) : (c * cs - other * sn);
                q[l32] = (bf16_t)f2bf(a * qscale); q[l32 + 32] = (bf16_t)f2bf(b * qscale); q[l32 + 64] = (bf16_t)f2bf(c * qscale); }
        }
        const float kr = bflo((unsigned)PROJ[(size_t)row * 512 + 384 + l32]);
        for (int p = 0; p < 8; ++p) { const int hh = 2 * p + hs; bf16_t* k = KV + (size_t)row * 2048 + hh * 128;
            float a = bflo((unsigned)k[l32]), b = bflo((unsigned)k[l32 + 32]), c = kr;
            float s = a * a + b * b + c * c; s += __shfl_xor(s, 1); s += __shfl_xor(s, 2); s += __shfl_xor(s, 4); s += __shfl_xor(s, 8); s += __shfl_xor(s, 16);
            const float rstd = 1.0f / sqrtf(s * (1.0f / 96.0f) + EPS);
            a *= rstd * gk0; b *= rstd * gk1; c *= rstd * gk2;
            const float other = __shfl_xor(c, 8); c = x2 ? (other * sn + c * cs) : (c * cs - other * sn);
            k[l32] = (bf16_t)f2bf(a); k[l32 + 32] = (bf16_t)f2bf(b); KR[(size_t)row * 512 + hh * 32 + l32] = (bf16_t)f2bf(c); }
    }
}

__device__ __forceinline__ void pool_phase(const int TID, const bf16_t* A, bf16_t* P) {
    const int lane = TID & 63, wave = TID >> 6;
    const int gw = blockIdx.x * NWAVES + wave, NGW = gridDim.x * NWAVES;
    for (int row = gw; row < MTOT; row += NGW) {
        int base, L, t; if (row < LAT) { base = row & ~(SEQ - 1); L = SEQ; t = row - base; } else { const int r = row - LAT; base = LAT + (r & ~(CTXL - 1)); L = CTXL; t = r & (CTXL - 1); }
#pragma unroll
        for (int j = 0; j < 4; ++j) {
            const int w = 2 << j; int lo = t - w / 2, hi = t - w / 2 + w; lo = lo < 0 ? 0 : lo; hi = hi > L ? L : hi;
            f32x4 s = {0.f, 0.f, 0.f, 0.f};
            for (int k = lo; k < hi; ++k) { const u32x2 v = *(const u32x2*)(A + (size_t)(base + k) * DM + 256 * j + 4 * lane); s += (f32x4){bflo(v.x), bfhi(v.x), bflo(v.y), bfhi(v.y)}; }
            const u32x2 v = *(const u32x2*)(A + (size_t)row * DM + 256 * j + 4 * lane); const f32x4 self = {bflo(v.x), bfhi(v.x), bflo(v.y), bfhi(v.y)};
            const f32x4 o = s * (1.0f / (float)(hi - lo)) - self;
            u32x2 wo; wo.x = pk2(o.x, o.y); wo.y = pk2(o.z, o.w); *(u32x2*)(P + (size_t)row * DM + 256 * j + 4 * lane) = wo;
        }
    }
}

typedef short v4i16_t __attribute__((ext_vector_type(4)));
constexpr float ATT_THR = 8.0f;
__device__ __forceinline__ int crow16(int r, int hi) { return (r & 3) + 8 * (r >> 2) + 4 * hi; }
template <int MODE> __device__ __forceinline__ void attn_phase(const int TID, KArgs a, LAS unsigned char* lds) {
    constexpr int DQK = MODE == 2 ? 96 : 64, NKS = DQK / 16;
    constexpr int KROWB = DQK * 2 + 16, KBUF = 64 * KROWB, VOFF = 2 * KBUF, BIASOFF = VOFF + 16384;
    const int tid = TID, lane = tid & 63, wid = __builtin_amdgcn_readfirstlane(tid >> 6), r32 = lane & 31, hi = lane >> 5;
    unsigned char* ws = a->ws;
    const bf16_t *Qb, *Kb, *K2b = nullptr, *Vb; bf16_t* Ob; int ldq, ldk;
    if (MODE == 0) { Qb = (const bf16_t*)(ws + WS_RB); ldq = 1536; Kb = Qb + 1024; Vb = Qb + 1280; ldk = 1536; Ob = (bf16_t*)(ws + WS_RO); }
    else if (MODE == 1) { Qb = (const bf16_t*)(ws + WS_RB); ldq = 3072; Kb = Qb + 1024; Vb = Qb + 2048; ldk = 3072; Ob = (bf16_t*)(ws + WS_RO); }
    else { Qb = (const bf16_t*)(ws + WS_QR); ldq = 1536; Kb = (const bf16_t*)(ws + WS_KV); Vb = Kb + 64; K2b = (const bf16_t*)(ws + WS_KR); ldk = 2048; Ob = (bf16_t*)(ws + WS_RA); }
    const int G = gridDim.x, bx = blockIdx.x, vcu = (G % 8 == 0) ? (bx % 8) * (G / 8) + bx / 8 : bx;
    constexpr int NLAT = 2048, NCTXU = MODE == 2 ? 0 : 256;
    const int lat_per = (NLAT + G - 1) / G, ctx_per = (NCTXU + G - 1) / G;
    LAS float* btab = (LAS float*)(lds + BIASOFF);
    const int srow = tid >> 3, sch = tid & 7, s2row = tid >> 2, s2ch = tid & 3;
    const int kst = srow * KROWB + sch * 16, k2st = s2row * KROWB + 128 + s2ch * 16, vst = (sch >> 2) * 4096 + srow * 64 + (sch & 3) * 16;
    const int vrd = (4 * hi + ((lane & 15) >> 2)) * 64 + (16 * ((lane >> 4) & 1) + 4 * (lane & 3)) * 2;
    for (int it = 0; it < lat_per + ctx_per; ++it) {
        const bool ctxu = it >= lat_per;
        const int u = ctxu ? vcu * ctx_per + (it - lat_per) : vcu * lat_per + it;
        if (u >= (ctxu ? NCTXU : NLAT)) continue;
        int b, head, hoff, qrow, NT, lat0 = 0, qtok = 0, jj_lo = 0, rrow = 0, R0 = 0;
        if (MODE == 0) {
            if (!ctxu) { b = u >> 7; const int kvh = (u >> 5) & 3, qb = u & 31; head = kvh * 4 + (wid >> 1); hoff = kvh * 64; qtok = qb * 64 + (wid & 1) * 32 + r32; qrow = b * SEQ + qtok;
                jj_lo = 2 - qb > 0 ? 2 - qb : 0; const int jj_hi = 33 - qb < 4 ? 33 - qb : 4; lat0 = b * SEQ + qb * 64 - 128 + 64 * jj_lo; NT = 4 + (jj_hi - jj_lo + 1); }
            else { b = u >> 4; const int kvh = (u >> 2) & 3, qb = u & 3; head = kvh * 4 + (wid >> 1); hoff = kvh * 64; qtok = qb * 64 + (wid & 1) * 32 + r32; qrow = LAT + b * CTXL + qtok; NT = 4; }
        } else if (MODE == 1) {
            if (!ctxu) { b = u >> 7; head = (u >> 3) & 15; const int rq = u & 7; hoff = head * 64; rrow = 4 * rq + (wid >> 1); qtok = 32 * (wid & 1) + r32; qrow = b * SEQ + rrow * 64 + qtok;
                R0 = 4 * rq - 4; R0 = R0 < 0 ? 0 : (R0 > 24 ? 24 : R0); int R1 = 4 * rq - 1; R1 = (R1 < 0 ? 0 : (R1 > 24 ? 24 : R1)) + 7; lat0 = b * SEQ + R0 * 64; NT = 4 + (R1 - R0 + 1); }
            else { b = u >> 4; head = u & 15; hoff = head * 64; qrow = LAT + b * CTXL + wid * 32 + r32; NT = 4; }
        } else { b = u >> 7; head = (u >> 3) & 15; const int qb = u & 7; hoff = head * 128; qrow = b * SEQ + qb * 256 + wid * 32 + r32; lat0 = b * SEQ; NT = 4 + 32; }
        const int ctx0 = LAT + b * CTXL;
        bf16x8 qf[NKS];
        { const bf16_t* qp = Qb + (size_t)qrow * ldq + head * DQK + 8 * hi;
#pragma unroll
          for (int ks = 0; ks < NKS; ++ks) qf[ks] = *(const bf16x8*)(qp + 16 * ks); }
        if (MODE == 1 && !ctxu) { const float* rp = a->in[18] + (size_t)head * 465; for (int i = tid; i < 465; i += NTHREADS) btab[64 + i] = rp[i] * LOG2E; }
        u32x4 kreg, k2reg = {0u, 0u, 0u, 0u}, vreg;
#define ATT_TILE_ROW(j) ((j) < 4 ? ctx0 + 64 * (j) : lat0 + 64 * ((j) - 4))
#define ATT_LOAD(j) do { const int kr0_ = ATT_TILE_ROW(j); kreg = *(const u32x4*)(Kb + (size_t)(kr0_ + srow) * ldk + hoff + sch * 8); vreg = *(const u32x4*)(Vb + (size_t)(kr0_ + srow) * ldk + hoff + sch * 8); \
        if (MODE == 2 && tid < 256) k2reg = *(const u32x4*)(K2b + (size_t)(kr0_ + s2row) * 512 + head * 32 + s2ch * 8); } while (0)
#define ATT_STORE(buf) do { *(LAS u32x4*)(lds + (buf) * KBUF + kst) = kreg; *(LAS u32x4*)(lds + VOFF + (buf) * 8192 + vst) = vreg; if (MODE == 2 && tid < 256) *(LAS u32x4*)(lds + (buf) * KBUF + k2st) = k2reg; } while (0)
        ATT_LOAD(0); ATT_STORE(0);
        __syncthreads();
        f32x16 o0, o1;
#pragma unroll
        for (int i = 0; i < 16; ++i) { o0[i] = 0.f; o1[i] = 0.f; }
        float m = 0.f, l = 0.f;
        f32x16 negm;
#pragma unroll
        for (int i = 0; i < 16; ++i) negm[i] = 0.f;
        int r0w = rrow - 4; r0w = r0w < 0 ? 0 : (r0w > 24 ? 24 : r0w);
        int cs = qtok - 8; cs = cs < 0 ? 0 : (cs > 48 ? 48 : cs);
        for (int j = 0; j < NT; ++j) {
            if (j + 1 < NT) ATT_LOAD(j + 1);
            const int buf = j & 1;
            bool active = true, masked = false; int kr = 0, kstart = 0;
            if (MODE == 0 && j >= 4) { const int jj = jj_lo + (j - 4); masked = (jj == 0 || jj == 4); kstart = (lat0 - b * SEQ) + 64 * (j - 4); }
            if (MODE == 1 && j >= 4) { kr = R0 + (j - 4); active = (kr >= r0w && kr < r0w + 8); masked = true; }
            if (active) {
                const LAS unsigned char* kb = lds + buf * KBUF + r32 * KROWB + hi * 16;
                f32x16 s0, s1;
                __builtin_amdgcn_s_setprio(1);
#pragma unroll
                for (int ks = 0; ks < NKS; ++ks) { const bf16x8 a0 = *(const LAS bf16x8*)(kb + ks * 32), a1 = *(const LAS bf16x8*)(kb + 32 * KROWB + ks * 32);
                    s0 = __builtin_amdgcn_mfma_f32_32x32x16_bf16(a0, qf[ks], ks == 0 ? negm : s0, 0, 0, 0); s1 = __builtin_amdgcn_mfma_f32_32x32x16_bf16(a1, qf[ks], ks == 0 ? negm : s1, 0, 0, 0); }
                __builtin_amdgcn_s_setprio(0);
                if (MODE == 0 && masked) { const int d0 = qtok - kstart - 4 * hi + 128;
#pragma unroll
                    for (int i = 0; i < 16; ++i) { const int c = (i & 3) + 8 * (i >> 2); if ((unsigned)(d0 - c) > 256u) s0[i] = -1e30f; if ((unsigned)(d0 - c - 32) > 256u) s1[i] = -1e30f; } }
                if (MODE == 1 && masked) { const LAS float* bp = btab + 64 + (kr - rrow + 7) * 31 + 15 - qtok + 4 * hi; const int e0 = 4 * hi - cs;
#pragma unroll
                    for (int i = 0; i < 16; ++i) { const int c = (i & 3) + 8 * (i >> 2);
                        s0[i] = (unsigned)(e0 + c) < 16u ? s0[i] + bp[c] : -1e30f; s1[i] = (unsigned)(e0 + c + 32) < 16u ? s1[i] + bp[c + 32] : -1e30f; } }
                float mxa = __builtin_fmaxf(__builtin_fmaxf(s0[0], s0[1]), s1[0]), mxb = __builtin_fmaxf(__builtin_fmaxf(s0[2], s0[3]), s1[1]); mxa = __builtin_fmaxf(__builtin_fmaxf(mxa, s1[2]), s1[3]);
#pragma unroll
                for (int i = 4; i < 16; i += 4) { mxa = __builtin_fmaxf(__builtin_fmaxf(mxa, s0[i]), s0[i + 1]); mxb = __builtin_fmaxf(__builtin_fmaxf(mxb, s0[i + 2]), s0[i + 3]);
                    mxa = __builtin_fmaxf(__builtin_fmaxf(mxa, s1[i]), s1[i + 1]); mxb = __builtin_fmaxf(__builtin_fmaxf(mxb, s1[i + 2]), s1[i + 3]); }
                float mx = __builtin_fmaxf(mxa, mxb);
                { const auto rr = __builtin_amdgcn_permlane32_swap(__float_as_uint(mx), __float_as_uint(mx), false, false); mx = __builtin_fmaxf(__uint_as_float(rr[0]), __uint_as_float(rr[1])); }
                if (j == 0 || __any(mx > ATT_THR)) {
                    const float dl = j == 0 ? mx : __builtin_fmaxf(mx, 0.f); m += dl;
                    const float f = j == 0 ? 0.f : __builtin_amdgcn_exp2f(-dl); l *= f;
#pragma unroll
                    for (int i = 0; i < 16; ++i) { s0[i] -= dl; s1[i] -= dl; o0[i] *= f; o1[i] *= f; negm[i] = -m; }
                }
                float ls = 0.f;
#pragma unroll
                for (int i = 0; i < 16; ++i) { s0[i] = __builtin_amdgcn_exp2f(s0[i]); s1[i] = __builtin_amdgcn_exp2f(s1[i]); ls += s0[i] + s1[i]; }
                l += ls;
                bf16x8 pf[4];
#pragma unroll
                for (int s = 0; s < 4; ++s) { u32x4 w;
#pragma unroll
                    for (int e = 0; e < 4; ++e) { const int r = 8 * (s & 1) + 2 * e; w[e] = s < 2 ? pg8::cvt_pk_bf16(s0[r], s0[r + 1]) : pg8::cvt_pk_bf16(s1[r], s1[r + 1]); }
                    pf[s] = __builtin_bit_cast(bf16x8, w); }
                const LAS unsigned char* vb = lds + VOFF + buf * 8192 + vrd;
                __builtin_amdgcn_s_setprio(1);
#pragma unroll
                for (int s = 0; s < 4; ++s) {
#pragma unroll
                    for (int dh = 0; dh < 2; ++dh) {
                        const v4i16_t lo = __builtin_amdgcn_ds_read_tr16_b64_v4i16((LAS v4i16_t*)(vb + dh * 4096 + s * 1024));
                        const v4i16_t hh = __builtin_amdgcn_ds_read_tr16_b64_v4i16((LAS v4i16_t*)(vb + dh * 4096 + s * 1024 + 512));
                        const bf16x8 vf = __builtin_shufflevector(lo, hh, 0, 1, 2, 3, 4, 5, 6, 7);
                        if (dh == 0) o0 = __builtin_amdgcn_mfma_f32_32x32x16_bf16(vf, pf[s], o0, 0, 0, 0); else o1 = __builtin_amdgcn_mfma_f32_32x32x16_bf16(vf, pf[s], o1, 0, 0, 0); } }
                __builtin_amdgcn_s_setprio(0);
            }
            if (j + 1 < NT) ATT_STORE(buf ^ 1);
            __syncthreads();
        }
#undef ATT_TILE_ROW
#undef ATT_LOAD
#undef ATT_STORE
        l += __shfl_xor(l, 32);
        if (MODE == 0) l += __builtin_amdgcn_exp2f(a->in[13][head] * LOG2E - m);
        const float inv = 1.0f / l;
        bf16_t* op = Ob + (size_t)qrow * DM + head * 64 + 4 * hi;
#pragma unroll
        for (int g4 = 0; g4 < 4; ++g4) {
            u32x2 w0, w1; w0.x = pg8::cvt_pk_bf16(o0[4 * g4] * inv, o0[4 * g4 + 1] * inv); w0.y = pg8::cvt_pk_bf16(o0[4 * g4 + 2] * inv, o0[4 * g4 + 3] * inv);
            w1.x = pg8::cvt_pk_bf16(o1[4 * g4] * inv, o1[4 * g4 + 1] * inv); w1.y = pg8::cvt_pk_bf16(o1[4 * g4 + 2] * inv, o1[4 * g4 + 3] * inv);
            *(u32x2*)(op + 8 * g4) = w0; *(u32x2*)(op + 32 + 8 * g4) = w1; }
    }
}

enum Kind { K_PRO = 0, K_N1, K_G1, K_QKN, K_ATT, K_G2, K_N2, K_G3, K_G4, K_POOL, K_GPOOL, K_GPROJ, K_MLAN1, K_GUP, K_MLAN2 };
constexpr int NPHASES = 26;
__device__ __forceinline__ void decode_phase(int p, int& L, int& kind) {
    if (p == 0) { L = 0; kind = K_PRO; return; }
    if (p <= 7) { L = 0; const int k = p - 1; kind = k == 0 ? K_N1 : k == 1 ? K_G1 : k == 2 ? K_QKN : k == 3 ? K_ATT : k == 4 ? K_G2 : k == 5 ? K_G3 : K_G4; return; }
    if (p <= 13) { L = 1; const int k = p - 8; kind = k == 0 ? K_G1 : k == 1 ? K_QKN : k == 2 ? K_ATT : k == 3 ? K_G2 : k == 4 ? K_G3 : K_G4; return; }
    if (p <= 17) { L = 2; const int k = p - 14; kind = k == 0 ? K_POOL : k == 1 ? K_GPOOL : k == 2 ? K_G3 : K_G4; return; }
    L = 3; const int k = p - 18;
    kind = k == 0 ? K_GPROJ : k == 1 ? K_MLAN1 : k == 2 ? K_GUP : k == 3 ? K_MLAN2 : k == 4 ? K_ATT : k == 5 ? K_G2 : k == 6 ? K_G3 : K_G4;
}

#define XB_TMO      128
#define XB_XCNT(j)  (256  + 64 * (j))
#define XB_XSUB(j)  (1280 + 64 * (j))
#define XB_XGEN(j)  (2304 + 64 * (j))
#define XB_TOP      3328
#define XB_TOPGEN   3392
#define XCD_BAR_WORDS 3456
#define XB_SPIN_CAP (1u << 18)

__device__ __forceinline__ unsigned xb_ld(unsigned* p)              { return __hip_atomic_load(p, __ATOMIC_RELAXED, __HIP_MEMORY_SCOPE_AGENT); }
__device__ __forceinline__ unsigned xb_add(unsigned* p, unsigned v) { return __hip_atomic_fetch_add(p, v, __ATOMIC_RELAXED, __HIP_MEMORY_SCOPE_AGENT); }
__device__ __forceinline__ unsigned xb_xcc_id() { return (unsigned)__builtin_amdgcn_s_getreg((3 << 11) | 20) & 0xFu; }
#define XB_SPIN(cond, bar) do { unsigned _sp = 0; while (cond) { __builtin_amdgcn_s_sleep(1); \
    if ((++_sp & 255u) == 0u) { if (xb_ld(&(bar)[XB_TMO])) break; if (_sp > XB_SPIN_CAP) { atomicAdd(&(bar)[XB_TMO], 1u); break; } } } } while (0)

struct XcdBarrier {
    unsigned* bar; unsigned x;
    volatile LAS unsigned* st;
};

__device__ __forceinline__ XcdBarrier xcd_barrier_post(unsigned* bar, volatile LAS unsigned* st) {
    XcdBarrier b; b.bar = bar; b.x = xb_xcc_id(); b.st = st;
    if (threadIdx.x == 0) (void)xb_add(&bar[XB_XCNT(b.x)], 1u);
    return b;
}
__device__ __forceinline__ void xcd_barrier_complete(unsigned* bar, unsigned x, unsigned& nloc, unsigned& nx) {
    const unsigned G = gridDim.x * gridDim.y * gridDim.z;
    unsigned sum, cnt, mine, sp = 0u;
    for (;;) {
        sum = 0u; cnt = 0u; mine = 0u;
#pragma unroll
        for (unsigned j = 0; j < 16; ++j) { const unsigned c = xb_ld(&bar[XB_XCNT(j)]); sum += c; cnt += (c > 0u) ? 1u : 0u; mine = (j == x) ? c : mine; }
        if (sum == G) break;
        __builtin_amdgcn_s_sleep(1);
        if ((++sp & 255u) == 0u) { if (xb_ld(&bar[XB_TMO])) break; if (sp > XB_SPIN_CAP) { atomicAdd(&bar[XB_TMO], 1u); break; } }
    }
    nloc = mine > 0u ? mine : 1u; nx = cnt > 0u ? cnt : 1u;
}

__device__ __forceinline__ void xcd_barrier(const XcdBarrier& b) {
    asm volatile("s_waitcnt vmcnt(0)" ::: "memory");
    __syncthreads();
    if (threadIdx.x == 0) {
        unsigned* bar = b.bar;
        __builtin_amdgcn_s_waitcnt(0);
        unsigned nloc = b.st[0], nx = b.st[1];
        if (nloc == 0u) { xcd_barrier_complete(bar, b.x, nloc, nx); b.st[0] = nloc; b.st[1] = nx; }
        const unsigned old = xb_add(&bar[XB_XSUB(b.x)], 1u);
        const unsigned gen = old / nloc;
        if (old + 1u == (gen + 1u) * nloc) {
            __builtin_amdgcn_fence(__ATOMIC_RELEASE, "agent");
            asm volatile("s_waitcnt vmcnt(0)" ::: "memory");
            const unsigned og = xb_add(&bar[XB_TOP], 1u);
            const unsigned tg = og / nx;
            if (og + 1u == (tg + 1u) * nx) xb_add(&bar[XB_TOPGEN], 1u);
            else XB_SPIN(xb_ld(&bar[XB_TOPGEN]) == tg, bar);
            __builtin_amdgcn_fence(__ATOMIC_ACQUIRE, "agent");
            xb_add(&bar[XB_XGEN(b.x)], 1u);
            asm volatile("s_waitcnt vmcnt(0)" ::: "memory");
        } else {
            XB_SPIN(xb_ld(&bar[XB_XGEN(b.x)]) == gen, bar);
            __builtin_amdgcn_fence(__ATOMIC_ACQUIRE, "agent");
            asm volatile("s_waitcnt vmcnt(0)" ::: "memory");
        }
    }
    __syncthreads();
}

#ifndef PROBE_KIND
#define PROBE_KIND -1
#endif
#ifndef PROBE_N
#define PROBE_N 0
#endif
#ifndef PROBE_L
#define PROBE_L -1
#endif
#ifndef PROBE_PLAIN
#define PROBE_PLAIN 0
#endif
#ifndef PROBE_SYNC
#define PROBE_SYNC 0
#endif
__global__ void __launch_bounds__(NTHREADS) fwd_kernel(Args a_by_value) {
    extern __shared__ __attribute__((aligned(16))) unsigned char lds_raw[];
    LAS unsigned char* lds = (LAS unsigned char*)lds_raw;
    cg::grid_group grid = cg::this_grid();
    const int ph_lo = a_by_value.ph_lo, ph_hi = a_by_value.ph_hi;
    volatile LAS unsigned* MISC = (volatile LAS unsigned*)(lds + 131072);
    if (threadIdx.x < 4) MISC[threadIdx.x] = 0u;
    __syncthreads();
    const XcdBarrier xbar = xcd_barrier_post((unsigned*)(a_by_value.ws + WS_CTL), MISC);
    if (ph_hi > 4096) grid.sync();
    for (int q = ph_lo * (1 + PROBE_N); q < ph_hi * (1 + PROBE_N); ++q) {
        const int p = q / (1 + PROBE_N);
        int L, kind; decode_phase(p, L, kind);
        const bool extra_visit = PROBE_N > 0 && (q % (1 + PROBE_N)) != 0;
        if (extra_visit && (kind != PROBE_KIND || (PROBE_L >= 0 && L != PROBE_L))) continue;
        KArgs a = (KArgs)__builtin_amdgcn_kernarg_segment_ptr(); asm volatile("" : "+s"(a));
        unsigned char* ws = a->ws;
        const float* MOD = (const float*)(ws + WS_MOD);
        float* HC = (float*)(ws + WS_HC);
        bf16_t* RA = (bf16_t*)(ws + WS_RA); bf16_t* RO = (bf16_t*)(ws + WS_RO); bf16_t* RB = (bf16_t*)(ws + WS_RB);
        int TID = threadIdx.x; asm volatile("" : "+v"(TID));
        const float* modL = MOD + (size_t)L * NMODB * MODLD;
        const int Mffn = L == 3 ? LAT : MTOT;
        if (kind == K_PRO) {
            prologue_phase(TID, a, lds);
        } else if (kind == K_N1) {
            norm_phase(TID, a->in[0], a->in[2], MTOT, a->in[6], modL, modL + DM, RA);
        } else if (kind == K_G1 || kind == K_GPROJ || kind == K_GUP) {
            const int nrep = kind == K_GUP ? 2 : 1;
            for (int rep = 0; rep < nrep; ++rep) {
                pg8::Gemm g; pg8::EpiStore E;
                if (kind == K_G1) { const int N = L == 0 ? 1536 : 3072; g = pg8::Gemm{RA, (const bf16_t*)(ws + (L == 0 ? WS_SWA_QKV : WS_NA_QKV)), MTOT, N, DM, DM, DM, 0}; E = pg8::EpiStore{RB, N}; }
                else if (kind == K_GPROJ) { g = pg8::Gemm{RA, (const bf16_t*)(ws + WS_MLA_WA), MTOT, 512, DM, DM, DM, 0}; E = pg8::EpiStore{(bf16_t*)(ws + WS_PROJ), 512}; }
                else if (rep == 0) { g = pg8::Gemm{(const bf16_t*)(ws + WS_PROJ), (const bf16_t*)(ws + WS_MLA_WUQ), LAT, 1536, 256, 512, 256, 0}; E = pg8::EpiStore{(bf16_t*)(ws + WS_QR), 1536}; }
                else { g = pg8::Gemm{(const bf16_t*)(ws + WS_PROJ) + 256, (const bf16_t*)(ws + WS_MLA_WUKV), MTOT, 2048, 128, 512, 128, 0}; E = pg8::EpiStore{(bf16_t*)(ws + WS_KV), 2048}; }
                pg8::StaticOrder S; S.init(g.M, g.N, (int)gridDim.x, (int)blockIdx.x);
                pg8::gemm_phase<pg8::EpiStore, pg8::StaticOrder, true, true>(lds, g, S, E);
            }
        } else if (kind == K_G3) {
            pg8::Gemm g{L == 3 ? RO : RA, (const bf16_t*)(ws + WS_WGU + (size_t)L * SZ_WGU), Mffn, 2 * DFF, DM, DM, DM, 0};
            pg8::EpiSwiglu E{RB, DFF};
            pg8::StaticOrder S; S.init(g.M, g.N, (int)gridDim.x, (int)blockIdx.x);
            pg8::gemm_phase<pg8::EpiSwiglu, pg8::StaticOrder, true, true>(lds, g, S, E);
        } else if (kind == K_G2 || kind == K_GPOOL || kind == K_G4) {
            pg8::Gemm g; pg8::EpiResid E;
            E.first = (L == 0 && kind == K_G2) ? 1 : 0; E.pool = kind == K_GPOOL ? 1 : 0; E.mod_byte = (unsigned)WS_MOD; E.hc_byte = (unsigned)WS_HC;
            E.gate_off = L * NMODB * MODLD + (kind == K_G4 ? 5 * DM : 2 * DM);
            const bool ffn = kind == K_G4;
            const int Ln = ffn ? L + 1 : L, pi = 2 * L + (ffn ? 1 : 0) - (L == 3 ? 0 : 0);
            E.donorm = ((ffn && L == 3) || (PROBE_PLAIN && extra_visit)) ? 0 : 1; E.g_in = ffn ? 6 : 7; E.g_off = Ln * DM; E.nmod_off = Ln * NMODB * MODLD + (ffn ? 0 : 3 * DM);
            E.a_byte = (L == 3 && !ffn) ? WS_RO : WS_RA; E.cnt_byte = (unsigned)(WS_CNT + (size_t)pi * 144 * 64); E.xbuf_byte = WS_XBUF + (size_t)pi * MTOT * 16;
            if (kind == K_G2) { const size_t wo = L == 0 ? WS_SWA_WO : L == 1 ? WS_NA_WO : WS_MLA_WO; g = pg8::Gemm{L == 3 ? RA : RO, (const bf16_t*)(ws + wo), Mffn, DM, DM, DM, DM, 0}; }
            else if (kind == K_GPOOL) { g = pg8::Gemm{RO, (const bf16_t*)(ws + WS_POOL), MTOT, DM, 256, DM, 256, 256}; }
            else { g = pg8::Gemm{RB, (const bf16_t*)(ws + WS_WDN + (size_t)L * SZ_WDN), Mffn, DM, DFF, DFF, DFF, 0}; }
            pg8::PanelOrder S; S.init(g.M, g.N, (int)gridDim.x, (int)blockIdx.x);
            pg8::gemm_phase<pg8::EpiResid, pg8::PanelOrder, true, true>(lds, g, S, E);
        } else if (kind == K_QKN) {
            if (L == 0) qknorm_phase(TID, RB, 1536, 16, 4, a->in[11], a->in[12], true, 0.125f * LOG2E, lds);
            else qknorm_phase(TID, RB, 3072, 16, 16, a->in[16], a->in[17], false, 0.125f * LOG2E, lds);
        } else if (kind == K_ATT) {
            if (L == 0) attn_phase<0>(TID, a, lds); else if (L == 1) attn_phase<1>(TID, a, lds); else attn_phase<2>(TID, a, lds);
        } else if (kind == K_POOL) {
            pool_phase(TID, RA, RO);
        } else if (kind == K_MLAN1) {
            mlanorm1_phase(TID, (bf16_t*)(ws + WS_PROJ), a->in[24], a->in[25]);
        } else if (kind == K_MLAN2) {
            mlanorm2_phase(TID, (bf16_t*)(ws + WS_QR), (bf16_t*)(ws + WS_KV), (const bf16_t*)(ws + WS_PROJ), (bf16_t*)(ws + WS_KR), a->in[28], a->in[29], 0.10206207261596577f * LOG2E, lds);
        }
        if (q + 1 < ph_hi * (1 + PROBE_N)) { xcd_barrier(xbar); for (int e = 0; e < PROBE_SYNC; ++e) xcd_barrier(xbar); }
    }
}

#ifndef MK_PER_PHASE
#define MK_PER_PHASE 0
#endif
extern "C" void kernel_launch(void* const* d_in, const int* in_sizes, int n_in, void* d_out, int out_size, void* d_ws, size_t ws_size, hipStream_t stream) {
    static int grid = 0;
    if (grid == 0) {
        if (n_in != 31 || in_sizes[0] != LAT * DM || out_size != LAT * DM || ws_size < WS_END) { fprintf(stderr, "kernel_launch: unexpected shapes (n_in %d, in0 %d, out %d, ws %zu < %zu)\n", n_in, n_in > 0 ? in_sizes[0] : -1, out_size, ws_size, (size_t)WS_END); grid = -1; return; }
        int dev = 0, cus = 0, per_cu = 0;
        if (hipGetDevice(&dev) != hipSuccess || hipDeviceGetAttribute(&cus, hipDeviceAttributeMultiprocessorCount, dev) != hipSuccess) { fprintf(stderr, "kernel_launch: device query failed\n"); grid = -1; return; }
        if (hipFuncSetAttribute((const void*)fwd_kernel, hipFuncAttributeMaxDynamicSharedMemorySize, LDS_BYTES) != hipSuccess) { fprintf(stderr, "kernel_launch: hipFuncSetAttribute failed\n"); grid = -1; return; }
        if (hipOccupancyMaxActiveBlocksPerMultiprocessor(&per_cu, (const void*)fwd_kernel, NTHREADS, LDS_BYTES) != hipSuccess || per_cu < 1) { fprintf(stderr, "kernel_launch: occupancy query says %d blocks per CU\n", per_cu); per_cu = 1; }
        (void)hipGetLastError();
        grid = cus * (per_cu > 1 ? 1 : per_cu);
        if (grid % 32 != 0) { fprintf(stderr, "kernel_launch: grid %d is not a multiple of 32 (the fused norm epilogues deal row panels to 4 workgroups per XCD)\n", grid); grid = -1; return; }
    }
    if (grid < 0) return;
    Args a{};
    for (int i = 0; i < 31; ++i) a.in[i] = (const float*)d_in[i];
    a.out = (float*)d_out; a.ws = (unsigned char*)d_ws;
#if MK_PER_PHASE
    for (int p = 0; p < NPHASES; ++p) { a.ph_lo = p; a.ph_hi = p + 1; hipLaunchKernelGGL(fwd_kernel, dim3(grid), dim3(NTHREADS), LDS_BYTES, stream, a); }
#else
    a.ph_lo = 0; a.ph_hi = NPHASES;
    if (hipMemsetAsync((char*)d_ws + WS_CTL, 0, CTL_ZERO_BYTES, stream) != hipSuccess) { fprintf(stderr, "kernel_launch: memset of the barrier words failed\n"); return; }
    void* args[] = {&a};
    hipError_t e = hipLaunchCooperativeKernel((const void*)fwd_kernel, dim3(grid), dim3(NTHREADS), args, LDS_BYTES, stream);
    if (e != hipSuccess) fprintf(stderr, "kernel_launch: cooperative launch failed: %s (grid %d)\n", hipGetErrorString(e), grid);
#endif
}
```

```cpp
#include <hip/hip_runtime.h>
#include <hip/hip_cooperative_groups.h>
#include <cstdio>
#include <cstdint>
#include <cmath>
namespace cg = cooperative_groups;

namespace pg8 {
#define PG8_LAS __attribute__((address_space(3)))
typedef unsigned short bf16_t;
typedef short bf16x8 __attribute__((ext_vector_type(8)));
typedef float f32x4 __attribute__((ext_vector_type(4)));
typedef unsigned u32x4 __attribute__((ext_vector_type(4)));
typedef unsigned u32x2 __attribute__((ext_vector_type(2)));
constexpr int BM = 256, BK = 64, HALF = 128, HTB = HALF * BK * 2  , STAGE_BYTES = 8 * HTB, NXCD = 8, WGM = 8;

__host__ __device__ __forceinline__ int lds_byte(int r, int c) { const int st = (r >> 4) * 2 + (c >> 5), rr = r & 15, cc = c & 31, ob = rr * 64 + cc * 2; return st * 1024 + (ob ^ (((ob >> 9) & 1) << 5)); }
__host__ __device__ __forceinline__ void stage_rc(int b, int& R, int& C) { const int st = b / 1024, sb = b % 1024, swz = sb ^ (((sb >> 9) & 1) << 5); R = (st >> 1) * 16 + swz / 64; C = (st & 1) * 32 + (swz % 64) / 2; }
__host__ __device__ __forceinline__ int perm32(int rho) { const int n = rho >> 4, i = rho & 15; return 8 * (i >> 2) + 4 * n + (i & 3); }

struct Unit { int pm, pn; };
struct Gemm { const bf16_t* A; const bf16_t* Bt; int M, N, K, lda, ldb, akoff; };

struct StaticOrder {
    int nM, nN, nwg, G, c;
    __host__ __device__ void init(int M, int N, int G_, int c_) { nM = M / BM; nN = N / BM; nwg = nM * nN; G = G_; c = c_; }
    __host__ __device__ bool next(int i, Unit& u) const {
        const long L = (long)i * G + c; if (L >= nwg) return false;
        int wgid = (int)L; { const int q = nwg / NXCD, r = nwg % NXCD, xcd = wgid % NXCD, off = wgid / NXCD; wgid = (xcd < r ? xcd * (q + 1) : r * (q + 1) + (xcd - r) * q) + off; }
        const int nig = WGM * nN, gid = wgid / nig, fm = gid * WGM, gsz = (nM - fm) < WGM ? (nM - fm) : WGM;
        u.pm = fm + ((wgid % nig) % gsz); u.pn = (wgid % nig) / gsz; return true;
    }
    __device__ __forceinline__ void a_ready(const Unit&) const {}
    __device__ __forceinline__ void done(const Unit&) const {}
};

__device__ __forceinline__ unsigned cvt_pk_bf16(float lo, float hi) { unsigned r; asm volatile("v_cvt_pk_bf16_f32 %0, %1, %2" : "=v"(r) : "v"(lo), "v"(hi)); return r; }

struct EpiStore {
    static constexpr bool PERM = true, AFTER_DRAIN = false, WITH_LDS = false;
    bf16_t* O; int ldc;
    __device__ __forceinline__ void operator()(const f32x4 (&acc)[2][2][4][2], const Unit& u, int wr, int wc, int fr, int fq) const {
        const int row0 = u.pm * BM + wr * 64 + fr, col0 = u.pn * BM + wc * 32 + 8 * fq;
#pragma unroll
        for (int ai = 0; ai < 2; ++ai)
#pragma unroll
            for (int m = 0; m < 4; ++m) { bf16_t* rowp = O + (size_t)(row0 + ai * HALF + m * 16) * ldc + col0;
#pragma unroll
                for (int bj = 0; bj < 2; ++bj) { const f32x4 v0 = acc[ai][bj][m][0], v1 = acc[ai][bj][m][1];
                    u32x4 w; w.x = cvt_pk_bf16(v0[0], v0[1]); w.y = cvt_pk_bf16(v0[2], v0[3]); w.z = cvt_pk_bf16(v1[0], v1[1]); w.w = cvt_pk_bf16(v1[2], v1[3]);
                    *(u32x4*)(rowp + bj * HALF) = w; } }
    }
};
__device__ __forceinline__ float silu_mul(float g, float u) { return g * u * __builtin_amdgcn_rcpf(1.0f + __builtin_amdgcn_exp2f(-1.4426950408889634f * g)); }
struct EpiSwiglu {
    static constexpr bool PERM = true, AFTER_DRAIN = false, WITH_LDS = false;
    bf16_t* O; int ldc;
    __device__ __forceinline__ void operator()(const f32x4 (&acc)[2][2][4][2], const Unit& u, int wr, int wc, int fr, int fq) const {
        const int row0 = u.pm * BM + wr * 64 + fr, col0 = u.pn * HALF + wc * 32 + 8 * fq;
#pragma unroll
        for (int ai = 0; ai < 2; ++ai)
#pragma unroll
            for (int m = 0; m < 4; ++m) { bf16_t* rowp = O + (size_t)(row0 + ai * HALF + m * 16) * ldc + col0;
                const f32x4 g0 = acc[ai][0][m][0], g1 = acc[ai][0][m][1], u0 = acc[ai][1][m][0], u1 = acc[ai][1][m][1];
                u32x4 w; w.x = cvt_pk_bf16(silu_mul(g0[0], u0[0]), silu_mul(g0[1], u0[1])); w.y = cvt_pk_bf16(silu_mul(g0[2], u0[2]), silu_mul(g0[3], u0[3]));
                w.z = cvt_pk_bf16(silu_mul(g1[0], u1[0]), silu_mul(g1[1], u1[1])); w.w = cvt_pk_bf16(silu_mul(g1[2], u1[2]), silu_mul(g1[3], u1[3]));
                *(u32x4*)rowp = w; }
    }
};
constexpr int EP_LAT = 32768, EP_SEQ = 2048, EP_D = 1024, EP_MODLD = 6144;
struct EpiArgs { const float* in[31]; float* out; unsigned char* ws; int ph_lo, ph_hi; };
struct EpiQKV {
    static constexpr bool PERM = true, AFTER_DRAIN = false, WITH_LDS = true;
    bf16_t* O; int ldc, nq, nk, rope, gq_in, gk_in; float qscale; unsigned rope_byte;
    __device__ __forceinline__ void run(f32x4 (&acc)[2][2][4][2], const Unit& u, int wr, int wc, int fr, int fq, PG8_LAS unsigned char* sl, int wid, int lane) const {
        const int row0 = u.pm * BM + wr * 64 + fr, col0 = u.pn * BM + wc * 32 + 8 * fq;
        if (u.pn < nq + nk) {
            const __attribute__((address_space(4))) EpiArgs* a = (const __attribute__((address_space(4))) EpiArgs*)__builtin_amdgcn_kernarg_segment_ptr(); asm volatile("" : "+s"(a));
            const bool isq = u.pn < nq;
            PG8_LAS float* P = (PG8_LAS float*)sl;
#pragma unroll
            for (int ai = 0; ai < 2; ++ai)
#pragma unroll
                for (int m = 0; m < 4; ++m)
#pragma unroll
                    for (int bj = 0; bj < 2; ++bj) { const f32x4 x0 = acc[ai][bj][m][0], x1 = acc[ai][bj][m][1];
                        float s = ((x0[0] * x0[0] + x0[1] * x0[1]) + (x0[2] * x0[2] + x0[3] * x0[3])) + ((x1[0] * x1[0] + x1[1] * x1[1]) + (x1[2] * x1[2] + x1[3] * x1[3]));
                        s += __shfl_xor(s, 16); s += __shfl_xor(s, 32);
                        if (fq == 0) P[((ai * HALF + wr * 64 + m * 16 + fr) * 2 + bj) * 4 + wc] = s; }
            asm volatile("s_waitcnt lgkmcnt(0)" ::: "memory"); __builtin_amdgcn_s_barrier(); asm volatile("" ::: "memory");
            const float* gp = (isq ? a->in[gq_in] : a->in[gk_in]) + (wc & 1) * 32 + 8 * fq;
            const f32x4 g0 = *(const f32x4*)gp, g1 = *(const f32x4*)(gp + 4);
            const float osc = isq ? qscale : 1.0f;
            const float* rt_ = (const float*)(a->ws + rope_byte) + 2 * (8 * (fq & 1));
            const bool x2 = fq >= 2;
#pragma unroll
            for (int ai = 0; ai < 2; ++ai)
#pragma unroll
                for (int m = 0; m < 4; ++m) { const int rl = ai * HALF + wr * 64 + m * 16 + fr, row = u.pm * BM + rl; bf16_t* rowp = O + (size_t)row * ldc + col0;
                    const bool dorope = rope && row < EP_LAT; const int t = row & (EP_SEQ - 1), pos = (wc & 1) ? (t & 63) : (t >> 6);
                    f32x4 c0 = {1.f, 1.f, 1.f, 1.f}, c1 = c0, s0 = {0.f, 0.f, 0.f, 0.f}, s1 = s0;
                    if (dorope) { const f32x4* tp = (const f32x4*)(rt_ + pos * 32); const f32x4 t0 = tp[0], t1 = tp[1], t2 = tp[2], t3 = tp[3];
                        c0 = (f32x4){t0[0], t0[2], t1[0], t1[2]}; s0 = (f32x4){t0[1], t0[3], t1[1], t1[3]}; c1 = (f32x4){t2[0], t2[2], t3[0], t3[2]}; s1 = (f32x4){t2[1], t2[3], t3[1], t3[3]}; }
#pragma unroll
                    for (int bj = 0; bj < 2; ++bj) { const PG8_LAS float* pp = P + (rl * 2 + bj) * 4;
                        const float rstd = 1.0f / sqrtf((pp[wc] + pp[wc ^ 1]) * (1.0f / 64.0f) + 1e-6f);
                        f32x4 v0 = acc[ai][bj][m][0] * rstd * g0, v1 = acc[ai][bj][m][1] * rstd * g1;
                        f32x4 p0, p1;
#pragma unroll
                        for (int j = 0; j < 4; ++j) { p0[j] = __shfl_xor(v0[j], 32); p1[j] = __shfl_xor(v1[j], 32); }
                        if (x2) { v0 = p0 * s0 + v0 * c0; v1 = p1 * s1 + v1 * c1; } else { v0 = v0 * c0 - p0 * s0; v1 = v1 * c1 - p1 * s1; }
                        v0 = v0 * osc; v1 = v1 * osc;
                        u32x4 w; w.x = cvt_pk_bf16(v0[0], v0[1]); w.y = cvt_pk_bf16(v0[2], v0[3]); w.z = cvt_pk_bf16(v1[0], v1[1]); w.w = cvt_pk_bf16(v1[2], v1[3]);
                        *(u32x4*)(rowp + bj * HALF) = w; } }
        } else {
#pragma unroll
            for (int ai = 0; ai < 2; ++ai)
#pragma unroll
                for (int m = 0; m < 4; ++m) { bf16_t* rowp = O + (size_t)(row0 + ai * HALF + m * 16) * ldc + col0;
#pragma unroll
                    for (int bj = 0; bj < 2; ++bj) { const f32x4 v0 = acc[ai][bj][m][0], v1 = acc[ai][bj][m][1];
                        u32x4 w; w.x = cvt_pk_bf16(v0[0], v0[1]); w.y = cvt_pk_bf16(v0[2], v0[3]); w.z = cvt_pk_bf16(v1[0], v1[1]); w.w = cvt_pk_bf16(v1[2], v1[3]);
                        *(u32x4*)(rowp + bj * HALF) = w; } }
        }
    }
};
struct EpiResid {
    static constexpr bool PERM = false, AFTER_DRAIN = false, WITH_LDS = true;
    int first;
    int gate_off;
    int pool;
    int donorm, g_in, g_off, nmod_off;
    unsigned mod_byte, hc_byte, cnt_byte; size_t a_byte, xbuf_byte;
    __device__ __forceinline__ void run(f32x4 (&acc)[2][2][4][2], const Unit& u, int wr, int wc, int fr, int fq, PG8_LAS unsigned char* sl, int wid, int lane) const {
        const __attribute__((address_space(4))) EpiArgs* a = (const __attribute__((address_space(4))) EpiArgs*)__builtin_amdgcn_kernarg_segment_ptr(); asm volatile("" : "+s"(a));
        unsigned char* ws = a->ws; float* HCp = (float*)(ws + hc_byte);
        const float* in_lat = first ? a->in[0] : a->out; const float* in_ctx = first ? a->in[2] : HCp; float* out_lat = a->out; float* out_ctx = HCp;
        const float* MODp = (const float*)(ws + mod_byte);
        const float* gate = MODp + gate_off; const float* bias = pool ? a->in[21] : nullptr; const float* cscale = pool ? a->in[22] : nullptr;
        const int rt = u.pm * BM; const bool isl = rt < EP_LAT; const int b = isl ? rt / EP_SEQ : 16;
        const float* ip = isl ? in_lat : in_ctx - (size_t)EP_LAT * EP_D; float* op = isl ? out_lat : out_ctx - (size_t)EP_LAT * EP_D;
        const int col0 = u.pn * BM + wc * 32 + 4 * fq; const float* gp = gate + (size_t)b * EP_MODLD + col0;
        {
        f32x4 gv[2][2], bv[2][2], sv[2][2];
#pragma unroll
        for (int bj = 0; bj < 2; ++bj)
#pragma unroll
            for (int n = 0; n < 2; ++n) { gv[bj][n] = *(const f32x4*)(gp + bj * HALF + n * 16);
                bv[bj][n] = bias ? *(const f32x4*)(bias + col0 + bj * HALF + n * 16) : (f32x4){0.f, 0.f, 0.f, 0.f};
                sv[bj][n] = cscale ? *(const f32x4*)(cscale + col0 + bj * HALF + n * 16) : (f32x4){1.f, 1.f, 1.f, 1.f}; }
#pragma unroll
        for (int ai = 0; ai < 2; ++ai)
#pragma unroll
            for (int m = 0; m < 4; ++m) { const size_t off = (size_t)(rt + ai * HALF + wr * 64 + m * 16 + fr) * EP_D + col0;
#pragma unroll
                for (int bj = 0; bj < 2; ++bj)
#pragma unroll
                    for (int n = 0; n < 2; ++n) { const f32x4 bs = *(const f32x4*)(ip + off + bj * HALF + n * 16);
                        const f32x4 h = bs + gv[bj][n] * ((acc[ai][bj][m][n] + bv[bj][n]) * sv[bj][n]);
                        if (!donorm) *(f32x4*)(op + off + bj * HALF + n * 16) = h; acc[ai][bj][m][n] = h; } }
        }
        if (!donorm) return;
        PG8_LAS float* P = (PG8_LAS float*)sl; PG8_LAS float* S = P + 1024;
#pragma unroll
        for (int ai = 0; ai < 2; ++ai)
#pragma unroll
            for (int m = 0; m < 4; ++m) { float s = 0.f;
#pragma unroll
                for (int bj = 0; bj < 2; ++bj)
#pragma unroll
                    for (int n = 0; n < 2; ++n) { const f32x4 x = acc[ai][bj][m][n]; s += (x[0] * x[0] + x[1] * x[1]) + (x[2] * x[2] + x[3] * x[3]); }
                s += __shfl_xor(s, 16); s += __shfl_xor(s, 32);
                if (fq == 0) P[(ai * HALF + wr * 64 + m * 16 + fr) * 4 + wc] = s; }
        asm volatile("s_waitcnt lgkmcnt(0)" ::: "memory"); __builtin_amdgcn_s_barrier(); asm volatile("" ::: "memory");
        const int tid = wid * 64 + lane;
        float* xb = (float*)(ws + xbuf_byte) + ((size_t)u.pm * BM) * 4;
        unsigned* cnt = (unsigned*)(ws + cnt_byte) + 16 * u.pm;
        if (tid < BM) { const float s = (P[tid * 4] + P[tid * 4 + 1]) + (P[tid * 4 + 2] + P[tid * 4 + 3]);
            __hip_atomic_store(xb + tid * 4 + u.pn, s, __ATOMIC_RELAXED, __HIP_MEMORY_SCOPE_AGENT); }
        asm volatile("s_waitcnt vmcnt(0)" ::: "memory");
        if (wid < 4 && lane == 0) __hip_atomic_fetch_add(cnt, 1u, __ATOMIC_RELAXED, __HIP_MEMORY_SCOPE_AGENT);
#pragma unroll
        for (int ai = 0; ai < 2; ++ai)
#pragma unroll
            for (int m = 0; m < 4; ++m) { const size_t off = (size_t)(rt + ai * HALF + wr * 64 + m * 16 + fr) * EP_D + col0;
#pragma unroll
                for (int bj = 0; bj < 2; ++bj)
#pragma unroll
                    for (int n = 0; n < 2; ++n) *(f32x4*)(op + off + bj * HALF + n * 16) = acc[ai][bj][m][n]; }
        if (wid == 0) { unsigned sp = 0u;
            while ((unsigned)__builtin_amdgcn_readfirstlane(__hip_atomic_load(cnt, __ATOMIC_RELAXED, __HIP_MEMORY_SCOPE_AGENT)) < 16u) { __builtin_amdgcn_s_sleep(2); if (++sp > (1u << 22)) break; }
            __builtin_amdgcn_fence(__ATOMIC_ACQUIRE, "agent"); }
        asm volatile("s_waitcnt lgkmcnt(0)" ::: "memory"); __builtin_amdgcn_s_barrier(); asm volatile("" ::: "memory");
        if (tid < BM) { float t = 0.f;
#pragma unroll
            for (int k = 0; k < 4; ++k) t += __hip_atomic_load(xb + tid * 4 + k, __ATOMIC_RELAXED, __HIP_MEMORY_SCOPE_AGENT);
            S[tid] = 1.0f / sqrtf(t * (1.0f / EP_D) + 1e-6f); }
        asm volatile("s_waitcnt lgkmcnt(0)" ::: "memory"); __builtin_amdgcn_s_barrier(); asm volatile("" ::: "memory");
        bf16_t* Ap = (bf16_t*)(ws + a_byte);
        const float* gnp = a->in[g_in] + g_off + col0; const float* shp = MODp + nmod_off + (size_t)b * EP_MODLD + col0; const float* scp = shp + 1024;
        f32x4 wv[2][2], hv[2][2];
#pragma unroll
        for (int bj = 0; bj < 2; ++bj)
#pragma unroll
            for (int n = 0; n < 2; ++n) { wv[bj][n] = *(const f32x4*)(gnp + bj * HALF + n * 16) * (*(const f32x4*)(scp + bj * HALF + n * 16) + 1.0f); hv[bj][n] = *(const f32x4*)(shp + bj * HALF + n * 16); }
#pragma unroll
        for (int ai = 0; ai < 2; ++ai)
#pragma unroll
            for (int m = 0; m < 4; ++m) { const int rl = ai * HALF + wr * 64 + m * 16 + fr; const float rs = S[rl]; bf16_t* arow = Ap + (size_t)(rt + rl) * EP_D + col0;
#pragma unroll
                for (int bj = 0; bj < 2; ++bj)
#pragma unroll
                    for (int n = 0; n < 2; ++n) { const f32x4 y = (acc[ai][bj][m][n] * rs) * wv[bj][n] + hv[bj][n];
                        u32x2 w; w.x = cvt_pk_bf16(y[0], y[1]); w.y = cvt_pk_bf16(y[2], y[3]); *(u32x2*)(arow + bj * HALF + n * 16) = w; } }
    }
};
struct PanelOrder {
    int nM, G, x, y;
    __device__ void init(int M, int N, int G_, int c_) { nM = M / BM; G = G_; x = c_ & 7; y = c_ >> 3; (void)N; }
    __device__ bool next(int i, Unit& u) const {
        const int ppr = G / 4, base = i * ppr; if (base >= nM) return false;
        int rem = nM - base; rem = rem > ppr ? ppr : rem;
        const int per_x = (rem + 7) / 8, q = y >> 2; if (q >= per_x) return false;
        const int pm = base + x * per_x + q; if (pm >= nM) return false;
        u.pm = pm; u.pn = y & 3; return true;
    }
    __device__ __forceinline__ void a_ready(const Unit&) const {}
    __device__ __forceinline__ void done(const Unit&) const {}
};

template <class Epi, class Sched, bool ALIGN_EPI = false, bool SP2 = false>
__device__ __forceinline__ void gemm_phase(PG8_LAS unsigned char* lds, const Gemm g, const Sched& S, const Epi& E) {
    int tid_ = threadIdx.x; asm volatile("" : "+v"(tid_));
    const int tid = tid_, wid = __builtin_amdgcn_readfirstlane(tid >> 6), lane = tid & 63, wr = wid >> 2, wc = wid & 3, fr = lane & 15, fq = lane >> 4;
    const int K = g.K, nt = K / BK;
    unsigned voffA[2], voffB[2];
#pragma unroll
    for (int i = 0; i < 2; ++i) { int R, C; stage_rc(tid * 16 + i * 8192, R, C); const int Rb = Epi::PERM ? ((R & ~31) + perm32(R & 31)) : R;
        voffA[i] = (unsigned)(R * g.lda + C) * 2u; voffB[i] = (unsigned)(Rb * g.ldb + C) * 2u; }
    const size_t kstep = (size_t)(BK * 2);
    const size_t hstepA = (size_t)HALF * g.lda * 2, hstepB = (size_t)HALF * g.ldb * 2;
    const size_t tstepA = 2 * hstepA, tstepB = 2 * hstepB; const size_t akoff = (size_t)g.akoff * 2;
    const unsigned ldsw = (unsigned)wid * 1024u;
    const int aoff = lds_byte(wr * 64 + fr, fq * 8), boff = lds_byte(wc * 32 + fr, fq * 8);
#define PG8_SA(b, h) (((b) * 2 + (h)) * HTB)
#define PG8_SB(b, h) ((4 + (b) * 2 + (h)) * HTB)
#define PG8_STAGE(bufoff, gbase, voff) do { _Pragma("unroll") for (int _i = 0; _i < 2; ++_i) \
        __builtin_amdgcn_global_load_lds((const unsigned*)((const char*)(gbase) + (voff)[_i]), (PG8_LAS unsigned*)(lds + (bufoff) + ldsw + _i * 8192), 16, 0, 0); } while (0)
#define PG8_LDA(dst, b, h) do { _Pragma("unroll") for (int m = 0; m < 4; ++m) _Pragma("unroll") for (int k = 0; k < 2; ++k) dst[m][k] = *(const PG8_LAS bf16x8*)(lds + PG8_SA(b, h) + aoff + m * 2048 + k * 1024); } while (0)
#define PG8_LDB(dst, b, h) do { _Pragma("unroll") for (int n = 0; n < 2; ++n) _Pragma("unroll") for (int k = 0; k < 2; ++k) dst[n][k] = *(const PG8_LAS bf16x8*)(lds + PG8_SB(b, h) + boff + n * 2048 + k * 1024); } while (0)
#define PG8_MMA(ai, bj, At, Bt) do { __builtin_amdgcn_s_setprio(1); _Pragma("unroll") for (int m = 0; m < 4; ++m) _Pragma("unroll") for (int n = 0; n < 2; ++n) _Pragma("unroll") for (int k = 0; k < 2; ++k) \
        acc[ai][bj][m][n] = __builtin_amdgcn_mfma_f32_16x16x32_bf16(Bt[n][k], At[m][k], acc[ai][bj][m][n], 0, 0, 0); __builtin_amdgcn_s_setprio(0); } while (0)
#define PG8_WAIT_V(n) asm volatile("s_waitcnt vmcnt(" #n ")" ::: "memory")
#define PG8_WAIT_L(n) asm volatile("s_waitcnt lgkmcnt(" #n ")" ::: "memory")
#define PG8_BAR __builtin_amdgcn_s_barrier()
#define PG8_SCHED __builtin_amdgcn_sched_barrier(0)
    Unit cur, nxt; int ui = 0;
    if (!S.next(0, cur)) return;
    f32x4 acc[2][2][4][2];
#pragma unroll
    for (int a = 0; a < 2; ++a)
#pragma unroll
        for (int b = 0; b < 2; ++b)
#pragma unroll
            for (int m = 0; m < 4; ++m)
#pragma unroll
                for (int n = 0; n < 2; ++n) acc[a][b][m][n] = (f32x4){0.f, 0.f, 0.f, 0.f};
    bf16x8 At[4][2], B0[2][2], B1[2][2];
    const char* cA = (const char*)g.A + (size_t)cur.pm * tstepA + (size_t)cur.pn * akoff; const char* cB = (const char*)g.Bt + (size_t)cur.pn * tstepB;
    S.a_ready(cur);
    if constexpr (SP2) {
        PG8_STAGE(PG8_SB(0, 0), cB, voffB); PG8_STAGE(PG8_SB(0, 1), cB + hstepB, voffB); PG8_STAGE(PG8_SA(0, 0), cA, voffA); PG8_STAGE(PG8_SA(0, 1), cA + hstepA, voffA);
        if (wr == 1) PG8_BAR;
        PG8_WAIT_V(2); PG8_BAR;
        PG8_STAGE(PG8_SB(1, 0), cB + kstep, voffB); PG8_STAGE(PG8_SA(1, 0), cA + kstep, voffA); PG8_STAGE(PG8_SB(1, 1), cB + hstepB + kstep, voffB);
        PG8_WAIT_V(6); PG8_BAR;
    } else {
        PG8_STAGE(PG8_SB(0, 0), cB, voffB); PG8_STAGE(PG8_SA(0, 0), cA, voffA); PG8_STAGE(PG8_SB(0, 1), cB + hstepB, voffB); PG8_STAGE(PG8_SA(0, 1), cA + hstepA, voffA);
        if (wr == 1) PG8_BAR;
        PG8_WAIT_V(4); PG8_BAR;
        PG8_STAGE(PG8_SB(1, 0), cB + kstep, voffB); PG8_STAGE(PG8_SA(1, 0), cA + kstep, voffA); PG8_STAGE(PG8_SB(1, 1), cB + hstepB + kstep, voffB);
        PG8_WAIT_V(6); PG8_BAR;
    }
    for (;;) {
        const bool has_next = S.next(ui + 1, nxt);
        const char* nA = has_next ? (const char*)g.A + (size_t)nxt.pm * tstepA + (size_t)nxt.pn * akoff : cA; const char* nB = has_next ? (const char*)g.Bt + (size_t)nxt.pn * tstepB : cB;
        for (int t = 0; t < nt; t += 2) {
            const bool last = (t == nt - 2);
            const char* a1 = cA + (size_t)(t + 1) * kstep;
            const char* a2 = last ? nA : cA + (size_t)(t + 2) * kstep; const char* b2 = last ? nB : cB + (size_t)(t + 2) * kstep;
            const char* a3 = a2 + kstep; const char* b3 = b2 + kstep;
            if (last && has_next) S.a_ready(nxt);
            if constexpr (SP2) {
            PG8_LDB(B0, 0, 0); PG8_LDB(B1, 0, 1); PG8_SCHED; PG8_LDA(At, 0, 0); PG8_STAGE(PG8_SA(1, 1), a1 + hstepA, voffA);
            PG8_WAIT_V(8); PG8_WAIT_L(0); PG8_BAR; PG8_MMA(0, 0, At, B0); PG8_MMA(0, 1, At, B1); PG8_BAR; PG8_SCHED;
            PG8_LDA(At, 0, 1); PG8_STAGE(PG8_SB(0, 0), b2, voffB); PG8_STAGE(PG8_SB(0, 1), b2 + hstepB, voffB); PG8_STAGE(PG8_SA(0, 0), a2, voffA);
            PG8_WAIT_V(8); PG8_WAIT_L(0); PG8_BAR; PG8_MMA(1, 0, At, B0); PG8_MMA(1, 1, At, B1); PG8_BAR; PG8_SCHED;
            PG8_LDB(B0, 1, 0); PG8_LDB(B1, 1, 1); PG8_SCHED; PG8_LDA(At, 1, 0); PG8_STAGE(PG8_SA(0, 1), a2 + hstepA, voffA);
            PG8_WAIT_V(8); PG8_WAIT_L(0); PG8_BAR; PG8_MMA(0, 0, At, B0); PG8_MMA(0, 1, At, B1); PG8_BAR; PG8_SCHED;
            PG8_LDA(At, 1, 1); PG8_STAGE(PG8_SB(1, 0), b3, voffB); PG8_STAGE(PG8_SB(1, 1), b3 + hstepB, voffB); PG8_STAGE(PG8_SA(1, 0), a3, voffA);
            PG8_WAIT_V(8); PG8_WAIT_L(0); PG8_BAR; PG8_MMA(1, 0, At, B0); PG8_MMA(1, 1, At, B1); PG8_BAR; PG8_SCHED;
            } else {
            PG8_LDB(B0, 0, 0); PG8_SCHED; PG8_LDA(At, 0, 0); PG8_STAGE(PG8_SA(1, 1), a1 + hstepA, voffA);
            PG8_WAIT_L(8); PG8_BAR; PG8_WAIT_L(0); PG8_MMA(0, 0, At, B0); PG8_BAR; PG8_SCHED;
            PG8_LDB(B1, 0, 1); PG8_STAGE(PG8_SB(0, 0), b2, voffB);
            PG8_BAR; PG8_WAIT_L(0); PG8_MMA(0, 1, At, B1); PG8_BAR;
            PG8_LDA(At, 0, 1); PG8_STAGE(PG8_SA(0, 0), a2, voffA);
            PG8_BAR; PG8_WAIT_L(0); PG8_MMA(1, 0, At, B0); PG8_BAR; PG8_SCHED;
            PG8_STAGE(PG8_SB(0, 1), b2 + hstepB, voffB);
            PG8_WAIT_V(6); PG8_BAR; PG8_MMA(1, 1, At, B1); PG8_BAR;
            PG8_LDB(B0, 1, 0); PG8_SCHED; PG8_LDA(At, 1, 0); PG8_STAGE(PG8_SA(0, 1), a2 + hstepA, voffA);
            PG8_WAIT_L(8); PG8_BAR; PG8_WAIT_L(0); PG8_MMA(0, 0, At, B0); PG8_BAR; PG8_SCHED;
            PG8_LDB(B1, 1, 1); PG8_STAGE(PG8_SB(1, 0), b3, voffB);
            PG8_BAR; PG8_WAIT_L(0); PG8_MMA(0, 1, At, B1); PG8_BAR;
            PG8_LDA(At, 1, 1); PG8_STAGE(PG8_SA(1, 0), a3, voffA);
            PG8_BAR; PG8_WAIT_L(0); PG8_MMA(1, 0, At, B0); PG8_BAR; PG8_SCHED;
            PG8_STAGE(PG8_SB(1, 1), b3 + hstepB, voffB);
            PG8_WAIT_V(6); PG8_BAR; PG8_MMA(1, 1, At, B1); PG8_BAR;
            }
        }
        if constexpr (ALIGN_EPI) { if (wr == 0) PG8_BAR; }
        if constexpr (!Epi::AFTER_DRAIN) { if constexpr (Epi::WITH_LDS) E.run(acc, cur, wr, wc, fr, fq, lds + 131072 + 64, wid, lane); else E(acc, cur, wr, wc, fr, fq); S.done(cur); }
        if (!has_next) break;
#pragma unroll
        for (int a = 0; a < 2; ++a)
#pragma unroll
            for (int b = 0; b < 2; ++b)
#pragma unroll
                for (int m = 0; m < 4; ++m)
#pragma unroll
                    for (int n = 0; n < 2; ++n) acc[a][b][m][n] = (f32x4){0.f, 0.f, 0.f, 0.f};
        cur = nxt; cA = nA; cB = nB; ++ui;
        if constexpr (ALIGN_EPI) { if (wr == 1) PG8_BAR; }
    }
    PG8_WAIT_V(0);
    if constexpr (!ALIGN_EPI) { if (wr == 0) PG8_BAR; }
    PG8_BAR;
    if constexpr (Epi::AFTER_DRAIN) { E.fused(acc, cur, wr, wc, fr, fq, lds, wid, lane); S.done(cur); }
#undef PG8_SA
#undef PG8_SB
#undef PG8_STAGE
#undef PG8_LDA
#undef PG8_LDB
#undef PG8_MMA
#undef PG8_WAIT_V
#undef PG8_WAIT_L
#undef PG8_BAR
#undef PG8_SCHED
}
}

using pg8::bf16_t; using pg8::bf16x8; using pg8::f32x4; using pg8::u32x4;
typedef float f32x16 __attribute__((ext_vector_type(16)));
typedef unsigned u32x2 __attribute__((ext_vector_type(2)));
#define LAS __attribute__((address_space(3)))
constexpr int DM = 1024, NBATCH = 16, SEQ = 2048, LAT = NBATCH * SEQ, CTXL = 256, NCTX = NBATCH * CTXL, MTOT = LAT + NCTX, DFF = 2816, MODLD = 6 * DM, NMODB = 17;
constexpr float EPS = 1e-6f, LOG2E = 1.4426950408889634f;
constexpr int NTHREADS = 512, NWAVES = 8;
constexpr int LDS_BYTES = 143360;

constexpr size_t MiB = 1u << 20;
constexpr size_t WS_MOD = 0;
constexpr size_t WS_CTL = 1835008;
constexpr size_t WS_CNT = WS_CTL + 16384;
constexpr size_t CTL_ZERO_BYTES = 16384 + 7 * 144 * 64;
static_assert(WS_CNT + 7 * 144 * 64 <= 2 * MiB, "control words");
constexpr size_t WS_ROPE = 1916928;
static_assert(WS_ROPE >= WS_CNT + 7 * 144 * 64 && WS_ROPE + 8192 <= 2 * MiB, "rope table");
constexpr size_t WS_W = 2 * MiB;
constexpr size_t SZ_WGU = (size_t)2 * DFF * DM * 2, SZ_WDN = (size_t)DM * DFF * 2;
constexpr size_t WS_WGU = WS_W, WS_WDN = WS_WGU + 4 * SZ_WGU;
constexpr size_t WS_SWA_QKV = WS_WDN + 4 * SZ_WDN, WS_SWA_WO = WS_SWA_QKV + (size_t)1536 * DM * 2;
constexpr size_t WS_NA_QKV = WS_SWA_WO + (size_t)DM * DM * 2, WS_NA_WO = WS_NA_QKV + (size_t)3072 * DM * 2;
constexpr size_t WS_POOL = WS_NA_WO + (size_t)DM * DM * 2;
constexpr size_t WS_MLA_WA = WS_POOL + (size_t)DM * 256 * 2, WS_MLA_WUQ = WS_MLA_WA + (size_t)512 * DM * 2, WS_MLA_WUKV = WS_MLA_WUQ + (size_t)1536 * 256 * 2;
constexpr size_t WS_MLA_WO = WS_MLA_WUKV + (size_t)2048 * 128 * 2, WS_W_END = WS_MLA_WO + (size_t)DM * DM * 2;
constexpr size_t WS_HC = 86 * MiB;
constexpr size_t WS_RA = 102 * MiB;
constexpr size_t WS_RO = WS_RA + 72 * MiB;
constexpr size_t WS_RB = WS_RO + 72 * MiB;
constexpr size_t WS_XBUF = 507 * MiB;
constexpr size_t WS_END = WS_XBUF + (size_t)7 * MTOT * 16;
static_assert(WS_END <= 512 * MiB, "workspace");
static_assert(WS_W_END <= WS_HC, "weights fit");
static_assert(WS_RB + (size_t)MTOT * 3072 * 2 <= WS_XBUF && WS_RB + (size_t)MTOT * DFF * 2 <= WS_XBUF, "big region");
constexpr size_t WS_PROJ = WS_RO, WS_QR = WS_PROJ + (size_t)MTOT * 512 * 2, WS_KV = WS_QR + (size_t)LAT * 1536 * 2, WS_KR = WS_KV + (size_t)MTOT * 2048 * 2;
static_assert(WS_KR + (size_t)MTOT * 512 * 2 <= WS_XBUF, "mla region");

__device__ __forceinline__ unsigned f2bf(float f) { unsigned u = __builtin_bit_cast(unsigned, f); return (u + 0x7fffu + ((u >> 16) & 1u)) >> 16; }
__device__ __forceinline__ unsigned pk2(float lo, float hi) { return f2bf(lo) | (f2bf(hi) << 16); }
__device__ __forceinline__ float bflo(unsigned w) { return __builtin_bit_cast(float, w << 16); }
__device__ __forceinline__ float bfhi(unsigned w) { return __builtin_bit_cast(float, w & 0xffff0000u); }
__device__ __forceinline__ float wave_sum(float v) {
#pragma unroll
    for (int o = 1; o < 64; o <<= 1) v += __shfl_xor(v, o);
    return v;
}

struct Args { const float* in[31]; float* out; unsigned char* ws; int ph_lo, ph_hi; };
typedef const __attribute__((address_space(4))) Args* KArgs;

__device__ __forceinline__ void transpose_item(const float* W, int K, int N, bf16_t* WT, int drow0, int k0, int n0, LAS float* scr, int lane) {
#pragma unroll 8
    for (int i = 0; i < 32; ++i) { const int kk = 2 * i + (lane >> 5); scr[kk * 33 + (lane & 31)] = W[(size_t)(k0 + kk) * N + n0 + (lane & 31)]; }
    asm volatile("s_waitcnt lgkmcnt(0)" ::: "memory");
    const int c = lane & 7;
#pragma unroll
    for (int j = 0; j < 4; ++j) { const int n = (lane >> 3) + 8 * j; const LAS float* s = scr + (8 * c) * 33 + n;
        u32x4 o; o.x = pk2(s[0 * 33], s[1 * 33]); o.y = pk2(s[2 * 33], s[3 * 33]); o.z = pk2(s[4 * 33], s[5 * 33]); o.w = pk2(s[6 * 33], s[7 * 33]);
        *(u32x4*)(WT + (size_t)(drow0 + n) * K + k0 + 8 * c) = o; }
    asm volatile("s_waitcnt lgkmcnt(0)" ::: "memory");
}
__device__ __forceinline__ void transpose_job(const float* W, int K, int N, bf16_t* WT, int map, int item, LAS float* scr, int lane) {
    const int nblk = N / 32, kb = item / nblk, nb = item % nblk, k0 = 64 * kb, n0 = 32 * nb;
    int drow0 = n0;
    if (map == 1) { const bool up = n0 >= DFF; const int j = up ? n0 - DFF : n0; drow0 = (j >> 7) * 256 + (up ? 128 : 0) + (j & 127); }
    transpose_item(W, K, N, WT, drow0, k0, n0, scr, lane);
}
__device__ __forceinline__ void prologue_phase(const int TID, KArgs a, LAS unsigned char* lds) {
    const int tid = TID, lane = tid & 63, wave = tid >> 6;
    unsigned char* ws = a->ws;
    LAS float* scr = (LAS float*)(lds + wave * 16384);
    const int gw = blockIdx.x * NWAVES + wave, NGW = gridDim.x * NWAVES;
    constexpr int I_GU = (DM / 64) * (2 * DFF / 32), I_DN = (DFF / 64) * (DM / 32), I_SQ = (DM / 64) * (1536 / 32), I_SQ2 = (DM / 64) * (DM / 32), I_NQ = (DM / 64) * (3072 / 32);
    constexpr int I_PL = (256 / 64) * (256 / 32), I_WA = (DM / 64) * (416 / 32), I_UQ = (256 / 64) * (1536 / 32), I_UKV = (128 / 64) * (2048 / 32);
    constexpr int NITEMS = 4 * I_GU + 4 * I_DN + I_SQ + I_SQ2 + I_NQ + I_SQ2 + 4 * I_PL + I_WA + I_UQ + I_UKV + I_SQ2;
    for (int it = gw; it < NITEMS; it += NGW) {
        int r = it;
        if (r < 4 * I_GU) { const int l = r / I_GU; transpose_job(a->in[8] + (size_t)l * DM * 2 * DFF, DM, 2 * DFF, (bf16_t*)(ws + WS_WGU + l * SZ_WGU), 1, r % I_GU, scr, lane); continue; } r -= 4 * I_GU;
        if (r < 4 * I_DN) { const int l = r / I_DN; transpose_job(a->in[9] + (size_t)l * DFF * DM, DFF, DM, (bf16_t*)(ws + WS_WDN + l * SZ_WDN), 0, r % I_DN, scr, lane); continue; } r -= 4 * I_DN;
        if (r < I_SQ) { transpose_job(a->in[10], DM, 1536, (bf16_t*)(ws + WS_SWA_QKV), 0, r, scr, lane); continue; } r -= I_SQ;
        if (r < I_SQ2) { transpose_job(a->in[14], DM, DM, (bf16_t*)(ws + WS_SWA_WO), 0, r, scr, lane); continue; } r -= I_SQ2;
        if (r < I_NQ) { transpose_job(a->in[15], DM, 3072, (bf16_t*)(ws + WS_NA_QKV), 0, r, scr, lane); continue; } r -= I_NQ;
        if (r < I_SQ2) { transpose_job(a->in[19], DM, DM, (bf16_t*)(ws + WS_NA_WO), 0, r, scr, lane); continue; } r -= I_SQ2;
        if (r < 4 * I_PL) { const int g = r / I_PL; transpose_job(a->in[20] + (size_t)g * 65536, 256, 256, (bf16_t*)(ws + WS_POOL) + (size_t)g * 65536, 0, r % I_PL, scr, lane); continue; } r -= 4 * I_PL;
        if (r < I_WA) { transpose_job(a->in[23], DM, 416, (bf16_t*)(ws + WS_MLA_WA), 0, r, scr, lane); continue; } r -= I_WA;
        if (r < I_UQ) { transpose_job(a->in[26], 256, 1536, (bf16_t*)(ws + WS_MLA_WUQ), 0, r, scr, lane); continue; } r -= I_UQ;
        if (r < I_UKV) { transpose_job(a->in[27], 128, 2048, (bf16_t*)(ws + WS_MLA_WUKV), 0, r, scr, lane); continue; } r -= I_UKV;
        transpose_job(a->in[30], DM, DM, (bf16_t*)(ws + WS_MLA_WO), 0, r, scr, lane);
    }
    if (blockIdx.x == 0) { float* rt = (float*)(ws + WS_ROPE); for (int i = tid; i < 64 * 16; i += NTHREADS) { const int pos = i >> 4, f = i & 15; const float fr = powf(10000.0f, -(float)f / 16.0f); float sn, cs; sincosf((float)pos * fr, &sn, &cs); rt[2 * i] = cs; rt[2 * i + 1] = sn; } }
    { u32x4* z = (u32x4*)(ws + WS_MLA_WA + (size_t)416 * DM * 2); const int nz = 96 * DM * 2 / 16;
      for (int i = blockIdx.x * NTHREADS + tid; i < nz; i += gridDim.x * NTHREADS) z[i] = (u32x4){0u, 0u, 0u, 0u}; }
    __syncthreads();
    if ((int)blockIdx.x < 384) {
        LAS float* cond = (LAS float*)lds;
        LAS float* red = (LAS float*)(lds + 81920);
        for (int i = tid; i < NMODB * DM; i += NTHREADS) { const int b = i / DM, k = i % DM; const float v = b < 16 ? a->in[1][b * DM + k] : a->in[3][k];
            cond[k * 20 + b] = v / (1.0f + __expf(-v)); }
        __syncthreads();
        const int col = tid & 63, kg = tid >> 6;
        for (int u = blockIdx.x; u < 384; u += gridDim.x) {
            const int l = u / 96, cb = u % 96;
            const float* w = a->in[4] + (size_t)l * DM * MODLD + cb * 64 + col;
            float acc[NMODB];
#pragma unroll
            for (int b = 0; b < NMODB; ++b) acc[b] = 0.f;
#pragma unroll 4
            for (int k = kg * 128; k < kg * 128 + 128; ++k) { const float wv = w[(size_t)k * MODLD]; const LAS float* cp = cond + k * 20;
#pragma unroll
                for (int b = 0; b < NMODB; ++b) acc[b] += cp[b] * wv; }
#pragma unroll
            for (int b = 0; b < NMODB; ++b) red[(kg * NMODB + b) * 64 + col] = acc[b];
            __syncthreads();
            for (int i = tid; i < NMODB * 64; i += NTHREADS) { const int b = i >> 6, c = i & 63; float s = 0.f;
#pragma unroll
                for (int g = 0; g < 8; ++g) s += red[(g * NMODB + b) * 64 + c];
                ((float*)(ws + WS_MOD))[((size_t)l * NMODB + b) * MODLD + cb * 64 + c] = s + a->in[5][l * MODLD + cb * 64 + c]; }
            __syncthreads();
        }
    }
}

__device__ __forceinline__ void norm_phase(const int TID, const float* in_lat, const float* in_ctx, int M, const float* g, const float* sh, const float* sc, bf16_t* A) {
    const int lane = TID & 63, wave = TID >> 6;
    const int gw = blockIdx.x * NWAVES + wave, NGW = gridDim.x * NWAVES;
    f32x4 gv[4];
#pragma unroll
    for (int j = 0; j < 4; ++j) gv[j] = *(const f32x4*)(g + 4 * lane + 256 * j);
    for (int row = gw; row < M; row += NGW) {
        const float* xr = row < LAT ? in_lat + (size_t)row * DM : in_ctx + (size_t)(row - LAT) * DM;
        const int b = row < LAT ? row / SEQ : 16;
        f32x4 v[4]; float s = 0.f;
#pragma unroll
        for (int j = 0; j < 4; ++j) { v[j] = *(const f32x4*)(xr + 4 * lane + 256 * j); s += (v[j].x * v[j].x + v[j].y * v[j].y) + (v[j].z * v[j].z + v[j].w * v[j].w); }
        const float rstd = 1.0f / sqrtf(wave_sum(s) * (1.0f / DM) + EPS);
        const float* shp = sh + (size_t)b * MODLD + 4 * lane; const float* scp = sc + (size_t)b * MODLD + 4 * lane;
        bf16_t* op = A + (size_t)row * DM + 4 * lane;
#pragma unroll
        for (int j = 0; j < 4; ++j) { const f32x4 s4 = *(const f32x4*)(scp + 256 * j), h4 = *(const f32x4*)(shp + 256 * j);
            const f32x4 y = (v[j] * rstd * gv[j]) * (s4 + 1.0f) + h4;
            u32x2 w; w.x = pk2(y.x, y.y); w.y = pk2(y.z, y.w); *(u32x2*)(op + 256 * j) = w; }
    }
}

template <int HALFD> __device__ __forceinline__ void rope_table(const int TID, LAS float* tab) {
    for (int i = TID; i < 64 * HALFD; i += NTHREADS) { const int pos = i / HALFD, f = i % HALFD;
        const float fr = powf(10000.0f, -(float)f / (float)HALFD); float sn, cs; sincosf((float)pos * fr, &sn, &cs); tab[2 * i] = cs; tab[2 * i + 1] = sn; }
    __syncthreads();
}

__device__ __forceinline__ void qknorm_phase(const int TID, bf16_t* QKV, int ld, int nq, int nk, const float* gq, const float* gk, bool rope, float qscale, LAS unsigned char* lds) {
    LAS float* tab = (LAS float*)lds;
    if (rope) rope_table<16>(TID, tab);
    const int lane = TID & 63, wave = TID >> 6, l16 = lane & 15;
    const int gw = blockIdx.x * NWAVES + wave, NGW = gridDim.x * NWAVES;
    const f32x4 gq4 = *(const f32x4*)(gq + 4 * l16), gk4 = *(const f32x4*)(gk + 4 * l16);
    const int npass = (nq + nk) / 4;
    for (int row = gw; row < MTOT; row += NGW) {
        const bool dorope = rope && row < LAT; const int t = row & (SEQ - 1);
        const int pos = (l16 & 8) ? (t & 63) : (t >> 6); const int fi = 4 * (l16 & 3); const bool x2 = (l16 & 4) != 0;
        f32x4 cs = {1.f, 1.f, 1.f, 1.f}, sn = {0.f, 0.f, 0.f, 0.f};
        if (dorope) {
#pragma unroll
            for (int j = 0; j < 4; ++j) { cs[j] = tab[2 * (pos * 16 + fi + j)]; sn[j] = tab[2 * (pos * 16 + fi + j) + 1]; } }
        for (int p = 0; p < npass; ++p) {
            const int hh = 4 * p + (lane >> 4); const bool isq = hh < nq;
            bf16_t* ptr = QKV + (size_t)row * ld + hh * 64 + 4 * l16;
            const u32x2 w = *(const u32x2*)ptr;
            f32x4 x = {bflo(w.x), bfhi(w.x), bflo(w.y), bfhi(w.y)};
            float s = (x.x * x.x + x.y * x.y) + (x.z * x.z + x.w * x.w);
            s += __shfl_xor(s, 1); s += __shfl_xor(s, 2); s += __shfl_xor(s, 4); s += __shfl_xor(s, 8);
            const float rstd = 1.0f / sqrtf(s * (1.0f / 64.0f) + EPS);
            x = x * rstd * (isq ? gq4 : gk4);
            f32x4 o;
#pragma unroll
            for (int j = 0; j < 4; ++j) { const float other = __shfl_xor(x[j], 4); o[j] = x2 ? (other * sn[j] + x[j] * cs[j]) : (x[j] * cs[j] - other * sn[j]); }
            if (isq) o = o * qscale;
            u32x2 wo; wo.x = pk2(o.x, o.y); wo.y = pk2(o.z, o.w); *(u32x2*)ptr = wo;
        }
    }
}

__device__ __forceinline__ void mlanorm1_phase(const int TID, bf16_t* PROJ, const float* gcq, const float* gckv) {
    const int lane = TID & 63, wave = TID >> 6;
    const int gw = blockIdx.x * NWAVES + wave, NGW = gridDim.x * NWAVES;
    const f32x4 g1 = *(const f32x4*)(gcq + 4 * lane);
    const float g2a = gckv[2 * lane], g2b = gckv[2 * lane + 1];
    for (int row = gw; row < MTOT; row += NGW) {
        bf16_t* p = PROJ + (size_t)row * 512;
        const u32x2 w = *(const u32x2*)(p + 4 * lane); const unsigned w2 = *(const unsigned*)(p + 256 + 2 * lane);
        f32x4 x = {bflo(w.x), bfhi(w.x), bflo(w.y), bfhi(w.y)}; float ya = bflo(w2), yb = bfhi(w2);
        const float s1 = wave_sum((x.x * x.x + x.y * x.y) + (x.z * x.z + x.w * x.w)), s2 = wave_sum(ya * ya + yb * yb);
        const float r1 = 1.0f / sqrtf(s1 * (1.0f / 256.0f) + EPS), r2 = 1.0f / sqrtf(s2 * (1.0f / 128.0f) + EPS);
        x = x * r1 * g1; ya *= r2 * g2a; yb *= r2 * g2b;
        u32x2 wo; wo.x = pk2(x.x, x.y); wo.y = pk2(x.z, x.w); *(u32x2*)(p + 4 * lane) = wo; *(unsigned*)(p + 256 + 2 * lane) = pk2(ya, yb);
    }
}
__device__ __forceinline__ void mlanorm2_phase(const int TID, bf16_t* QR, bf16_t* KV, const bf16_t* PROJ, bf16_t* KR, const float* gq, const float* gk, float qscale, LAS unsigned char* lds) {
    LAS float* tab = (LAS float*)lds;
    rope_table<8>(TID, tab);
    const int lane = TID & 63, wave = TID >> 6, l32 = lane & 31, hs = lane >> 5;
    const int gw = blockIdx.x * NWAVES + wave, NGW = gridDim.x * NWAVES;
    const float gq0 = gq[l32], gq1 = gq[l32 + 32], gq2 = gq[l32 + 64], gk0 = gk[l32], gk1 = gk[l32 + 32], gk2 = gk[l32 + 64];
    const int fi = l32 & 7; const bool x2 = (l32 & 8) != 0, colpos = (l32 & 16) != 0;
    for (int row = gw; row < MTOT; row += NGW) {
        const bool islat = row < LAT; const int t = row & (SEQ - 1); const int pos = colpos ? (t & 63) : (t >> 6);
        float cs = 1.f, sn = 0.f; if (islat) { cs = tab[2 * (pos * 8 + fi)]; sn = tab[2 * (pos * 8 + fi) + 1]; }
        if (islat) {
            for (int p = 0; p < 8; ++p) { bf16_t* q = QR + (size_t)row * 1536 + (2 * p + hs) * 96;
                float a = bflo((unsigned)q[l32]), b = bflo((unsigned)q[l32 + 32]), c = bflo((unsigned)q[l32 + 64]);
                float s = a * a + b * b + c * c; s += __shfl_xor(s, 1); s += __shfl_xor(s, 2); s += __shfl_xor(s, 4); s += __shfl_xor(s, 8); s += __shfl_xor(s, 16);
                const float rstd = 1.0f / sqrtf(s * (1.0f / 96.0f) + EPS);
                a *= rstd * gq0; b *= rstd * gq1; c *= rstd * gq2;
                const float other = __shfl_xor(c, 8); c = x2 ? (other * sn + c * cs) : (c * cs - other * sn);
                q[l32] = (bf16_t)f2bf(a * qscale); q[l32 + 32] = (bf16_t)f2bf(b * qscale); q[l32 + 64] = (bf16_t)f2bf(c * qscale); }
        }
        const float kr = bflo((unsigned)PROJ[(size_t)row * 512 + 384 + l32]);
        for (int p = 0; p < 8; ++p) { const int hh = 2 * p + hs; bf16_t* k = KV + (size_t)row * 2048 + hh * 128;
            float a = bflo((unsigned)k[l32]), b = bflo((unsigned)k[l32 + 32]), c = kr;
            float s = a * a + b * b + c * c; s += __shfl_xor(s, 1); s += __shfl_xor(s, 2); s += __shfl_xor(s, 4); s += __shfl_xor(s, 8); s += __shfl_xor(s, 16);
            const float rstd = 1.0f / sqrtf(s * (1.0f / 96.0f) + EPS);
            a *= rstd * gk0; b *= rstd * gk1; c *= rstd * gk2;
            const float other = __shfl_xor(c, 8); c = x2 ? (other * sn + c * cs) : (c * cs - other * sn);
            k[l32] = (bf16_t)f2bf(a); k[l32 + 32] = (bf16_t)f2bf(b); KR[(size_t)row * 512 + hh * 32 + l32] = (bf16_t)f2bf(c); }
    }
}

__device__ __forceinline__ void pool_phase(const int TID, const bf16_t* A, bf16_t* P) {
    const int lane = TID & 63, wave = TID >> 6;
    const int gw = blockIdx.x * NWAVES + wave, NGW = gridDim.x * NWAVES;
    for (int row = gw; row < MTOT; row += NGW) {
        int base, L, t; if (row < LAT) { base = row & ~(SEQ - 1); L = SEQ; t = row - base; } else { const int r = row - LAT; base = LAT + (r & ~(CTXL - 1)); L = CTXL; t = r & (CTXL - 1); }
#pragma unroll
        for (int j = 0; j < 4; ++j) {
            const int w = 2 << j; int lo = t - w / 2, hi = t - w / 2 + w; lo = lo < 0 ? 0 : lo; hi = hi > L ? L : hi;
            f32x4 s = {0.f, 0.f, 0.f, 0.f};
            for (int k = lo; k < hi; ++k) { const u32x2 v = *(const u32x2*)(A + (size_t)(base + k) * DM + 256 * j + 4 * lane); s += (f32x4){bflo(v.x), bfhi(v.x), bflo(v.y), bfhi(v.y)}; }
            const u32x2 v = *(const u32x2*)(A + (size_t)row * DM + 256 * j + 4 * lane); const f32x4 self = {bflo(v.x), bfhi(v.x), bflo(v.y), bfhi(v.y)};
            const f32x4 o = s * (1.0f / (float)(hi - lo)) - self;
            u32x2 wo; wo.x = pk2(o.x, o.y); wo.y = pk2(o.z, o.w); *(u32x2*)(P + (size_t)row * DM + 256 * j + 4 * lane) = wo;
        }
    }
}

typedef short v4i16_t __attribute__((ext_vector_type(4)));
constexpr float ATT_THR = 8.0f;
__device__ __forceinline__ int crow16(int r, int hi) { return (r & 3) + 8 * (r >> 2) + 4 * hi; }
template <int MODE> __device__ __forceinline__ void attn_phase(const int TID, KArgs a, LAS unsigned char* lds) {
    constexpr int DQK = MODE == 2 ? 96 : 64, NKS = DQK / 16;
    constexpr int KROWB = DQK * 2 + 16, KBUF = 64 * KROWB, VOFF = 2 * KBUF, BIASOFF = VOFF + 16384;
    const int tid = TID, lane = tid & 63, wid = __builtin_amdgcn_readfirstlane(tid >> 6), r32 = lane & 31, hi = lane >> 5;
    unsigned char* ws = a->ws;
    const bf16_t *Qb, *Kb, *K2b = nullptr, *Vb; bf16_t* Ob; int ldq, ldk;
    if (MODE == 0) { Qb = (const bf16_t*)(ws + WS_RB); ldq = 1536; Kb = Qb + 1024; Vb = Qb + 1280; ldk = 1536; Ob = (bf16_t*)(ws + WS_RO); }
    else if (MODE == 1) { Qb = (const bf16_t*)(ws + WS_RB); ldq = 3072; Kb = Qb + 1024; Vb = Qb + 2048; ldk = 3072; Ob = (bf16_t*)(ws + WS_RO); }
    else { Qb = (const bf16_t*)(ws + WS_QR); ldq = 1536; Kb = (const bf16_t*)(ws + WS_KV); Vb = Kb + 64; K2b = (const bf16_t*)(ws + WS_KR); ldk = 2048; Ob = (bf16_t*)(ws + WS_RA); }
    const int G = gridDim.x, bx = blockIdx.x, vcu = (G % 8 == 0) ? (bx % 8) * (G / 8) + bx / 8 : bx;
    constexpr int NLAT = 2048, NCTXU = MODE == 2 ? 0 : 256;
    const int lat_per = (NLAT + G - 1) / G, ctx_per = (NCTXU + G - 1) / G;
    LAS float* btab = (LAS float*)(lds + BIASOFF);
    const int srow = tid >> 3, sch = tid & 7, s2row = tid >> 2, s2ch = tid & 3;
    const int kst = srow * KROWB + sch * 16, k2st = s2row * KROWB + 128 + s2ch * 16, vst = (sch >> 2) * 4096 + srow * 64 + (sch & 3) * 16;
    const int vrd = (4 * hi + ((lane & 15) >> 2)) * 64 + (16 * ((lane >> 4) & 1) + 4 * (lane & 3)) * 2;
    for (int it = 0; it < lat_per + ctx_per; ++it) {
        const bool ctxu = it >= lat_per;
        const int u = ctxu ? vcu * ctx_per + (it - lat_per) : vcu * lat_per + it;
        if (u >= (ctxu ? NCTXU : NLAT)) continue;
        int b, head, hoff, qrow, NT, lat0 = 0, qtok = 0, jj_lo = 0, rrow = 0, R0 = 0;
        if (MODE == 0) {
            if (!ctxu) { b = u >> 7; const int kvh = (u >> 5) & 3, qb = u & 31; head = kvh * 4 + (wid >> 1); hoff = kvh * 64; qtok = qb * 64 + (wid & 1) * 32 + r32; qrow = b * SEQ + qtok;
                jj_lo = 2 - qb > 0 ? 2 - qb : 0; const int jj_hi = 33 - qb < 4 ? 33 - qb : 4; lat0 = b * SEQ + qb * 64 - 128 + 64 * jj_lo; NT = 4 + (jj_hi - jj_lo + 1); }
            else { b = u >> 4; const int kvh = (u >> 2) & 3, qb = u & 3; head = kvh * 4 + (wid >> 1); hoff = kvh * 64; qtok = qb * 64 + (wid & 1) * 32 + r32; qrow = LAT + b * CTXL + qtok; NT = 4; }
        } else if (MODE == 1) {
            if (!ctxu) { b = u >> 7; head = (u >> 3) & 15; const int rq = u & 7; hoff = head * 64; rrow = 4 * rq + (r32 >> 3); qtok = 8 * wid + (r32 & 7); qrow = b * SEQ + rrow * 64 + qtok;
                R0 = 4 * rq - 4; R0 = R0 < 0 ? 0 : (R0 > 24 ? 24 : R0); int R1 = 4 * rq - 1; R1 = (R1 < 0 ? 0 : (R1 > 24 ? 24 : R1)) + 7; lat0 = b * SEQ + R0 * 64; NT = 4 + (R1 - R0 + 1); }
            else { b = u >> 4; head = u & 15; hoff = head * 64; qrow = LAT + b * CTXL + wid * 32 + r32; NT = 4; }
        } else { b = u >> 7; head = (u >> 3) & 15; const int qb = u & 7; hoff = head * 128; qrow = b * SEQ + qb * 256 + wid * 32 + r32; lat0 = b * SEQ; NT = 4 + 32; }
        const int ctx0 = LAT + b * CTXL;
        bf16x8 qf[NKS];
        { const bf16_t* qp = Qb + (size_t)qrow * ldq + head * DQK + 8 * hi;
#pragma unroll
          for (int ks = 0; ks < NKS; ++ks) qf[ks] = *(const bf16x8*)(qp + 16 * ks); }
        if (MODE == 1 && !ctxu) { const float* rp = a->in[18] + (size_t)head * 465; for (int i = tid; i < 465; i += NTHREADS) btab[64 + i] = rp[i] * LOG2E; }
        u32x4 kreg, k2reg = {0u, 0u, 0u, 0u}, vreg;
#define ATT_TILE_ROW(j) ((j) < 4 ? ctx0 + 64 * (j) : lat0 + 64 * ((j) - 4))
#define ATT_LOAD(j) do { const int kr0_ = ATT_TILE_ROW(j); kreg = *(const u32x4*)(Kb + (size_t)(kr0_ + srow) * ldk + hoff + sch * 8); vreg = *(const u32x4*)(Vb + (size_t)(kr0_ + srow) * ldk + hoff + sch * 8); \
        if (MODE == 2 && tid < 256) k2reg = *(const u32x4*)(K2b + (size_t)(kr0_ + s2row) * 512 + head * 32 + s2ch * 8); } while (0)
#define ATT_STORE(buf) do { *(LAS u32x4*)(lds + (buf) * KBUF + kst) = kreg; *(LAS u32x4*)(lds + VOFF + (buf) * 8192 + vst) = vreg; if (MODE == 2 && tid < 256) *(LAS u32x4*)(lds + (buf) * KBUF + k2st) = k2reg; } while (0)
        ATT_LOAD(0); ATT_STORE(0);
        __syncthreads();
        f32x16 o0, o1;
#pragma unroll
        for (int i = 0; i < 16; ++i) { o0[i] = 0.f; o1[i] = 0.f; }
        float l = 0.f;
        f32x16 zacc;
#pragma unroll
        for (int i = 0; i < 16; ++i) zacc[i] = 0.f;
        int r0w = rrow - 4; r0w = r0w < 0 ? 0 : (r0w > 24 ? 24 : r0w);
        int cs = qtok - 8; cs = cs < 0 ? 0 : (cs > 48 ? 48 : cs);
        for (int j = 0; j < NT; ++j) {
            if (j + 1 < NT) ATT_LOAD(j + 1);
            const int buf = j & 1;
            bool active = true, masked = false; int kr = 0, kstart = 0;
            if (MODE == 0 && j >= 4) { const int jj = jj_lo + (j - 4); masked = (jj == 0 || jj == 4); kstart = (lat0 - b * SEQ) + 64 * (j - 4); }
            if (MODE == 1 && j >= 4) { kr = R0 + (j - 4); active = false; }
            if (MODE == 1 && j >= 4) {
                const int wsk = wid == 0 ? 0 : (wid > 5 ? 32 : 8 * wid - 8);
                const LAS unsigned char* kb = lds + buf * KBUF + (wsk + r32) * KROWB + hi * 16;
                bf16x8 kf0[NKS];
#pragma unroll
                for (int ks = 0; ks < NKS; ++ks) kf0[ks] = *(const LAS bf16x8*)(kb + ks * 32);
                __builtin_amdgcn_sched_barrier(0);
                f32x16 s0;
#pragma unroll
                for (int ks = 0; ks < NKS; ++ks) s0 = __builtin_amdgcn_mfma_f32_32x32x16_bf16(kf0[ks], qf[ks], ks == 0 ? zacc : s0, 0, 0, 0);
                const LAS unsigned char* vb = lds + VOFF + buf * 8192 + vrd + wsk * 64;
                v4i16_t vlo[4], vhi[4];
#pragma unroll
                for (int s = 0; s < 2; ++s)
#pragma unroll
                    for (int dh = 0; dh < 2; ++dh) { vlo[2 * s + dh] = __builtin_amdgcn_ds_read_tr16_b64_v4i16((LAS v4i16_t*)(vb + dh * 4096 + s * 1024)); vhi[2 * s + dh] = __builtin_amdgcn_ds_read_tr16_b64_v4i16((LAS v4i16_t*)(vb + dh * 4096 + s * 1024 + 512)); }
                __builtin_amdgcn_sched_barrier(0);
                const bool rowok = (unsigned)(kr - r0w) < 8u;
                const LAS float* bp = btab + 64 + (kr - rrow + 7) * 31 + 15 - qtok + wsk + 4 * hi; const int e0 = rowok ? wsk + 4 * hi - cs : -1000;
                float ls = 0.f;
#pragma unroll
                for (int i = 0; i < 16; ++i) { const int c = (i & 3) + 8 * (i >> 2); const float sv = (unsigned)(e0 + c) < 16u ? s0[i] + bp[c] : -1e30f; s0[i] = __builtin_amdgcn_exp2f(sv); ls += s0[i]; }
                l += ls;
                bf16x8 pf[2];
#pragma unroll
                for (int s = 0; s < 2; ++s) { u32x4 w;
#pragma unroll
                    for (int e = 0; e < 4; ++e) { const int r = 8 * s + 2 * e; w[e] = pg8::cvt_pk_bf16(s0[r], s0[r + 1]); }
                    pf[s] = __builtin_bit_cast(bf16x8, w); }
                __builtin_amdgcn_sched_barrier(0);
#pragma unroll
                for (int s = 0; s < 2; ++s) {
                    const bf16x8 vf0 = __builtin_shufflevector(vlo[2 * s], vhi[2 * s], 0, 1, 2, 3, 4, 5, 6, 7), vf1 = __builtin_shufflevector(vlo[2 * s + 1], vhi[2 * s + 1], 0, 1, 2, 3, 4, 5, 6, 7);
                    o0 = __builtin_amdgcn_mfma_f32_32x32x16_bf16(vf0, pf[s], o0, 0, 0, 0); o1 = __builtin_amdgcn_mfma_f32_32x32x16_bf16(vf1, pf[s], o1, 0, 0, 0); }
            }
            if (active) {
                const LAS unsigned char* kb = lds + buf * KBUF + r32 * KROWB + hi * 16;
                f32x16 s0, s1;
                bf16x8 kf0[NKS], kf1[NKS];
#pragma unroll
                for (int ks = 0; ks < NKS; ++ks) { kf0[ks] = *(const LAS bf16x8*)(kb + ks * 32); kf1[ks] = *(const LAS bf16x8*)(kb + 32 * KROWB + ks * 32); }
                __builtin_amdgcn_sched_barrier(0);
#pragma unroll
                for (int ks = 0; ks < NKS; ++ks) {
                    s0 = __builtin_amdgcn_mfma_f32_32x32x16_bf16(kf0[ks], qf[ks], ks == 0 ? zacc : s0, 0, 0, 0); s1 = __builtin_amdgcn_mfma_f32_32x32x16_bf16(kf1[ks], qf[ks], ks == 0 ? zacc : s1, 0, 0, 0); }
                const LAS unsigned char* vb = lds + VOFF + buf * 8192 + vrd;
                v4i16_t vlo[8], vhi[8];
#pragma unroll
                for (int s = 0; s < 4; ++s)
#pragma unroll
                    for (int dh = 0; dh < 2; ++dh) { vlo[2 * s + dh] = __builtin_amdgcn_ds_read_tr16_b64_v4i16((LAS v4i16_t*)(vb + dh * 4096 + s * 1024)); vhi[2 * s + dh] = __builtin_amdgcn_ds_read_tr16_b64_v4i16((LAS v4i16_t*)(vb + dh * 4096 + s * 1024 + 512)); }
                __builtin_amdgcn_sched_barrier(0);
                if (MODE == 0 && masked) { const int d0 = qtok - kstart - 4 * hi + 128;
#pragma unroll
                    for (int i = 0; i < 16; ++i) { const int c = (i & 3) + 8 * (i >> 2); if ((unsigned)(d0 - c) > 256u) s0[i] = -1e30f; if ((unsigned)(d0 - c - 32) > 256u) s1[i] = -1e30f; } }
                float ls = 0.f;
#pragma unroll
                for (int i = 0; i < 16; ++i) { s0[i] = __builtin_amdgcn_exp2f(s0[i]); s1[i] = __builtin_amdgcn_exp2f(s1[i]); ls += s0[i] + s1[i]; }
                l += ls;
                bf16x8 pf[4];
#pragma unroll
                for (int s = 0; s < 4; ++s) { u32x4 w;
#pragma unroll
                    for (int e = 0; e < 4; ++e) { const int r = 8 * (s & 1) + 2 * e; w[e] = s < 2 ? pg8::cvt_pk_bf16(s0[r], s0[r + 1]) : pg8::cvt_pk_bf16(s1[r], s1[r + 1]); }
                    pf[s] = __builtin_bit_cast(bf16x8, w); }
                __builtin_amdgcn_sched_barrier(0);
#pragma unroll
                for (int s = 0; s < 4; ++s) {
                    const bf16x8 vf0 = __builtin_shufflevector(vlo[2 * s], vhi[2 * s], 0, 1, 2, 3, 4, 5, 6, 7), vf1 = __builtin_shufflevector(vlo[2 * s + 1], vhi[2 * s + 1], 0, 1, 2, 3, 4, 5, 6, 7);
                    o0 = __builtin_amdgcn_mfma_f32_32x32x16_bf16(vf0, pf[s], o0, 0, 0, 0); o1 = __builtin_amdgcn_mfma_f32_32x32x16_bf16(vf1, pf[s], o1, 0, 0, 0); }
            }
            if (j + 1 < NT) ATT_STORE(buf ^ 1);
            __syncthreads();
        }
#undef ATT_TILE_ROW
#undef ATT_LOAD
#undef ATT_STORE
        l += __shfl_xor(l, 32);
        if (MODE == 0) l += __builtin_amdgcn_exp2f(a->in[13][head] * LOG2E);
        const float inv = 1.0f / l;
        bf16_t* op = Ob + (size_t)qrow * DM + head * 64 + 4 * hi;
#pragma unroll
        for (int g4 = 0; g4 < 4; ++g4) {
            u32x2 w0, w1; w0.x = pg8::cvt_pk_bf16(o0[4 * g4] * inv, o0[4 * g4 + 1] * inv); w0.y = pg8::cvt_pk_bf16(o0[4 * g4 + 2] * inv, o0[4 * g4 + 3] * inv);
            w1.x = pg8::cvt_pk_bf16(o1[4 * g4] * inv, o1[4 * g4 + 1] * inv); w1.y = pg8::cvt_pk_bf16(o1[4 * g4 + 2] * inv, o1[4 * g4 + 3] * inv);
            *(u32x2*)(op + 8 * g4) = w0; *(u32x2*)(op + 32 + 8 * g4) = w1; }
    }
}

enum Kind { K_PRO = 0, K_N1, K_G1, K_QKN, K_ATT, K_G2, K_N2, K_G3, K_G4, K_POOL, K_GPOOL, K_GPROJ, K_MLAN1, K_GUP, K_MLAN2 };
constexpr int NPHASES = 24;
__device__ __forceinline__ void decode_phase(int p, int& L, int& kind) {
    if (p == 0) { L = 0; kind = K_PRO; return; }
    if (p <= 6) { L = 0; const int k = p - 1; kind = k == 0 ? K_N1 : k == 1 ? K_G1 : k == 2 ? K_ATT : k == 3 ? K_G2 : k == 4 ? K_G3 : K_G4; return; }
    if (p <= 11) { L = 1; const int k = p - 7; kind = k == 0 ? K_G1 : k == 1 ? K_ATT : k == 2 ? K_G2 : k == 3 ? K_G3 : K_G4; return; }
    if (p <= 15) { L = 2; const int k = p - 12; kind = k == 0 ? K_POOL : k == 1 ? K_GPOOL : k == 2 ? K_G3 : K_G4; return; }
    L = 3; const int k = p - 16;
    kind = k == 0 ? K_GPROJ : k == 1 ? K_MLAN1 : k == 2 ? K_GUP : k == 3 ? K_MLAN2 : k == 4 ? K_ATT : k == 5 ? K_G2 : k == 6 ? K_G3 : K_G4;
}

#define XB_TMO      128
#define XB_XCNT(j)  (256  + 64 * (j))
#define XB_XSUB(j)  (1280 + 64 * (j))
#define XB_XGEN(j)  (2304 + 64 * (j))
#define XB_TOP      3328
#define XB_TOPGEN   3392
#define XCD_BAR_WORDS 3456
#define XB_SPIN_CAP (1u << 18)

__device__ __forceinline__ unsigned xb_ld(unsigned* p)              { return __hip_atomic_load(p, __ATOMIC_RELAXED, __HIP_MEMORY_SCOPE_AGENT); }
__device__ __forceinline__ unsigned xb_add(unsigned* p, unsigned v) { return __hip_atomic_fetch_add(p, v, __ATOMIC_RELAXED, __HIP_MEMORY_SCOPE_AGENT); }
__device__ __forceinline__ unsigned xb_xcc_id() { return (unsigned)__builtin_amdgcn_s_getreg((3 << 11) | 20) & 0xFu; }
#define XB_SPIN(cond, bar) do { unsigned _sp = 0; while (cond) { __builtin_amdgcn_s_sleep(1); \
    if ((++_sp & 255u) == 0u) { if (xb_ld(&(bar)[XB_TMO])) break; if (_sp > XB_SPIN_CAP) { atomicAdd(&(bar)[XB_TMO], 1u); break; } } } } while (0)

struct XcdBarrier {
    unsigned* bar; unsigned x;
    volatile LAS unsigned* st;
};

__device__ __forceinline__ XcdBarrier xcd_barrier_post(unsigned* bar, volatile LAS unsigned* st) {
    XcdBarrier b; b.bar = bar; b.x = xb_xcc_id(); b.st = st;
    if (threadIdx.x == 0) (void)xb_add(&bar[XB_XCNT(b.x)], 1u);
    return b;
}
__device__ __forceinline__ void xcd_barrier_complete(unsigned* bar, unsigned x, unsigned& nloc, unsigned& nx) {
    const unsigned G = gridDim.x * gridDim.y * gridDim.z;
    unsigned sum, cnt, mine, sp = 0u;
    for (;;) {
        sum = 0u; cnt = 0u; mine = 0u;
#pragma unroll
        for (unsigned j = 0; j < 16; ++j) { const unsigned c = xb_ld(&bar[XB_XCNT(j)]); sum += c; cnt += (c > 0u) ? 1u : 0u; mine = (j == x) ? c : mine; }
        if (sum == G) break;
        __builtin_amdgcn_s_sleep(1);
        if ((++sp & 255u) == 0u) { if (xb_ld(&bar[XB_TMO])) break; if (sp > XB_SPIN_CAP) { atomicAdd(&bar[XB_TMO], 1u); break; } }
    }
    nloc = mine > 0u ? mine : 1u; nx = cnt > 0u ? cnt : 1u;
}

__device__ __forceinline__ void xcd_barrier(const XcdBarrier& b) {
    asm volatile("s_waitcnt vmcnt(0)" ::: "memory");
    __syncthreads();
    if (threadIdx.x == 0) {
        unsigned* bar = b.bar;
        __builtin_amdgcn_s_waitcnt(0);
        unsigned nloc = b.st[0], nx = b.st[1];
        if (nloc == 0u) { xcd_barrier_complete(bar, b.x, nloc, nx); b.st[0] = nloc; b.st[1] = nx; }
        const unsigned old = xb_add(&bar[XB_XSUB(b.x)], 1u);
        const unsigned gen = old / nloc;
        if (old + 1u == (gen + 1u) * nloc) {
            __builtin_amdgcn_fence(__ATOMIC_RELEASE, "agent");
            asm volatile("s_waitcnt vmcnt(0)" ::: "memory");
            const unsigned og = xb_add(&bar[XB_TOP], 1u);
            const unsigned tg = og / nx;
            if (og + 1u == (tg + 1u) * nx) xb_add(&bar[XB_TOPGEN], 1u);
            else XB_SPIN(xb_ld(&bar[XB_TOPGEN]) == tg, bar);
            __builtin_amdgcn_fence(__ATOMIC_ACQUIRE, "agent");
            xb_add(&bar[XB_XGEN(b.x)], 1u);
            asm volatile("s_waitcnt vmcnt(0)" ::: "memory");
        } else {
            XB_SPIN(xb_ld(&bar[XB_XGEN(b.x)]) == gen, bar);
            __builtin_amdgcn_fence(__ATOMIC_ACQUIRE, "agent");
            asm volatile("s_waitcnt vmcnt(0)" ::: "memory");
        }
    }
    __syncthreads();
}

#ifndef PROBE_KIND
#define PROBE_KIND -1
#endif
#ifndef PROBE_N
#define PROBE_N 0
#endif
#ifndef PROBE_L
#define PROBE_L -1
#endif
#ifndef PROBE_PLAIN
#define PROBE_PLAIN 0
#endif
#ifndef PROBE_SYNC
#define PROBE_SYNC 0
#endif
__global__ void __launch_bounds__(NTHREADS) fwd_kernel(Args a_by_value) {
    extern __shared__ __attribute__((aligned(16))) unsigned char lds_raw[];
    LAS unsigned char* lds = (LAS unsigned char*)lds_raw;
    cg::grid_group grid = cg::this_grid();
    const int ph_lo = a_by_value.ph_lo, ph_hi = a_by_value.ph_hi;
    volatile LAS unsigned* MISC = (volatile LAS unsigned*)(lds + 131072);
    if (threadIdx.x < 4) MISC[threadIdx.x] = 0u;
    __syncthreads();
    const XcdBarrier xbar = xcd_barrier_post((unsigned*)(a_by_value.ws + WS_CTL), MISC);
    if (ph_hi > 4096) grid.sync();
    for (int q = ph_lo * (1 + PROBE_N); q < ph_hi * (1 + PROBE_N); ++q) {
        const int p = q / (1 + PROBE_N);
        int L, kind; decode_phase(p, L, kind);
        const bool extra_visit = PROBE_N > 0 && (q % (1 + PROBE_N)) != 0;
        if (extra_visit && (kind != PROBE_KIND || (PROBE_L >= 0 && L != PROBE_L))) continue;
        KArgs a = (KArgs)__builtin_amdgcn_kernarg_segment_ptr(); asm volatile("" : "+s"(a));
        unsigned char* ws = a->ws;
        const float* MOD = (const float*)(ws + WS_MOD);
        float* HC = (float*)(ws + WS_HC);
        bf16_t* RA = (bf16_t*)(ws + WS_RA); bf16_t* RO = (bf16_t*)(ws + WS_RO); bf16_t* RB = (bf16_t*)(ws + WS_RB);
        int TID = threadIdx.x; asm volatile("" : "+v"(TID));
        const float* modL = MOD + (size_t)L * NMODB * MODLD;
        const int Mffn = L == 3 ? LAT : MTOT;
        if (kind == K_PRO) {
            prologue_phase(TID, a, lds);
        } else if (kind == K_N1) {
            norm_phase(TID, a->in[0], a->in[2], MTOT, a->in[6], modL, modL + DM, RA);
        } else if (kind == K_G1) {
            const int N = L == 0 ? 1536 : 3072;
            pg8::Gemm g{RA, (const bf16_t*)(ws + (L == 0 ? WS_SWA_QKV : WS_NA_QKV)), MTOT, N, DM, DM, DM, 0};
            pg8::EpiQKV E{RB, N, 4, L == 0 ? 1 : 4, L == 0 ? 1 : 0, L == 0 ? 11 : 16, L == 0 ? 12 : 17, 0.125f * LOG2E, (unsigned)WS_ROPE};
            pg8::StaticOrder S; S.init(g.M, g.N, (int)gridDim.x, (int)blockIdx.x);
            pg8::gemm_phase<pg8::EpiQKV, pg8::StaticOrder, true, true>(lds, g, S, E);
        } else if (kind == K_GPROJ || kind == K_GUP) {
            const int nrep = kind == K_GUP ? 2 : 1;
            for (int rep = 0; rep < nrep; ++rep) {
                pg8::Gemm g; pg8::EpiStore E;
                if (kind == K_GPROJ) { g = pg8::Gemm{RA, (const bf16_t*)(ws + WS_MLA_WA), MTOT, 512, DM, DM, DM, 0}; E = pg8::EpiStore{(bf16_t*)(ws + WS_PROJ), 512}; }
                else if (rep == 0) { g = pg8::Gemm{(const bf16_t*)(ws + WS_PROJ), (const bf16_t*)(ws + WS_MLA_WUQ), LAT, 1536, 256, 512, 256, 0}; E = pg8::EpiStore{(bf16_t*)(ws + WS_QR), 1536}; }
                else { g = pg8::Gemm{(const bf16_t*)(ws + WS_PROJ) + 256, (const bf16_t*)(ws + WS_MLA_WUKV), MTOT, 2048, 128, 512, 128, 0}; E = pg8::EpiStore{(bf16_t*)(ws + WS_KV), 2048}; }
                pg8::StaticOrder S; S.init(g.M, g.N, (int)gridDim.x, (int)blockIdx.x);
                pg8::gemm_phase<pg8::EpiStore, pg8::StaticOrder, true, true>(lds, g, S, E);
            }
        } else if (kind == K_G3) {
            pg8::Gemm g{L == 3 ? RO : RA, (const bf16_t*)(ws + WS_WGU + (size_t)L * SZ_WGU), Mffn, 2 * DFF, DM, DM, DM, 0};
            pg8::EpiSwiglu E{RB, DFF};
            pg8::StaticOrder S; S.init(g.M, g.N, (int)gridDim.x, (int)blockIdx.x);
            pg8::gemm_phase<pg8::EpiSwiglu, pg8::StaticOrder, true, true>(lds, g, S, E);
        } else if (kind == K_G2 || kind == K_GPOOL || kind == K_G4) {
            pg8::Gemm g; pg8::EpiResid E;
            E.first = (L == 0 && kind == K_G2) ? 1 : 0; E.pool = kind == K_GPOOL ? 1 : 0; E.mod_byte = (unsigned)WS_MOD; E.hc_byte = (unsigned)WS_HC;
            E.gate_off = L * NMODB * MODLD + (kind == K_G4 ? 5 * DM : 2 * DM);
            const bool ffn = kind == K_G4;
            const int Ln = ffn ? L + 1 : L, pi = 2 * L + (ffn ? 1 : 0) - (L == 3 ? 0 : 0);
            E.donorm = ((ffn && L == 3) || (PROBE_PLAIN && extra_visit)) ? 0 : 1; E.g_in = ffn ? 6 : 7; E.g_off = Ln * DM; E.nmod_off = Ln * NMODB * MODLD + (ffn ? 0 : 3 * DM);
            E.a_byte = (L == 3 && !ffn) ? WS_RO : WS_RA; E.cnt_byte = (unsigned)(WS_CNT + (size_t)pi * 144 * 64); E.xbuf_byte = WS_XBUF + (size_t)pi * MTOT * 16;
            if (kind == K_G2) { const size_t wo = L == 0 ? WS_SWA_WO : L == 1 ? WS_NA_WO : WS_MLA_WO; g = pg8::Gemm{L == 3 ? RA : RO, (const bf16_t*)(ws + wo), Mffn, DM, DM, DM, DM, 0}; }
            else if (kind == K_GPOOL) { g = pg8::Gemm{RO, (const bf16_t*)(ws + WS_POOL), MTOT, DM, 256, DM, 256, 256}; }
            else { g = pg8::Gemm{RB, (const bf16_t*)(ws + WS_WDN + (size_t)L * SZ_WDN), Mffn, DM, DFF, DFF, DFF, 0}; }
            pg8::PanelOrder S; S.init(g.M, g.N, (int)gridDim.x, (int)blockIdx.x);
            pg8::gemm_phase<pg8::EpiResid, pg8::PanelOrder, true, true>(lds, g, S, E);
        } else if (kind == K_QKN) {
            if (L == 0) qknorm_phase(TID, RB, 1536, 16, 4, a->in[11], a->in[12], true, 0.125f * LOG2E, lds);
            else qknorm_phase(TID, RB, 3072, 16, 16, a->in[16], a->in[17], false, 0.125f * LOG2E, lds);
        } else if (kind == K_ATT) {
            if (L == 0) attn_phase<0>(TID, a, lds); else if (L == 1) attn_phase<1>(TID, a, lds); else attn_phase<2>(TID, a, lds);
        } else if (kind == K_POOL) {
            pool_phase(TID, RA, RO);
        } else if (kind == K_MLAN1) {
            mlanorm1_phase(TID, (bf16_t*)(ws + WS_PROJ), a->in[24], a->in[25]);
        } else if (kind == K_MLAN2) {
            mlanorm2_phase(TID, (bf16_t*)(ws + WS_QR), (bf16_t*)(ws + WS_KV), (const bf16_t*)(ws + WS_PROJ), (bf16_t*)(ws + WS_KR), a->in[28], a->in[29], 0.10206207261596577f * LOG2E, lds);
        }
        if (q + 1 < ph_hi * (1 + PROBE_N)) { xcd_barrier(xbar); for (int e = 0; e < PROBE_SYNC; ++e) xcd_barrier(xbar); }
    }
}

#ifndef MK_PER_PHASE
#define MK_PER_PHASE 0
#endif
extern "C" void kernel_launch(void* const* d_in, const int* in_sizes, int n_in, void* d_out, int out_size, void* d_ws, size_t ws_size, hipStream_t stream) {
    static int grid = 0;
    if (grid == 0) {
        if (n_in != 31 || in_sizes[0] != LAT * DM || out_size != LAT * DM || ws_size < WS_END) { fprintf(stderr, "kernel_launch: unexpected shapes (n_in %d, in0 %d, out %d, ws %zu < %zu)\n", n_in, n_in > 0 ? in_sizes[0] : -1, out_size, ws_size, (size_t)WS_END); grid = -1; return; }
        int dev = 0, cus = 0, per_cu = 0;
        if (hipGetDevice(&dev) != hipSuccess || hipDeviceGetAttribute(&cus, hipDeviceAttributeMultiprocessorCount, dev) != hipSuccess) { fprintf(stderr, "kernel_launch: device query failed\n"); grid = -1; return; }
        if (hipFuncSetAttribute((const void*)fwd_kernel, hipFuncAttributeMaxDynamicSharedMemorySize, LDS_BYTES) != hipSuccess) { fprintf(stderr, "kernel_launch: hipFuncSetAttribute failed\n"); grid = -1; return; }
        if (hipOccupancyMaxActiveBlocksPerMultiprocessor(&per_cu, (const void*)fwd_kernel, NTHREADS, LDS_BYTES) != hipSuccess || per_cu < 1) { fprintf(stderr, "kernel_launch: occupancy query says %d blocks per CU\n", per_cu); per_cu = 1; }
        (void)hipGetLastError();
        grid = cus * (per_cu > 1 ? 1 : per_cu);
        if (grid % 32 != 0) { fprintf(stderr, "kernel_launch: grid %d is not a multiple of 32 (the fused norm epilogues deal row panels to 4 workgroups per XCD)\n", grid); grid = -1; return; }
    }
    if (grid < 0) return;
    Args a{};
    for (int i = 0; i < 31; ++i) a.in[i] = (const float*)d_in[i];
    a.out = (float*)d_out; a.ws = (unsigned char*)d_ws;
#if MK_PER_PHASE
    for (int p = 0; p < NPHASES; ++p) { a.ph_lo = p; a.ph_hi = p + 1; hipLaunchKernelGGL(fwd_kernel, dim3(grid), dim3(NTHREADS), LDS_BYTES, stream, a); }
#else
    a.ph_lo = 0; a.ph_hi = NPHASES;
    if (hipMemsetAsync((char*)d_ws + WS_CTL, 0, CTL_ZERO_BYTES, stream) != hipSuccess) { fprintf(stderr, "kernel_launch: memset of the barrier words failed\n"); return; }
    void* args[] = {&a};
    hipError_t e = hipLaunchCooperativeKernel((const void*)fwd_kernel, dim3(grid), dim3(NTHREADS), args, LDS_BYTES, stream);
    if (e != hipSuccess) fprintf(stderr, "kernel_launch: cooperative launch failed: %s (grid %d)\n", hipGetErrorString(e), grid);
#endif
}
```

```cpp
#include <hip/hip_runtime.h>
#include <hip/hip_cooperative_groups.h>
#include <cstdio>
#include <cstdint>
#include <cmath>
namespace cg = cooperative_groups;

namespace pg8 {
#define PG8_LAS __attribute__((address_space(3)))
typedef unsigned short bf16_t;
typedef short bf16x8 __attribute__((ext_vector_type(8)));
typedef float f32x4 __attribute__((ext_vector_type(4)));
typedef unsigned u32x4 __attribute__((ext_vector_type(4)));
typedef unsigned u32x2 __attribute__((ext_vector_type(2)));
constexpr int BM = 256, BK = 64, HALF = 128, HTB = HALF * BK * 2  , STAGE_BYTES = 8 * HTB, NXCD = 8, WGM = 4;

__host__ __device__ __forceinline__ int lds_byte(int r, int c) { const int st = (r >> 4) * 2 + (c >> 5), rr = r & 15, cc = c & 31, ob = rr * 64 + cc * 2; return st * 1024 + (ob ^ (((ob >> 9) & 1) << 5)); }
__host__ __device__ __forceinline__ void stage_rc(int b, int& R, int& C) { const int st = b / 1024, sb = b % 1024, swz = sb ^ (((sb >> 9) & 1) << 5); R = (st >> 1) * 16 + swz / 64; C = (st & 1) * 32 + (swz % 64) / 2; }
__host__ __device__ __forceinline__ int perm32(int rho) { const int n = rho >> 4, i = rho & 15; return 8 * (i >> 2) + 4 * n + (i & 3); }

struct Unit { int pm, pn; };
struct Gemm { const bf16_t* A; const bf16_t* Bt; int M, N, K, lda, ldb, akoff; };

struct StaticOrder {
    int nM, nN, nwg, G, c;
    __host__ __device__ void init(int M, int N, int G_, int c_) { nM = M / BM; nN = N / BM; nwg = nM * nN; G = G_; c = c_; }
    __host__ __device__ bool next(int i, Unit& u) const {
        const long L = (long)i * G + c; if (L >= nwg) return false;
        int wgid = (int)L; { const int q = nwg / NXCD, r = nwg % NXCD, xcd = wgid % NXCD, off = wgid / NXCD; wgid = (xcd < r ? xcd * (q + 1) : r * (q + 1) + (xcd - r) * q) + off; }
        const int nig = WGM * nN, gid = wgid / nig, fm = gid * WGM, gsz = (nM - fm) < WGM ? (nM - fm) : WGM;
        u.pm = fm + ((wgid % nig) % gsz); u.pn = (wgid % nig) / gsz; return true;
    }
    __device__ __forceinline__ void a_ready(const Unit&) const {}
    __device__ __forceinline__ void done(const Unit&) const {}
};

__device__ __forceinline__ unsigned cvt_pk_bf16(float lo, float hi) { unsigned r; asm volatile("v_cvt_pk_bf16_f32 %0, %1, %2" : "=v"(r) : "v"(lo), "v"(hi)); return r; }

struct EpiStore {
    static constexpr bool PERM = true, AFTER_DRAIN = false, WITH_LDS = true;
    bf16_t* O; int ldc, proj; const float* gcq; const float* gckv;
    __device__ __forceinline__ void run(f32x4 (&acc)[2][2][4][2], const Unit& u, int wr, int wc, int fr, int fq, PG8_LAS unsigned char* sl, int wid, int lane) const {
        const int row0 = u.pm * BM + wr * 64 + fr, col0 = u.pn * BM + wc * 32 + 8 * fq;
        if (proj) {
            const bool t0 = u.pn == 0;
            PG8_LAS float* P = (PG8_LAS float*)sl;
#pragma unroll
            for (int ai = 0; ai < 2; ++ai)
#pragma unroll
                for (int m = 0; m < 4; ++m) { float s = 0.f;
#pragma unroll
                    for (int bj = 0; bj < 2; ++bj) { if (bj == 0 || t0) { const f32x4 x0 = acc[ai][bj][m][0], x1 = acc[ai][bj][m][1];
                            s += ((x0[0] * x0[0] + x0[1] * x0[1]) + (x0[2] * x0[2] + x0[3] * x0[3])) + ((x1[0] * x1[0] + x1[1] * x1[1]) + (x1[2] * x1[2] + x1[3] * x1[3])); } }
                    s += __shfl_xor(s, 16); s += __shfl_xor(s, 32);
                    if (fq == 0) P[(ai * HALF + wr * 64 + m * 16 + fr) * 4 + wc] = s; }
            asm volatile("s_waitcnt lgkmcnt(0)" ::: "memory"); __builtin_amdgcn_s_barrier(); asm volatile("" ::: "memory");
            const float* g = t0 ? gcq : gckv; const int gc0 = wc * 32 + 8 * fq;
            const f32x4 g00 = *(const f32x4*)(g + gc0), g01 = *(const f32x4*)(g + gc0 + 4);
            f32x4 g10 = {1.f, 1.f, 1.f, 1.f}, g11 = g10; if (t0) { g10 = *(const f32x4*)(g + HALF + gc0); g11 = *(const f32x4*)(g + HALF + gc0 + 4); }
            const float invn = t0 ? 1.0f / 256.0f : 1.0f / 128.0f;
#pragma unroll
            for (int ai = 0; ai < 2; ++ai)
#pragma unroll
                for (int m = 0; m < 4; ++m) { const int rl = ai * HALF + wr * 64 + m * 16 + fr; const PG8_LAS float* pp = P + rl * 4;
                    const float rstd = 1.0f / sqrtf(((pp[0] + pp[1]) + (pp[2] + pp[3])) * invn + 1e-6f); const float r1 = t0 ? rstd : 1.0f;
                    acc[ai][0][m][0] = acc[ai][0][m][0] * rstd * g00; acc[ai][0][m][1] = acc[ai][0][m][1] * rstd * g01;
                    acc[ai][1][m][0] = acc[ai][1][m][0] * r1 * g10; acc[ai][1][m][1] = acc[ai][1][m][1] * r1 * g11; }
        }
#pragma unroll
        for (int ai = 0; ai < 2; ++ai)
#pragma unroll
            for (int m = 0; m < 4; ++m) { bf16_t* rowp = O + (size_t)(row0 + ai * HALF + m * 16) * ldc + col0;
#pragma unroll
                for (int bj = 0; bj < 2; ++bj) { const f32x4 v0 = acc[ai][bj][m][0], v1 = acc[ai][bj][m][1];
                    u32x4 w; w.x = cvt_pk_bf16(v0[0], v0[1]); w.y = cvt_pk_bf16(v0[2], v0[3]); w.z = cvt_pk_bf16(v1[0], v1[1]); w.w = cvt_pk_bf16(v1[2], v1[3]);
                    *(u32x4*)(rowp + bj * HALF) = w; } }
    }
};
__device__ __forceinline__ float silu_mul(float g, float u) { return g * u * __builtin_amdgcn_rcpf(1.0f + __builtin_amdgcn_exp2f(-1.4426950408889634f * g)); }
struct EpiSwiglu {
    static constexpr bool PERM = true, AFTER_DRAIN = false, WITH_LDS = false;
    bf16_t* O; int ldc;
    __device__ __forceinline__ void operator()(const f32x4 (&acc)[2][2][4][2], const Unit& u, int wr, int wc, int fr, int fq) const {
        const int row0 = u.pm * BM + wr * 64 + fr, col0 = u.pn * HALF + wc * 32 + 8 * fq;
#pragma unroll
        for (int ai = 0; ai < 2; ++ai)
#pragma unroll
            for (int m = 0; m < 4; ++m) { bf16_t* rowp = O + (size_t)(row0 + ai * HALF + m * 16) * ldc + col0;
                const f32x4 g0 = acc[ai][0][m][0], g1 = acc[ai][0][m][1], u0 = acc[ai][1][m][0], u1 = acc[ai][1][m][1];
                u32x4 w; w.x = cvt_pk_bf16(silu_mul(g0[0], u0[0]), silu_mul(g0[1], u0[1])); w.y = cvt_pk_bf16(silu_mul(g0[2], u0[2]), silu_mul(g0[3], u0[3]));
                w.z = cvt_pk_bf16(silu_mul(g1[0], u1[0]), silu_mul(g1[1], u1[1])); w.w = cvt_pk_bf16(silu_mul(g1[2], u1[2]), silu_mul(g1[3], u1[3]));
                *(u32x4*)rowp = w; }
    }
};
constexpr int EP_LAT = 32768, EP_SEQ = 2048, EP_D = 1024, EP_MODLD = 6144;
struct EpiArgs { const float* in[31]; float* out; unsigned char* ws; int ph_lo, ph_hi; };
struct EpiQKV {
    static constexpr bool PERM = true, AFTER_DRAIN = false, WITH_LDS = true;
    bf16_t* O; int ldc, nq, nk, rope, gq_in, gk_in; float qscale; unsigned rope_byte;
    __device__ __forceinline__ void run(f32x4 (&acc)[2][2][4][2], const Unit& u, int wr, int wc, int fr, int fq, PG8_LAS unsigned char* sl, int wid, int lane) const {
        const int row0 = u.pm * BM + wr * 64 + fr, col0 = u.pn * BM + wc * 32 + 8 * fq;
        if (u.pn < nq + nk) {
            const __attribute__((address_space(4))) EpiArgs* a = (const __attribute__((address_space(4))) EpiArgs*)__builtin_amdgcn_kernarg_segment_ptr(); asm volatile("" : "+s"(a));
            const bool isq = u.pn < nq;
            PG8_LAS float* P = (PG8_LAS float*)sl;
#pragma unroll
            for (int ai = 0; ai < 2; ++ai)
#pragma unroll
                for (int m = 0; m < 4; ++m)
#pragma unroll
                    for (int bj = 0; bj < 2; ++bj) { const f32x4 x0 = acc[ai][bj][m][0], x1 = acc[ai][bj][m][1];
                        float s = ((x0[0] * x0[0] + x0[1] * x0[1]) + (x0[2] * x0[2] + x0[3] * x0[3])) + ((x1[0] * x1[0] + x1[1] * x1[1]) + (x1[2] * x1[2] + x1[3] * x1[3]));
                        s += __shfl_xor(s, 16); s += __shfl_xor(s, 32);
                        if (fq == 0) P[((ai * HALF + wr * 64 + m * 16 + fr) * 2 + bj) * 4 + wc] = s; }
            asm volatile("s_waitcnt lgkmcnt(0)" ::: "memory"); __builtin_amdgcn_s_barrier(); asm volatile("" ::: "memory");
            const float* gp = (isq ? a->in[gq_in] : a->in[gk_in]) + (wc & 1) * 32 + 8 * fq;
            const f32x4 g0 = *(const f32x4*)gp, g1 = *(const f32x4*)(gp + 4);
            const float osc = isq ? qscale : 1.0f;
            const float* rt_ = (const float*)(a->ws + rope_byte) + 2 * (8 * (fq & 1));
            const bool x2 = fq >= 2;
#pragma unroll
            for (int ai = 0; ai < 2; ++ai)
#pragma unroll
            for (int mh = 0; mh < 2; ++mh) {
                f32x4 tq[2][4];
#pragma unroll
                for (int mm = 0; mm < 2; ++mm) { const int row = u.pm * BM + ai * HALF + wr * 64 + (2 * mh + mm) * 16 + fr; const int t = row & (EP_SEQ - 1), pos = (wc & 1) ? (t & 63) : (t >> 6);
                    const f32x4* tp = (const f32x4*)(rt_ + pos * 32); tq[mm][0] = tp[0]; tq[mm][1] = tp[1]; tq[mm][2] = tp[2]; tq[mm][3] = tp[3]; }
                __builtin_amdgcn_sched_barrier(0);
#pragma unroll
                for (int mm = 0; mm < 2; ++mm) { const int m = 2 * mh + mm; const int rl = ai * HALF + wr * 64 + m * 16 + fr, row = u.pm * BM + rl; bf16_t* rowp = O + (size_t)row * ldc + col0;
                    const bool dorope = rope && row < EP_LAT;
                    f32x4 c0 = {1.f, 1.f, 1.f, 1.f}, c1 = c0, s0 = {0.f, 0.f, 0.f, 0.f}, s1 = s0;
                    if (dorope) { const f32x4 t0 = tq[mm][0], t1 = tq[mm][1], t2 = tq[mm][2], t3 = tq[mm][3];
                        c0 = (f32x4){t0[0], t0[2], t1[0], t1[2]}; s0 = (f32x4){t0[1], t0[3], t1[1], t1[3]}; c1 = (f32x4){t2[0], t2[2], t3[0], t3[2]}; s1 = (f32x4){t2[1], t2[3], t3[1], t3[3]}; }
#pragma unroll
                    for (int bj = 0; bj < 2; ++bj) { const PG8_LAS float* pp = P + (rl * 2 + bj) * 4;
                        const float rstd = 1.0f / sqrtf((pp[wc] + pp[wc ^ 1]) * (1.0f / 64.0f) + 1e-6f);
                        f32x4 v0 = acc[ai][bj][m][0] * rstd * g0, v1 = acc[ai][bj][m][1] * rstd * g1;
                        if (rope) {
                            f32x4 p0, p1;
#pragma unroll
                            for (int j = 0; j < 4; ++j) {
                                const auto ra = __builtin_amdgcn_permlane32_swap(__float_as_uint(v0[j]), __float_as_uint(v0[j]), false, false), rb = __builtin_amdgcn_permlane32_swap(__float_as_uint(v1[j]), __float_as_uint(v1[j]), false, false);
                                p0[j] = __uint_as_float(x2 ? ra[0] : ra[1]); p1[j] = __uint_as_float(x2 ? rb[0] : rb[1]); }
                            if (x2) { v0 = p0 * s0 + v0 * c0; v1 = p1 * s1 + v1 * c1; } else { v0 = v0 * c0 - p0 * s0; v1 = v1 * c1 - p1 * s1; }
                        }
                        v0 = v0 * osc; v1 = v1 * osc;
                        u32x4 w; w.x = cvt_pk_bf16(v0[0], v0[1]); w.y = cvt_pk_bf16(v0[2], v0[3]); w.z = cvt_pk_bf16(v1[0], v1[1]); w.w = cvt_pk_bf16(v1[2], v1[3]);
                        *(u32x4*)(rowp + bj * HALF) = w; } }
            }
        } else {
#pragma unroll
            for (int ai = 0; ai < 2; ++ai)
#pragma unroll
                for (int m = 0; m < 4; ++m) { bf16_t* rowp = O + (size_t)(row0 + ai * HALF + m * 16) * ldc + col0;
#pragma unroll
                    for (int bj = 0; bj < 2; ++bj) { const f32x4 v0 = acc[ai][bj][m][0], v1 = acc[ai][bj][m][1];
                        u32x4 w; w.x = cvt_pk_bf16(v0[0], v0[1]); w.y = cvt_pk_bf16(v0[2], v0[3]); w.z = cvt_pk_bf16(v1[0], v1[1]); w.w = cvt_pk_bf16(v1[2], v1[3]);
                        *(u32x4*)(rowp + bj * HALF) = w; } }
        }
    }
};
struct EpiResid {
    static constexpr bool PERM = true, AFTER_DRAIN = false, WITH_LDS = true;
    int first;
    int gate_off;
    int pool;
    int donorm, g_in, g_off, nmod_off;
    unsigned mod_byte, hc_byte, cnt_byte; size_t a_byte, xbuf_byte;
    __device__ __forceinline__ void run(f32x4 (&acc)[2][2][4][2], const Unit& u, int wr, int wc, int fr, int fq, PG8_LAS unsigned char* sl, int wid, int lane) const {
        const __attribute__((address_space(4))) EpiArgs* a = (const __attribute__((address_space(4))) EpiArgs*)__builtin_amdgcn_kernarg_segment_ptr(); asm volatile("" : "+s"(a));
        unsigned char* ws = a->ws; float* HCp = (float*)(ws + hc_byte);
        const float* in_lat = first ? a->in[0] : a->out; const float* in_ctx = first ? a->in[2] : HCp; float* out_lat = a->out; float* out_ctx = HCp;
        const float* MODp = (const float*)(ws + mod_byte);
        const float* gate = MODp + gate_off; const float* bias = pool ? a->in[21] : nullptr; const float* cscale = pool ? a->in[22] : nullptr;
        const int rt = u.pm * BM; const bool isl = rt < EP_LAT; const int b = isl ? rt / EP_SEQ : 16;
        const float* ip = isl ? in_lat : in_ctx - (size_t)EP_LAT * EP_D; float* op = isl ? out_lat : out_ctx - (size_t)EP_LAT * EP_D;
        const int col0 = u.pn * BM + wc * 32 + 8 * fq; const float* gp = gate + (size_t)b * EP_MODLD + col0;
        if (pool) {
#pragma unroll
            for (int bj = 0; bj < 2; ++bj)
#pragma unroll
                for (int n = 0; n < 2; ++n) { const f32x4 bvv = *(const f32x4*)(bias + col0 + bj * HALF + n * 4), svv = *(const f32x4*)(cscale + col0 + bj * HALF + n * 4);
#pragma unroll
                    for (int ai = 0; ai < 2; ++ai)
#pragma unroll
                        for (int m = 0; m < 4; ++m) acc[ai][bj][m][n] = (acc[ai][bj][m][n] + bvv) * svv; }
        }
        {
        f32x4 gv[2][2];
#pragma unroll
        for (int bj = 0; bj < 2; ++bj)
#pragma unroll
            for (int n = 0; n < 2; ++n) gv[bj][n] = *(const f32x4*)(gp + bj * HALF + n * 4);
#pragma unroll
        for (int ai = 0; ai < 2; ++ai)
#pragma unroll
        for (int mh = 0; mh < 2; ++mh) {
            f32x4 bs[2][2][2];
#pragma unroll
            for (int mm = 0; mm < 2; ++mm) { const int m = 2 * mh + mm; const size_t off = (size_t)(rt + ai * HALF + wr * 64 + m * 16 + fr) * EP_D + col0;
#pragma unroll
                for (int bj = 0; bj < 2; ++bj)
#pragma unroll
                    for (int n = 0; n < 2; ++n) bs[mm][bj][n] = *(const f32x4*)(ip + off + bj * HALF + n * 4); }
            __builtin_amdgcn_sched_barrier(0);
#pragma unroll
            for (int mm = 0; mm < 2; ++mm) { const int m = 2 * mh + mm; const size_t off = (size_t)(rt + ai * HALF + wr * 64 + m * 16 + fr) * EP_D + col0;
#pragma unroll
                for (int bj = 0; bj < 2; ++bj)
#pragma unroll
                    for (int n = 0; n < 2; ++n) { const f32x4 h = bs[mm][bj][n] + gv[bj][n] * acc[ai][bj][m][n];
                        if (!donorm) *(f32x4*)(op + off + bj * HALF + n * 4) = h; acc[ai][bj][m][n] = h; } }
        }
        }
        if (!donorm) return;
        PG8_LAS float* P = (PG8_LAS float*)sl; PG8_LAS float* S = P + 1024;
        bf16_t* Ap = (bf16_t*)(ws + a_byte);
        const float* gnp = a->in[g_in] + g_off + col0; const float* shp = MODp + nmod_off + (size_t)b * EP_MODLD + col0; const float* scp = shp + 1024;
        f32x4 wv[2][2], hv[2][2];
#pragma unroll
        for (int bj = 0; bj < 2; ++bj)
#pragma unroll
            for (int n = 0; n < 2; ++n) { wv[bj][n] = *(const f32x4*)(gnp + bj * HALF + n * 4) * (*(const f32x4*)(scp + bj * HALF + n * 4) + 1.0f); hv[bj][n] = *(const f32x4*)(shp + bj * HALF + n * 4); }
#pragma unroll
        for (int ai = 0; ai < 2; ++ai)
#pragma unroll
            for (int m = 0; m < 4; ++m) { float s = 0.f;
#pragma unroll
                for (int bj = 0; bj < 2; ++bj)
#pragma unroll
                    for (int n = 0; n < 2; ++n) { const f32x4 x = acc[ai][bj][m][n]; s += (x[0] * x[0] + x[1] * x[1]) + (x[2] * x[2] + x[3] * x[3]); }
                s += __shfl_xor(s, 16); s += __shfl_xor(s, 32);
                if (fq == 0) P[(ai * HALF + wr * 64 + m * 16 + fr) * 4 + wc] = s; }
        asm volatile("s_waitcnt lgkmcnt(0)" ::: "memory"); __builtin_amdgcn_s_barrier(); asm volatile("" ::: "memory");
        const int tid = wid * 64 + lane;
        float* xb = (float*)(ws + xbuf_byte) + ((size_t)u.pm * BM) * 4;
        unsigned* cnt = (unsigned*)(ws + cnt_byte) + 16 * u.pm;
        if (tid < BM) { const float s = (P[tid * 4] + P[tid * 4 + 1]) + (P[tid * 4 + 2] + P[tid * 4 + 3]);
            __hip_atomic_store(xb + tid * 4 + u.pn, s, __ATOMIC_RELAXED, __HIP_MEMORY_SCOPE_AGENT); }
        asm volatile("s_waitcnt vmcnt(0)" ::: "memory");
        if (wid < 4 && lane == 0) __hip_atomic_fetch_add(cnt, 1u, __ATOMIC_RELAXED, __HIP_MEMORY_SCOPE_AGENT);
#pragma unroll
        for (int ai = 0; ai < 2; ++ai)
#pragma unroll
            for (int m = 0; m < 4; ++m) { const size_t off = (size_t)(rt + ai * HALF + wr * 64 + m * 16 + fr) * EP_D + col0;
#pragma unroll
                for (int bj = 0; bj < 2; ++bj)
#pragma unroll
                    for (int n = 0; n < 2; ++n) *(f32x4*)(op + off + bj * HALF + n * 4) = acc[ai][bj][m][n]; }
        if (wid == 0) { unsigned sp = 0u;
            while ((unsigned)__builtin_amdgcn_readfirstlane(__hip_atomic_load(cnt, __ATOMIC_RELAXED, __HIP_MEMORY_SCOPE_AGENT)) < 16u) { __builtin_amdgcn_s_sleep(2); if (++sp > (1u << 22)) break; }
            __builtin_amdgcn_fence(__ATOMIC_ACQUIRE, "agent"); }
        asm volatile("s_waitcnt lgkmcnt(0)" ::: "memory"); __builtin_amdgcn_s_barrier(); asm volatile("" ::: "memory");
        if (tid < BM) { float t = 0.f;
#pragma unroll
            for (int k = 0; k < 4; ++k) t += __hip_atomic_load(xb + tid * 4 + k, __ATOMIC_RELAXED, __HIP_MEMORY_SCOPE_AGENT);
            S[tid] = 1.0f / sqrtf(t * (1.0f / EP_D) + 1e-6f); }
        asm volatile("s_waitcnt lgkmcnt(0)" ::: "memory"); __builtin_amdgcn_s_barrier(); asm volatile("" ::: "memory");
#pragma unroll
        for (int ai = 0; ai < 2; ++ai)
#pragma unroll
            for (int m = 0; m < 4; ++m) { const int rl = ai * HALF + wr * 64 + m * 16 + fr; const float rs = S[rl]; bf16_t* arow = Ap + (size_t)(rt + rl) * EP_D + col0;
#pragma unroll
                for (int bj = 0; bj < 2; ++bj) { const f32x4 y0 = (acc[ai][bj][m][0] * rs) * wv[bj][0] + hv[bj][0], y1 = (acc[ai][bj][m][1] * rs) * wv[bj][1] + hv[bj][1];
                    u32x4 w; w.x = cvt_pk_bf16(y0[0], y0[1]); w.y = cvt_pk_bf16(y0[2], y0[3]); w.z = cvt_pk_bf16(y1[0], y1[1]); w.w = cvt_pk_bf16(y1[2], y1[3]); *(u32x4*)(arow + bj * HALF) = w; } }
    }
};
struct PanelOrder {
    int nM, G, x, y;
    __device__ void init(int M, int N, int G_, int c_) { nM = M / BM; G = G_; x = c_ & 7; y = c_ >> 3; (void)N; }
    __device__ bool next(int i, Unit& u) const {
        const int ppr = G / 4, base = i * ppr; if (base >= nM) return false;
        int rem = nM - base; rem = rem > ppr ? ppr : rem;
        const int per_x = (rem + 7) / 8, q = y >> 2; if (q >= per_x) return false;
        const int pm = base + x * per_x + q; if (pm >= nM) return false;
        u.pm = pm; u.pn = y & 3; return true;
    }
    __device__ __forceinline__ void a_ready(const Unit&) const {}
    __device__ __forceinline__ void done(const Unit&) const {}
};

template <class Epi, class Sched, bool ALIGN_EPI = false, bool SP2 = false>
__device__ __forceinline__ void gemm_phase(PG8_LAS unsigned char* lds, const Gemm g, const Sched& S, const Epi& E, const int tid_in) {
    int tid_ = tid_in; asm volatile("" : "+v"(tid_));
    const int tid = tid_, wid = __builtin_amdgcn_readfirstlane(tid >> 6), lane = tid & 63, wr = wid >> 2, wc = wid & 3, fr = lane & 15, fq = lane >> 4;
    const int K = g.K, nt = K / BK;
    unsigned voffA[2], voffB[2];
#pragma unroll
    for (int i = 0; i < 2; ++i) { int R, C; stage_rc(tid * 16 + i * 8192, R, C); const int Rb = Epi::PERM ? ((R & ~31) + perm32(R & 31)) : R;
        voffA[i] = (unsigned)(R * g.lda + C) * 2u; voffB[i] = (unsigned)(Rb * g.ldb + C) * 2u; }
    const size_t kstep = (size_t)(BK * 2);
    const size_t hstepA = (size_t)HALF * g.lda * 2, hstepB = (size_t)HALF * g.ldb * 2;
    const size_t tstepA = 2 * hstepA, tstepB = 2 * hstepB; const size_t akoff = (size_t)g.akoff * 2;
    const unsigned ldsw = (unsigned)wid * 1024u;
    const int aoff = lds_byte(wr * 64 + fr, fq * 8), boff = lds_byte(wc * 32 + fr, fq * 8);
#define PG8_SA(b, h) (((b) * 2 + (h)) * HTB)
#define PG8_SB(b, h) ((4 + (b) * 2 + (h)) * HTB)
#define PG8_STAGE(bufoff, gbase, voff) do { _Pragma("unroll") for (int _i = 0; _i < 2; ++_i) \
        __builtin_amdgcn_global_load_lds((const unsigned*)((const char*)(gbase) + (voff)[_i]), (PG8_LAS unsigned*)(lds + (bufoff) + ldsw + _i * 8192), 16, 0, 0); } while (0)
#define PG8_LDA(dst, b, h) do { _Pragma("unroll") for (int m = 0; m < 4; ++m) _Pragma("unroll") for (int k = 0; k < 2; ++k) dst[m][k] = *(const PG8_LAS bf16x8*)(lds + PG8_SA(b, h) + aoff + m * 2048 + k * 1024); } while (0)
#define PG8_LDB(dst, b, h) do { _Pragma("unroll") for (int n = 0; n < 2; ++n) _Pragma("unroll") for (int k = 0; k < 2; ++k) dst[n][k] = *(const PG8_LAS bf16x8*)(lds + PG8_SB(b, h) + boff + n * 2048 + k * 1024); } while (0)
#define PG8_MMA(ai, bj, At, Bt) do { __builtin_amdgcn_s_setprio(1); _Pragma("unroll") for (int m = 0; m < 4; ++m) _Pragma("unroll") for (int n = 0; n < 2; ++n) _Pragma("unroll") for (int k = 0; k < 2; ++k) \
        acc[ai][bj][m][n] = __builtin_amdgcn_mfma_f32_16x16x32_bf16(Bt[n][k], At[m][k], acc[ai][bj][m][n], 0, 0, 0); __builtin_amdgcn_s_setprio(0); } while (0)
#define PG8_WAIT_V(n) asm volatile("s_waitcnt vmcnt(" #n ")" ::: "memory")
#define PG8_WAIT_L(n) asm volatile("s_waitcnt lgkmcnt(" #n ")" ::: "memory")
#define PG8_BAR __builtin_amdgcn_s_barrier()
#define PG8_SCHED __builtin_amdgcn_sched_barrier(0)
    Unit cur, nxt; int ui = 0;
    if (!S.next(0, cur)) return;
    f32x4 acc[2][2][4][2];
#pragma unroll
    for (int a = 0; a < 2; ++a)
#pragma unroll
        for (int b = 0; b < 2; ++b)
#pragma unroll
            for (int m = 0; m < 4; ++m)
#pragma unroll
                for (int n = 0; n < 2; ++n) acc[a][b][m][n] = (f32x4){0.f, 0.f, 0.f, 0.f};
    bf16x8 At[4][2], B0[2][2], B1[2][2];
    const char* cA = (const char*)g.A + (size_t)cur.pm * tstepA + (size_t)cur.pn * akoff; const char* cB = (const char*)g.Bt + (size_t)cur.pn * tstepB;
    S.a_ready(cur);
    if constexpr (SP2) {
        PG8_STAGE(PG8_SB(0, 0), cB, voffB); PG8_STAGE(PG8_SB(0, 1), cB + hstepB, voffB); PG8_STAGE(PG8_SA(0, 0), cA, voffA); PG8_STAGE(PG8_SA(0, 1), cA + hstepA, voffA);
        if (wr == 1) PG8_BAR;
        PG8_WAIT_V(2); PG8_BAR;
        PG8_STAGE(PG8_SB(1, 0), cB + kstep, voffB); PG8_STAGE(PG8_SA(1, 0), cA + kstep, voffA); PG8_STAGE(PG8_SB(1, 1), cB + hstepB + kstep, voffB);
        PG8_WAIT_V(6); PG8_BAR;
    } else {
        PG8_STAGE(PG8_SB(0, 0), cB, voffB); PG8_STAGE(PG8_SA(0, 0), cA, voffA); PG8_STAGE(PG8_SB(0, 1), cB + hstepB, voffB); PG8_STAGE(PG8_SA(0, 1), cA + hstepA, voffA);
        if (wr == 1) PG8_BAR;
        PG8_WAIT_V(4); PG8_BAR;
        PG8_STAGE(PG8_SB(1, 0), cB + kstep, voffB); PG8_STAGE(PG8_SA(1, 0), cA + kstep, voffA); PG8_STAGE(PG8_SB(1, 1), cB + hstepB + kstep, voffB);
        PG8_WAIT_V(6); PG8_BAR;
    }
    for (;;) {
        const bool has_next = S.next(ui + 1, nxt);
        const char* nA = has_next ? (const char*)g.A + (size_t)nxt.pm * tstepA + (size_t)nxt.pn * akoff : cA; const char* nB = has_next ? (const char*)g.Bt + (size_t)nxt.pn * tstepB : cB;
        for (int t = 0; t < nt; t += 2) {
            const bool last = (t == nt - 2);
            const char* a1 = cA + (size_t)(t + 1) * kstep;
            const char* a2 = last ? nA : cA + (size_t)(t + 2) * kstep; const char* b2 = last ? nB : cB + (size_t)(t + 2) * kstep;
            const char* a3 = a2 + kstep; const char* b3 = b2 + kstep;
            if (last && has_next) S.a_ready(nxt);
            if constexpr (SP2) {
            PG8_LDB(B0, 0, 0); PG8_LDB(B1, 0, 1); PG8_SCHED; PG8_LDA(At, 0, 0); PG8_STAGE(PG8_SA(1, 1), a1 + hstepA, voffA);
            PG8_WAIT_V(8); PG8_WAIT_L(0); PG8_BAR; PG8_MMA(0, 0, At, B0); PG8_MMA(0, 1, At, B1); PG8_BAR; PG8_SCHED;
            PG8_LDA(At, 0, 1); PG8_STAGE(PG8_SB(0, 0), b2, voffB); PG8_STAGE(PG8_SB(0, 1), b2 + hstepB, voffB); PG8_STAGE(PG8_SA(0, 0), a2, voffA);
            PG8_WAIT_V(8); PG8_WAIT_L(0); PG8_BAR; PG8_MMA(1, 0, At, B0); PG8_MMA(1, 1, At, B1); PG8_BAR; PG8_SCHED;
            PG8_LDB(B0, 1, 0); PG8_LDB(B1, 1, 1); PG8_SCHED; PG8_LDA(At, 1, 0); PG8_STAGE(PG8_SA(0, 1), a2 + hstepA, voffA);
            PG8_WAIT_V(8); PG8_WAIT_L(0); PG8_BAR; PG8_MMA(0, 0, At, B0); PG8_MMA(0, 1, At, B1); PG8_BAR; PG8_SCHED;
            PG8_LDA(At, 1, 1); PG8_STAGE(PG8_SB(1, 0), b3, voffB); PG8_STAGE(PG8_SB(1, 1), b3 + hstepB, voffB); PG8_STAGE(PG8_SA(1, 0), a3, voffA);
            PG8_WAIT_V(8); PG8_WAIT_L(0); PG8_BAR; PG8_MMA(1, 0, At, B0); PG8_MMA(1, 1, At, B1); PG8_BAR; PG8_SCHED;
            } else {
            PG8_LDB(B0, 0, 0); PG8_SCHED; PG8_LDA(At, 0, 0); PG8_STAGE(PG8_SA(1, 1), a1 + hstepA, voffA);
            PG8_WAIT_L(8); PG8_BAR; PG8_WAIT_L(0); PG8_MMA(0, 0, At, B0); PG8_BAR; PG8_SCHED;
            PG8_LDB(B1, 0, 1); PG8_STAGE(PG8_SB(0, 0), b2, voffB);
            PG8_BAR; PG8_WAIT_L(0); PG8_MMA(0, 1, At, B1); PG8_BAR;
            PG8_LDA(At, 0, 1); PG8_STAGE(PG8_SA(0, 0), a2, voffA);
            PG8_BAR; PG8_WAIT_L(0); PG8_MMA(1, 0, At, B0); PG8_BAR; PG8_SCHED;
            PG8_STAGE(PG8_SB(0, 1), b2 + hstepB, voffB);
            PG8_WAIT_V(6); PG8_BAR; PG8_MMA(1, 1, At, B1); PG8_BAR;
            PG8_LDB(B0, 1, 0); PG8_SCHED; PG8_LDA(At, 1, 0); PG8_STAGE(PG8_SA(0, 1), a2 + hstepA, voffA);
            PG8_WAIT_L(8); PG8_BAR; PG8_WAIT_L(0); PG8_MMA(0, 0, At, B0); PG8_BAR; PG8_SCHED;
            PG8_LDB(B1, 1, 1); PG8_STAGE(PG8_SB(1, 0), b3, voffB);
            PG8_BAR; PG8_WAIT_L(0); PG8_MMA(0, 1, At, B1); PG8_BAR;
            PG8_LDA(At, 1, 1); PG8_STAGE(PG8_SA(1, 0), a3, voffA);
            PG8_BAR; PG8_WAIT_L(0); PG8_MMA(1, 0, At, B0); PG8_BAR; PG8_SCHED;
            PG8_STAGE(PG8_SB(1, 1), b3 + hstepB, voffB);
            PG8_WAIT_V(6); PG8_BAR; PG8_MMA(1, 1, At, B1); PG8_BAR;
            }
        }
        if constexpr (ALIGN_EPI) { if (wr == 0) PG8_BAR; }
        if constexpr (!Epi::AFTER_DRAIN) { if constexpr (Epi::WITH_LDS) E.run(acc, cur, wr, wc, fr, fq, lds + 131072 + 64, wid, lane); else E(acc, cur, wr, wc, fr, fq); S.done(cur); }
        if (!has_next) break;
#pragma unroll
        for (int a = 0; a < 2; ++a)
#pragma unroll
            for (int b = 0; b < 2; ++b)
#pragma unroll
                for (int m = 0; m < 4; ++m)
#pragma unroll
                    for (int n = 0; n < 2; ++n) acc[a][b][m][n] = (f32x4){0.f, 0.f, 0.f, 0.f};
        cur = nxt; cA = nA; cB = nB; ++ui;
        if constexpr (ALIGN_EPI) { if (wr == 1) PG8_BAR; }
    }
    PG8_WAIT_V(0);
    if constexpr (!ALIGN_EPI) { if (wr == 0) PG8_BAR; }
    PG8_BAR;
    if constexpr (Epi::AFTER_DRAIN) { E.fused(acc, cur, wr, wc, fr, fq, lds, wid, lane); S.done(cur); }
#undef PG8_SA
#undef PG8_SB
#undef PG8_STAGE
#undef PG8_LDA
#undef PG8_LDB
#undef PG8_MMA
#undef PG8_WAIT_V
#undef PG8_WAIT_L
#undef PG8_BAR
#undef PG8_SCHED
}
}

using pg8::bf16_t; using pg8::bf16x8; using pg8::f32x4; using pg8::u32x4;
typedef float f32x16 __attribute__((ext_vector_type(16)));
typedef unsigned u32x2 __attribute__((ext_vector_type(2)));
#define LAS __attribute__((address_space(3)))
constexpr int DM = 1024, NBATCH = 16, SEQ = 2048, LAT = NBATCH * SEQ, CTXL = 256, NCTX = NBATCH * CTXL, MTOT = LAT + NCTX, DFF = 2816, MODLD = 6 * DM, NMODB = 17;
constexpr float EPS = 1e-6f, LOG2E = 1.4426950408889634f;
constexpr int NTHREADS = 512, NWAVES = 8;
constexpr int LDS_BYTES = 143360;

constexpr size_t MiB = 1u << 20;
constexpr size_t WS_MOD = 0;
constexpr size_t WS_CTL = 1835008;
constexpr size_t WS_CNT = WS_CTL + 16384;
constexpr size_t CTL_ZERO_BYTES = 16384 + 7 * 144 * 64;
static_assert(WS_CNT + 7 * 144 * 64 <= 2 * MiB, "control words");
constexpr size_t WS_ROPE = 1916928;
static_assert(WS_ROPE >= WS_CNT + 7 * 144 * 64 && WS_ROPE + 8192 <= 2 * MiB, "rope table");
constexpr size_t WS_W = 2 * MiB;
constexpr size_t SZ_WGU = (size_t)2 * DFF * DM * 2, SZ_WDN = (size_t)DM * DFF * 2;
constexpr size_t WS_WGU = WS_W, WS_WDN = WS_WGU + 4 * SZ_WGU;
constexpr size_t WS_SWA_QKV = WS_WDN + 4 * SZ_WDN, WS_SWA_WO = WS_SWA_QKV + (size_t)1536 * DM * 2;
constexpr size_t WS_NA_QKV = WS_SWA_WO + (size_t)DM * DM * 2, WS_NA_WO = WS_NA_QKV + (size_t)3072 * DM * 2;
constexpr size_t WS_POOL = WS_NA_WO + (size_t)DM * DM * 2;
constexpr size_t WS_MLA_WA = WS_POOL + (size_t)DM * 256 * 2, WS_MLA_WUQ = WS_MLA_WA + (size_t)512 * DM * 2, WS_MLA_WUKV = WS_MLA_WUQ + (size_t)1536 * 256 * 2;
constexpr size_t WS_MLA_WO = WS_MLA_WUKV + (size_t)2048 * 128 * 2, WS_W_END = WS_MLA_WO + (size_t)DM * DM * 2;
constexpr size_t WS_HC = 86 * MiB;
constexpr size_t WS_RA = 102 * MiB;
constexpr size_t WS_RO = WS_RA + 72 * MiB;
constexpr size_t WS_RB = WS_RO + 72 * MiB;
constexpr size_t WS_XBUF = 507 * MiB;
constexpr size_t WS_END = WS_XBUF + (size_t)7 * MTOT * 16;
static_assert(WS_END <= 512 * MiB, "workspace");
static_assert(WS_W_END <= WS_HC, "weights fit");
static_assert(WS_RB + (size_t)MTOT * 3072 * 2 <= WS_XBUF && WS_RB + (size_t)MTOT * DFF * 2 <= WS_XBUF, "big region");
constexpr size_t WS_PROJ = WS_RO, WS_QR = WS_PROJ + (size_t)MTOT * 512 * 2, WS_KV = WS_QR + (size_t)LAT * 1536 * 2, WS_KR = WS_KV + (size_t)MTOT * 2048 * 2;
static_assert(WS_KR + (size_t)MTOT * 512 * 2 <= WS_XBUF, "mla region");

__device__ __forceinline__ unsigned f2bf(float f) { unsigned u = __builtin_bit_cast(unsigned, f); return (u + 0x7fffu + ((u >> 16) & 1u)) >> 16; }
__device__ __forceinline__ unsigned pk2(float lo, float hi) { return f2bf(lo) | (f2bf(hi) << 16); }
__device__ __forceinline__ float bflo(unsigned w) { return __builtin_bit_cast(float, w << 16); }
__device__ __forceinline__ float bfhi(unsigned w) { return __builtin_bit_cast(float, w & 0xffff0000u); }
__device__ __forceinline__ float wave_sum(float v) {
#pragma unroll
    for (int o = 1; o < 64; o <<= 1) v += __shfl_xor(v, o);
    return v;
}

struct Args { const float* in[31]; float* out; unsigned char* ws; int ph_lo, ph_hi; };
typedef const __attribute__((address_space(4))) Args* KArgs;

__device__ __forceinline__ void transpose_item(const float* W, int K, int N, bf16_t* WT, int drow0, int k0, int n0, LAS float* scr, int lane) {
    float tv[32];
#pragma unroll
    for (int i = 0; i < 32; ++i) tv[i] = W[(size_t)(k0 + 2 * i + (lane >> 5)) * N + n0 + (lane & 31)];
#pragma unroll
    for (int i = 0; i < 32; ++i) scr[(2 * i + (lane >> 5)) * 33 + (lane & 31)] = tv[i];
    asm volatile("s_waitcnt lgkmcnt(0)" ::: "memory");
    const int c = lane & 7;
#pragma unroll
    for (int j = 0; j < 4; ++j) { const int n = (lane >> 3) + 8 * j; const LAS float* s = scr + (8 * c) * 33 + n;
        u32x4 o; o.x = pk2(s[0 * 33], s[1 * 33]); o.y = pk2(s[2 * 33], s[3 * 33]); o.z = pk2(s[4 * 33], s[5 * 33]); o.w = pk2(s[6 * 33], s[7 * 33]);
        *(u32x4*)(WT + (size_t)(drow0 + n) * K + k0 + 8 * c) = o; }
    asm volatile("s_waitcnt lgkmcnt(0)" ::: "memory");
}
__device__ __forceinline__ void transpose_job(const float* W, int K, int N, bf16_t* WT, int map, int item, LAS float* scr, int lane) {
    const int nblk = N / 32, kb = item / nblk, nb = item % nblk, k0 = 64 * kb, n0 = 32 * nb;
    int drow0 = n0;
    if (map == 1) { const bool up = n0 >= DFF; const int j = up ? n0 - DFF : n0; drow0 = (j >> 7) * 256 + (up ? 128 : 0) + (j & 127); }
    transpose_item(W, K, N, WT, drow0, k0, n0, scr, lane);
}
__device__ __forceinline__ void prologue_phase(const int TID, KArgs a, LAS unsigned char* lds, const int parts = 3) {
    const int tid = TID, lane = tid & 63, wave = tid >> 6;
    unsigned char* ws = a->ws;
    LAS float* scr = (LAS float*)(lds + wave * 16384);
    const int gw = blockIdx.x * NWAVES + wave, NGW = gridDim.x * NWAVES;
    constexpr int I_GU = (DM / 64) * (2 * DFF / 32), I_DN = (DFF / 64) * (DM / 32), I_SQ = (DM / 64) * (1536 / 32), I_SQ2 = (DM / 64) * (DM / 32), I_NQ = (DM / 64) * (3072 / 32);
    constexpr int I_PL = (256 / 64) * (256 / 32), I_WA = (DM / 64) * (416 / 32), I_UQ = (256 / 64) * (1536 / 32), I_UKV = (128 / 64) * (2048 / 32);
    constexpr int NITEMS = 4 * I_GU + 4 * I_DN + I_SQ + I_SQ2 + I_NQ + I_SQ2 + 4 * I_PL + I_WA + I_UQ + I_UKV + I_SQ2;
    if (parts & 1)
    for (int it = gw; it < NITEMS; it += NGW) {
        int r = it;
        if (r < 4 * I_GU) { const int l = r / I_GU; transpose_job(a->in[8] + (size_t)l * DM * 2 * DFF, DM, 2 * DFF, (bf16_t*)(ws + WS_WGU + l * SZ_WGU), 1, r % I_GU, scr, lane); continue; } r -= 4 * I_GU;
        if (r < 4 * I_DN) { const int l = r / I_DN; transpose_job(a->in[9] + (size_t)l * DFF * DM, DFF, DM, (bf16_t*)(ws + WS_WDN + l * SZ_WDN), 0, r % I_DN, scr, lane); continue; } r -= 4 * I_DN;
        if (r < I_SQ) { transpose_job(a->in[10], DM, 1536, (bf16_t*)(ws + WS_SWA_QKV), 0, r, scr, lane); continue; } r -= I_SQ;
        if (r < I_SQ2) { transpose_job(a->in[14], DM, DM, (bf16_t*)(ws + WS_SWA_WO), 0, r, scr, lane); continue; } r -= I_SQ2;
        if (r < I_NQ) { transpose_job(a->in[15], DM, 3072, (bf16_t*)(ws + WS_NA_QKV), 0, r, scr, lane); continue; } r -= I_NQ;
        if (r < I_SQ2) { transpose_job(a->in[19], DM, DM, (bf16_t*)(ws + WS_NA_WO), 0, r, scr, lane); continue; } r -= I_SQ2;
        if (r < 4 * I_PL) { const int g = r / I_PL; transpose_job(a->in[20] + (size_t)g * 65536, 256, 256, (bf16_t*)(ws + WS_POOL) + (size_t)g * 65536, 0, r % I_PL, scr, lane); continue; } r -= 4 * I_PL;
        if (r < I_WA) { transpose_job(a->in[23], DM, 416, (bf16_t*)(ws + WS_MLA_WA), 0, r, scr, lane); continue; } r -= I_WA;
        if (r < I_UQ) { transpose_job(a->in[26], 256, 1536, (bf16_t*)(ws + WS_MLA_WUQ), 0, r, scr, lane); continue; } r -= I_UQ;
        if (r < I_UKV) { transpose_job(a->in[27], 128, 2048, (bf16_t*)(ws + WS_MLA_WUKV), 0, r, scr, lane); continue; } r -= I_UKV;
        transpose_job(a->in[30], DM, DM, (bf16_t*)(ws + WS_MLA_WO), 0, r, scr, lane);
    }
    if (blockIdx.x == 0) { float* rt = (float*)(ws + WS_ROPE); for (int i = tid; i < 64 * 16; i += NTHREADS) { const int pos = i >> 4, f = i & 15; const float fr = powf(10000.0f, -(float)f / 16.0f); float sn, cs; sincosf((float)pos * fr, &sn, &cs); rt[2 * i] = cs; rt[2 * i + 1] = sn; } }
    { u32x4* z = (u32x4*)(ws + WS_MLA_WA + (size_t)416 * DM * 2); const int nz = 96 * DM * 2 / 16;
      for (int i = blockIdx.x * NTHREADS + tid; i < nz; i += gridDim.x * NTHREADS) z[i] = (u32x4){0u, 0u, 0u, 0u}; }
    __syncthreads();
    if ((int)blockIdx.x < 192 && (parts & 2)) {
        LAS float* cond = (LAS float*)lds;
        typedef float f32x2 __attribute__((ext_vector_type(2)));
        LAS f32x2* red = (LAS f32x2*)(lds + 81920);
        { float cv[34];
#pragma unroll
          for (int r = 0; r < 34; ++r) { const int i = tid + r * NTHREADS, b = i >> 10, k = i & 1023; cv[r] = b < 16 ? a->in[1][b * DM + k] : a->in[3][k]; }
#pragma unroll
          for (int r = 0; r < 34; ++r) { const int i = tid + r * NTHREADS, b = i >> 10, k = i & 1023; cond[k * 20 + b] = cv[r] / (1.0f + __expf(-cv[r])); } }
        __syncthreads();
        const int c2 = tid & 63, kg = tid >> 6;
        for (int u = blockIdx.x; u < 192; u += gridDim.x) {
            const int l = u / 48, cb = u % 48;
            const float* w = a->in[4] + (size_t)l * DM * MODLD + cb * 128 + 2 * c2;
            f32x2 acc[NMODB];
#pragma unroll
            for (int b = 0; b < NMODB; ++b) acc[b] = (f32x2){0.f, 0.f};
#pragma unroll 16
            for (int k = kg * 128; k < kg * 128 + 128; ++k) { const f32x2 wv = *(const f32x2*)(w + (size_t)k * MODLD); const LAS float* cp = cond + k * 20;
#pragma unroll
                for (int b = 0; b < NMODB; ++b) acc[b] += wv * cp[b]; }
#pragma unroll
            for (int st = 4; st >= 1; st >>= 1) {
                if (kg >= st && kg < 2 * st) {
#pragma unroll
                    for (int b = 0; b < NMODB; ++b) red[((kg - st) * NMODB + b) * 64 + c2] = acc[b]; }
                __syncthreads();
                if (kg < st) {
#pragma unroll
                    for (int b = 0; b < NMODB; ++b) acc[b] += red[(kg * NMODB + b) * 64 + c2]; }
                __syncthreads();
            }
            if (kg == 0) { const f32x2 bias = *(const f32x2*)(a->in[5] + l * MODLD + cb * 128 + 2 * c2);
#pragma unroll
                for (int b = 0; b < NMODB; ++b) *(f32x2*)((float*)(ws + WS_MOD) + ((size_t)l * NMODB + b) * MODLD + cb * 128 + 2 * c2) = acc[b] + bias; }
        }
    }
}

__device__ __forceinline__ void norm_phase(const int TID, const float* in_lat, const float* in_ctx, int M, const float* g, const float* sh, const float* sc, bf16_t* A) {
    const int lane = TID & 63, wave = TID >> 6;
    const int gw = blockIdx.x * NWAVES + wave, NGW = gridDim.x * NWAVES;
    f32x4 gv[4];
#pragma unroll
    for (int j = 0; j < 4; ++j) gv[j] = *(const f32x4*)(g + 4 * lane + 256 * j);
    constexpr int NR = 4;
    for (int row0 = gw; row0 < M; row0 += NR * NGW) {
        f32x4 v[NR][4]; float s[NR];
#pragma unroll
        for (int r = 0; r < NR; ++r) { const int row = row0 + r * NGW; const int rc = row < M ? row : row0;
            const float* xr = rc < LAT ? in_lat + (size_t)rc * DM : in_ctx + (size_t)(rc - LAT) * DM;
#pragma unroll
            for (int j = 0; j < 4; ++j) v[r][j] = *(const f32x4*)(xr + 4 * lane + 256 * j); }
#pragma unroll
        for (int r = 0; r < NR; ++r) { float t = 0.f;
#pragma unroll
            for (int j = 0; j < 4; ++j) t += (v[r][j].x * v[r][j].x + v[r][j].y * v[r][j].y) + (v[r][j].z * v[r][j].z + v[r][j].w * v[r][j].w);
            s[r] = t; }
#pragma unroll
        for (int o = 1; o < 64; o <<= 1) {
#pragma unroll
            for (int r = 0; r < NR; ++r) s[r] += __shfl_xor(s[r], o); }
#pragma unroll
        for (int r = 0; r < NR; ++r) { const int row = row0 + r * NGW; if (row >= M) continue;
            const int b = row < LAT ? row / SEQ : 16;
            const float rstd = 1.0f / sqrtf(s[r] * (1.0f / DM) + EPS);
            const float* shp = sh + (size_t)b * MODLD + 4 * lane; const float* scp = sc + (size_t)b * MODLD + 4 * lane;
            bf16_t* op = A + (size_t)row * DM + 4 * lane;
#pragma unroll
            for (int j = 0; j < 4; ++j) { const f32x4 s4 = *(const f32x4*)(scp + 256 * j), h4 = *(const f32x4*)(shp + 256 * j);
                const f32x4 y = (v[r][j] * rstd * gv[j]) * (s4 + 1.0f) + h4;
                u32x2 w; w.x = pk2(y.x, y.y); w.y = pk2(y.z, y.w); *(u32x2*)(op + 256 * j) = w; } }
    }
}

template <int HALFD> __device__ __forceinline__ void rope_table(const int TID, LAS float* tab) {
    for (int i = TID; i < 64 * HALFD; i += NTHREADS) { const int pos = i / HALFD, f = i % HALFD;
        const float fr = powf(10000.0f, -(float)f / (float)HALFD); float sn, cs; sincosf((float)pos * fr, &sn, &cs); tab[2 * i] = cs; tab[2 * i + 1] = sn; }
    __syncthreads();
}

__device__ __forceinline__ void qknorm_phase(const int TID, bf16_t* QKV, int ld, int nq, int nk, const float* gq, const float* gk, bool rope, float qscale, LAS unsigned char* lds) {
    LAS float* tab = (LAS float*)lds;
    if (rope) rope_table<16>(TID, tab);
    const int lane = TID & 63, wave = TID >> 6, l16 = lane & 15;
    const int gw = blockIdx.x * NWAVES + wave, NGW = gridDim.x * NWAVES;
    const f32x4 gq4 = *(const f32x4*)(gq + 4 * l16), gk4 = *(const f32x4*)(gk + 4 * l16);
    const int npass = (nq + nk) / 4;
    for (int row = gw; row < MTOT; row += NGW) {
        const bool dorope = rope && row < LAT; const int t = row & (SEQ - 1);
        const int pos = (l16 & 8) ? (t & 63) : (t >> 6); const int fi = 4 * (l16 & 3); const bool x2 = (l16 & 4) != 0;
        f32x4 cs = {1.f, 1.f, 1.f, 1.f}, sn = {0.f, 0.f, 0.f, 0.f};
        if (dorope) {
#pragma unroll
            for (int j = 0; j < 4; ++j) { cs[j] = tab[2 * (pos * 16 + fi + j)]; sn[j] = tab[2 * (pos * 16 + fi + j) + 1]; } }
        for (int p = 0; p < npass; ++p) {
            const int hh = 4 * p + (lane >> 4); const bool isq = hh < nq;
            bf16_t* ptr = QKV + (size_t)row * ld + hh * 64 + 4 * l16;
            const u32x2 w = *(const u32x2*)ptr;
            f32x4 x = {bflo(w.x), bfhi(w.x), bflo(w.y), bfhi(w.y)};
            float s = (x.x * x.x + x.y * x.y) + (x.z * x.z + x.w * x.w);
            s += __shfl_xor(s, 1); s += __shfl_xor(s, 2); s += __shfl_xor(s, 4); s += __shfl_xor(s, 8);
            const float rstd = 1.0f / sqrtf(s * (1.0f / 64.0f) + EPS);
            x = x * rstd * (isq ? gq4 : gk4);
            f32x4 o;
#pragma unroll
            for (int j = 0; j < 4; ++j) { const float other = __shfl_xor(x[j], 4); o[j] = x2 ? (other * sn[j] + x[j] * cs[j]) : (x[j] * cs[j] - other * sn[j]); }
            if (isq) o = o * qscale;
            u32x2 wo; wo.x = pk2(o.x, o.y); wo.y = pk2(o.z, o.w); *(u32x2*)ptr = wo;
        }
    }
}

__device__ __forceinline__ void mlanorm1_phase(const int TID, bf16_t* PROJ, const float* gcq, const float* gckv) {
    const int lane = TID & 63, wave = TID >> 6;
    const int gw = blockIdx.x * NWAVES + wave, NGW = gridDim.x * NWAVES;
    const f32x4 g1 = *(const f32x4*)(gcq + 4 * lane);
    const float g2a = gckv[2 * lane], g2b = gckv[2 * lane + 1];
    for (int row0 = gw; row0 < MTOT; row0 += 4 * NGW) {
        u32x2 w[4]; unsigned w2[4];
#pragma unroll
        for (int r = 0; r < 4; ++r) { const int row = row0 + r * NGW < MTOT ? row0 + r * NGW : row0; const bf16_t* p = PROJ + (size_t)row * 512; w[r] = *(const u32x2*)(p + 4 * lane); w2[r] = *(const unsigned*)(p + 256 + 2 * lane); }
#pragma unroll
        for (int r = 0; r < 4; ++r) { const int row = row0 + r * NGW; if (row >= MTOT) continue;
            bf16_t* p = PROJ + (size_t)row * 512;
            f32x4 x = {bflo(w[r].x), bfhi(w[r].x), bflo(w[r].y), bfhi(w[r].y)}; float ya = bflo(w2[r]), yb = bfhi(w2[r]);
            const float s1 = wave_sum((x.x * x.x + x.y * x.y) + (x.z * x.z + x.w * x.w)), s2 = wave_sum(ya * ya + yb * yb);
            const float r1 = 1.0f / sqrtf(s1 * (1.0f / 256.0f) + EPS), r2 = 1.0f / sqrtf(s2 * (1.0f / 128.0f) + EPS);
            x = x * r1 * g1; ya *= r2 * g2a; yb *= r2 * g2b;
            u32x2 wo; wo.x = pk2(x.x, x.y); wo.y = pk2(x.z, x.w); *(u32x2*)(p + 4 * lane) = wo; *(unsigned*)(p + 256 + 2 * lane) = pk2(ya, yb); }
    }
}
__device__ __forceinline__ void mlanorm2_phase(const int TID, bf16_t* QR, bf16_t* KV, const bf16_t* PROJ, bf16_t* KR, const float* gq, const float* gk, float qscale, LAS unsigned char* lds) {
    LAS float* tab = (LAS float*)lds;
    rope_table<8>(TID, tab);
    const int lane = TID & 63, wave = TID >> 6, l16 = lane & 15, hq = lane >> 4;
    const int gw = blockIdx.x * NWAVES + wave, NGW = gridDim.x * NWAVES;
    const f32x4 gqn = *(const f32x4*)(gq + 4 * l16), gkn = *(const f32x4*)(gk + 4 * l16);
    const float gqr0 = gq[64 + 2 * l16], gqr1 = gq[65 + 2 * l16], gkr0 = gk[64 + 2 * l16], gkr1 = gk[65 + 2 * l16];
    const int fi = 2 * (l16 & 3); const bool x2 = (l16 & 4) != 0, colpos = (l16 & 8) != 0;
    for (int row = gw; row < MTOT; row += NGW) {
        const bool islat = row < LAT; const int t = row & (SEQ - 1); const int pos = colpos ? (t & 63) : (t >> 6);
        float cs0 = 1.f, sn0 = 0.f, cs1 = 1.f, sn1 = 0.f;
        if (islat) { cs0 = tab[2 * (pos * 8 + fi)]; sn0 = tab[2 * (pos * 8 + fi) + 1]; cs1 = tab[2 * (pos * 8 + fi + 1)]; sn1 = tab[2 * (pos * 8 + fi + 1) + 1]; }
        u32x2 qn[4], kn[4]; unsigned qr[4];
        const bf16_t* qrow = QR + (size_t)(islat ? row : 0) * 1536 + hq * 96;
        bf16_t* krow = KV + (size_t)row * 2048 + hq * 128;
#pragma unroll
        for (int p = 0; p < 4; ++p) { qn[p] = *(const u32x2*)(qrow + p * 384 + 4 * l16); qr[p] = *(const unsigned*)(qrow + p * 384 + 64 + 2 * l16); kn[p] = *(const u32x2*)(krow + p * 512 + 4 * l16); }
        const unsigned krw = *(const unsigned*)(PROJ + (size_t)row * 512 + 384 + 2 * l16);
        if (islat) {
#pragma unroll
            for (int p = 0; p < 4; ++p) { bf16_t* q = QR + (size_t)row * 1536 + (4 * p + hq) * 96;
                f32x4 a = {bflo(qn[p].x), bfhi(qn[p].x), bflo(qn[p].y), bfhi(qn[p].y)}; float c0 = bflo(qr[p]), c1 = bfhi(qr[p]);
                float s = ((a.x * a.x + a.y * a.y) + (a.z * a.z + a.w * a.w)) + (c0 * c0 + c1 * c1); s += __shfl_xor(s, 1); s += __shfl_xor(s, 2); s += __shfl_xor(s, 4); s += __shfl_xor(s, 8);
                const float rstd = 1.0f / sqrtf(s * (1.0f / 96.0f) + EPS);
                a = a * rstd * gqn; c0 *= rstd * gqr0; c1 *= rstd * gqr1;
                const float o0 = __shfl_xor(c0, 4), o1 = __shfl_xor(c1, 4);
                c0 = x2 ? (o0 * sn0 + c0 * cs0) : (c0 * cs0 - o0 * sn0); c1 = x2 ? (o1 * sn1 + c1 * cs1) : (c1 * cs1 - o1 * sn1);
                u32x2 w; w.x = pk2(a.x * qscale, a.y * qscale); w.y = pk2(a.z * qscale, a.w * qscale); *(u32x2*)(q + 4 * l16) = w; *(unsigned*)(q + 64 + 2 * l16) = pk2(c0 * qscale, c1 * qscale); }
        }
#pragma unroll
        for (int p = 0; p < 4; ++p) { const int hh = 4 * p + hq; bf16_t* k = KV + (size_t)row * 2048 + hh * 128;
            f32x4 a = {bflo(kn[p].x), bfhi(kn[p].x), bflo(kn[p].y), bfhi(kn[p].y)}; float c0 = bflo(krw), c1 = bfhi(krw);
            float s = ((a.x * a.x + a.y * a.y) + (a.z * a.z + a.w * a.w)) + (c0 * c0 + c1 * c1); s += __shfl_xor(s, 1); s += __shfl_xor(s, 2); s += __shfl_xor(s, 4); s += __shfl_xor(s, 8);
            const float rstd = 1.0f / sqrtf(s * (1.0f / 96.0f) + EPS);
            a = a * rstd * gkn; c0 *= rstd * gkr0; c1 *= rstd * gkr1;
            const float o0 = __shfl_xor(c0, 4), o1 = __shfl_xor(c1, 4);
            c0 = x2 ? (o0 * sn0 + c0 * cs0) : (c0 * cs0 - o0 * sn0); c1 = x2 ? (o1 * sn1 + c1 * cs1) : (c1 * cs1 - o1 * sn1);
            u32x2 w; w.x = pk2(a.x, a.y); w.y = pk2(a.z, a.w); *(u32x2*)(k + 4 * l16) = w; *(unsigned*)(KR + (size_t)row * 512 + hh * 32 + 2 * l16) = pk2(c0, c1); }
    }
}

__device__ __forceinline__ void pool_phase(const int TID, const bf16_t* A, bf16_t* P, LAS unsigned char* lds) {
    const int tid = TID, lane = tid & 63, wave = tid >> 6;
    u32x4 st[8];
#define POOL_GEO(u_, base_, L_, t0_) do { const int r0_ = 16 * (u_); if (r0_ < LAT) { base_ = r0_ & ~(SEQ - 1); L_ = SEQ; t0_ = r0_ - base_; } else { const int r_ = r0_ - LAT; base_ = LAT + (r_ & ~(CTXL - 1)); L_ = CTXL; t0_ = r_ & (CTXL - 1); } } while (0)
#define POOL_FETCH(u_) do { int base_, L_, t0_; POOL_GEO(u_, base_, L_, t0_); _Pragma("unroll") for (int q = 0; q < 8; ++q) { int i = tid + q * NTHREADS; i = i < 31 * 128 ? i : 31 * 128 - 1; int k = t0_ - 8 + (i >> 7); k = k < 0 ? 0 : (k >= L_ ? L_ - 1 : k); st[q] = *(const u32x4*)(A + (size_t)(base_ + k) * DM + (i & 127) * 8); } } while (0)
    int u = blockIdx.x;
    if (u < MTOT / 16) POOL_FETCH(u);
    for (; u < MTOT / 16; u += gridDim.x) {
        int base, L, t0; POOL_GEO(u, base, L, t0); const int r0 = 16 * u; (void)base;
#pragma unroll
        for (int q = 0; q < 8; ++q) { int i = tid + q * NTHREADS; i = i < 31 * 128 ? i : 31 * 128 - 1; *(LAS u32x4*)(lds + (size_t)i * 16) = st[q]; }
        __syncthreads();
        if (u + (int)gridDim.x < MTOT / 16) POOL_FETCH(u + (int)gridDim.x);
#pragma unroll
        for (int rr = 0; rr < 2; ++rr) { const int tl = 2 * wave + rr, t = t0 + tl;
#pragma unroll
            for (int j = 0; j < 4; ++j) {
                const int w = 2 << j; f32x4 s = {0.f, 0.f, 0.f, 0.f};
                const LAS unsigned char* colp = lds + (256 * j + 4 * lane) * 2;
#pragma unroll
                for (int d = 0; d < 16; ++d) { if (d < w) { const int k = t - w / 2 + d; const float wt = (k >= 0 && k < L) ? 1.0f : 0.0f;
                        const u32x2 v = *(const LAS u32x2*)(colp + (tl + 8 - w / 2 + d) * 2048);
                        s += (f32x4){bflo(v.x), bfhi(v.x), bflo(v.y), bfhi(v.y)} * wt; } }
                const u32x2 sv = *(const LAS u32x2*)(colp + (tl + 8) * 2048); const f32x4 self = {bflo(sv.x), bfhi(sv.x), bflo(sv.y), bfhi(sv.y)};
                int lo = t - w / 2, hi = t - w / 2 + w; lo = lo < 0 ? 0 : lo; hi = hi > L ? L : hi;
                const f32x4 o = s * (1.0f / (float)(hi - lo)) - self;
                u32x2 wo; wo.x = pk2(o.x, o.y); wo.y = pk2(o.z, o.w); *(u32x2*)(P + (size_t)(r0 + tl) * DM + 256 * j + 4 * lane) = wo; } }
        __syncthreads();
    }
#undef POOL_GEO
#undef POOL_FETCH
}

typedef short v4i16_t __attribute__((ext_vector_type(4)));
constexpr float ATT_THR = 8.0f;
__device__ __forceinline__ int crow16(int r, int hi) { return (r & 3) + 8 * (r >> 2) + 4 * hi; }
template <int MODE> __device__ __forceinline__ void attn_phase(const int TID, KArgs a, LAS unsigned char* lds) {
    constexpr int DQK = MODE == 2 ? 96 : 64, NKS = DQK / 16;
    constexpr int KROWB = DQK * 2 + 16, KBUF = 64 * KROWB, KSTR = (MODE == 1 ? 2 : 1) * KBUF, VSTR = (MODE == 1 ? 2 : 1) * 8192, VOFF = 2 * KSTR, BIASOFF = VOFF + 2 * VSTR;
    const int tid = TID, lane = tid & 63, wid = __builtin_amdgcn_readfirstlane(tid >> 6), r32 = lane & 31, hi = lane >> 5;
    unsigned char* ws = a->ws;
    const bf16_t *Qb, *Kb, *K2b = nullptr, *Vb; bf16_t* Ob; int ldq, ldk;
    if (MODE == 0) { Qb = (const bf16_t*)(ws + WS_RB); ldq = 1536; Kb = Qb + 1024; Vb = Qb + 1280; ldk = 1536; Ob = (bf16_t*)(ws + WS_RO); }
    else if (MODE == 1) { Qb = (const bf16_t*)(ws + WS_RB); ldq = 3072; Kb = Qb + 1024; Vb = Qb + 2048; ldk = 3072; Ob = (bf16_t*)(ws + WS_RO); }
    else { Qb = (const bf16_t*)(ws + WS_QR); ldq = 1536; Kb = (const bf16_t*)(ws + WS_KV); Vb = Kb + 64; K2b = (const bf16_t*)(ws + WS_KR); ldk = 2048; Ob = (bf16_t*)(ws + WS_RA); }
    const int G = gridDim.x, bx = blockIdx.x, vcu = (G % 8 == 0) ? (bx % 8) * (G / 8) + bx / 8 : bx;
    constexpr int NLAT = 2048, NCTXU = MODE == 2 ? 0 : 256;
    const int lat_per = (NLAT + G - 1) / G, ctx_per = (NCTXU + G - 1) / G;
    LAS float* btab = (LAS float*)(lds + BIASOFF);
    const int srow = tid >> 3, sch = tid & 7, s2row = tid >> 2, s2ch = tid & 3;
    const int kst = srow * KROWB + sch * 16, k2st = s2row * KROWB + 128 + s2ch * 16, vst = (sch >> 2) * 4096 + srow * 64 + (sch & 3) * 16;
    const int vrd = (4 * hi + ((lane & 15) >> 2)) * 64 + (16 * ((lane >> 4) & 1) + 4 * (lane & 3)) * 2;
    u32x4 kreg, k2reg = {0u, 0u, 0u, 0u}, vreg;
    u32x4 kregB = {0u, 0u, 0u, 0u}, vregB = {0u, 0u, 0u, 0u};
    bool pref = false;
    int bias_head = -1;
    for (int it = 0; it < lat_per + ctx_per; ++it) {
        const bool ctxu = it >= lat_per;
        const int u = ctxu ? vcu * ctx_per + (it - lat_per) : vcu * lat_per + it;
        if (u >= (ctxu ? NCTXU : NLAT)) continue;
        int b, head, hoff, qrow, NT, lat0 = 0, qtok = 0, jj_lo = 0, rrow = 0, R0 = 0, nl = 0;
        if (MODE == 0) {
            if (!ctxu) { b = u >> 7; const int kvh = (u >> 5) & 3, qb = u & 31; head = kvh * 4 + (wid >> 1); hoff = kvh * 64; qtok = qb * 64 + (wid & 1) * 32 + r32; qrow = b * SEQ + qtok;
                jj_lo = 2 - qb > 0 ? 2 - qb : 0; const int jj_hi = 33 - qb < 4 ? 33 - qb : 4; lat0 = b * SEQ + qb * 64 - 128 + 64 * jj_lo; NT = 4 + (jj_hi - jj_lo + 1); }
            else { b = u >> 4; const int kvh = (u >> 2) & 3, qb = u & 3; head = kvh * 4 + (wid >> 1); hoff = kvh * 64; qtok = qb * 64 + (wid & 1) * 32 + r32; qrow = LAT + b * CTXL + qtok; NT = 4; }
        } else if (MODE == 1) {
            if (!ctxu) { b = u >> 7; head = (u >> 3) & 15; const int rq = u & 7; hoff = head * 64; rrow = 4 * rq + (r32 >> 3); qtok = 8 * wid + (r32 & 7); qrow = b * SEQ + rrow * 64 + qtok;
                R0 = 4 * rq - 4; R0 = R0 < 0 ? 0 : (R0 > 24 ? 24 : R0); int R1 = 4 * rq - 1; R1 = (R1 < 0 ? 0 : (R1 > 24 ? 24 : R1)) + 7; lat0 = b * SEQ + R0 * 64; nl = R1 - R0 + 1; NT = 4 + (nl + 1) / 2; }
            else { b = u >> 4; head = u & 15; hoff = head * 64; qrow = LAT + b * CTXL + wid * 32 + r32; NT = 4; }
        } else { b = u >> 7; head = (u >> 3) & 15; const int qb = u & 7; hoff = head * 128; qrow = b * SEQ + qb * 256 + wid * 32 + r32; lat0 = b * SEQ; NT = 4 + 32; }
        const int ctx0 = LAT + b * CTXL;
        bf16x8 qf[NKS];
        { const bf16_t* qp = Qb + (size_t)qrow * ldq + head * DQK + 8 * hi;
#pragma unroll
          for (int ks = 0; ks < NKS; ++ks) qf[ks] = *(const bf16x8*)(qp + 16 * ks); }
        if (MODE == 1 && !ctxu && head != bias_head) { const float* rp = a->in[18] + (size_t)head * 465; for (int i = tid; i < 465; i += NTHREADS) btab[64 + i] = rp[i] * LOG2E; bias_head = head; }
#define ATT_TILE_ROW(j) ((j) < 4 ? ctx0 + 64 * (j) : lat0 + (MODE == 1 ? 128 : 64) * ((j) - 4))
#define ATT_TILE_ROWB(j) (lat0 + 64 * ((2 * ((j) - 4) + 1 < nl) ? 2 * ((j) - 4) + 1 : nl - 1))
#define ATT_LOAD(j) do { const int kr0_ = ATT_TILE_ROW(j); kreg = *(const u32x4*)(Kb + (size_t)(kr0_ + srow) * ldk + hoff + sch * 8); vreg = *(const u32x4*)(Vb + (size_t)(kr0_ + srow) * ldk + hoff + sch * 8); \
        if (MODE == 2 && tid < 256) k2reg = *(const u32x4*)(K2b + (size_t)(kr0_ + s2row) * 512 + head * 32 + s2ch * 8); \
        if (MODE == 1 && (j) >= 4) { const int krb_ = ATT_TILE_ROWB(j); kregB = *(const u32x4*)(Kb + (size_t)(krb_ + srow) * ldk + hoff + sch * 8); vregB = *(const u32x4*)(Vb + (size_t)(krb_ + srow) * ldk + hoff + sch * 8); } } while (0)
#define ATT_STORE(buf, jt) do { *(LAS u32x4*)(lds + (buf) * KSTR + kst) = kreg; *(LAS u32x4*)(lds + VOFF + (buf) * VSTR + vst) = vreg; if (MODE == 2 && tid < 256) *(LAS u32x4*)(lds + (buf) * KSTR + k2st) = k2reg; \
        if (MODE == 1 && (jt) >= 4) { *(LAS u32x4*)(lds + (buf) * KSTR + KBUF + kst) = kregB; *(LAS u32x4*)(lds + VOFF + (buf) * VSTR + 8192 + vst) = vregB; } } while (0)
#define ATT_LOAD0N(B_, HOFF_, HEAD_) do { const int kr0_ = LAT + (B_) * CTXL; kreg = *(const u32x4*)(Kb + (size_t)(kr0_ + srow) * ldk + (HOFF_) + sch * 8); vreg = *(const u32x4*)(Vb + (size_t)(kr0_ + srow) * ldk + (HOFF_) + sch * 8); \
        if (MODE == 2 && tid < 256) k2reg = *(const u32x4*)(K2b + (size_t)(kr0_ + s2row) * 512 + (HEAD_) * 32 + s2ch * 8); } while (0)
        if (!pref) ATT_LOAD(0);
        ATT_STORE(0, 0);
        __syncthreads();
        f32x16 o0, o1;
#pragma unroll
        for (int i = 0; i < 16; ++i) { o0[i] = 0.f; o1[i] = 0.f; }
        float l = 0.f;
        f32x16 zacc;
#pragma unroll
        for (int i = 0; i < 16; ++i) zacc[i] = 0.f;
        int r0w = rrow - 4; r0w = r0w < 0 ? 0 : (r0w > 24 ? 24 : r0w);
        int cs = qtok - 8; cs = cs < 0 ? 0 : (cs > 48 ? 48 : cs);
        for (int j = 0; j < NT; ++j) {
            if (j + 1 < NT) ATT_LOAD(j + 1);
            else {
                const int itn = it + 1; pref = false;
                if (itn < lat_per + ctx_per) { const bool cn = itn >= lat_per; const int un = cn ? vcu * ctx_per + (itn - lat_per) : vcu * lat_per + itn;
                    if (un < (cn ? NCTXU : NLAT)) { int bn, hn, hoffn;
                        if (MODE == 0) { bn = cn ? un >> 4 : un >> 7; const int kvh = cn ? (un >> 2) & 3 : (un >> 5) & 3; hn = 0; hoffn = kvh * 64; }
                        else if (MODE == 1) { bn = cn ? un >> 4 : un >> 7; hn = cn ? un & 15 : (un >> 3) & 15; hoffn = hn * 64; }
                        else { bn = un >> 7; hn = (un >> 3) & 15; hoffn = hn * 128; }
                        ATT_LOAD0N(bn, hoffn, hn); pref = true; } } }
            const int buf = j & 1;
            bool active = true, masked = false; int kr = 0, kstart = 0;
            if (MODE == 0 && j >= 4) { const int jj = jj_lo + (j - 4); masked = (jj == 0 || jj == 4); kstart = (lat0 - b * SEQ) + 64 * (j - 4); }
            if (MODE == 1 && j >= 4) { kr = R0 + 2 * (j - 4); active = false; }
            if (MODE == 1 && j >= 4) {
                const int wsk = wid == 0 ? 0 : (wid > 5 ? 32 : 8 * wid - 8);
                const bool hasB = 2 * (j - 4) + 1 < nl;
                const LAS unsigned char* kb = lds + buf * KSTR + (wsk + r32) * KROWB + hi * 16;
                bf16x8 kf0[NKS], kf1[NKS];
#pragma unroll
                for (int ks = 0; ks < NKS; ++ks) { kf0[ks] = *(const LAS bf16x8*)(kb + ks * 32); kf1[ks] = *(const LAS bf16x8*)(kb + KBUF + ks * 32); }
                __builtin_amdgcn_sched_barrier(0);
                f32x16 s0, s1;
#pragma unroll
                for (int ks = 0; ks < NKS; ++ks) { s0 = __builtin_amdgcn_mfma_f32_32x32x16_bf16(kf0[ks], qf[ks], ks == 0 ? zacc : s0, 0, 0, 0); s1 = __builtin_amdgcn_mfma_f32_32x32x16_bf16(kf1[ks], qf[ks], ks == 0 ? zacc : s1, 0, 0, 0); }
                const LAS unsigned char* vb = lds + VOFF + buf * VSTR + vrd + wsk * 64;
                v4i16_t vlo[8], vhi[8];
#pragma unroll
                for (int s = 0; s < 4; ++s)
#pragma unroll
                    for (int dh = 0; dh < 2; ++dh) { const int off = (s >> 1) * 8192 + dh * 4096 + (s & 1) * 1024;
                        vlo[2 * s + dh] = __builtin_amdgcn_ds_read_tr16_b64_v4i16((LAS v4i16_t*)(vb + off)); vhi[2 * s + dh] = __builtin_amdgcn_ds_read_tr16_b64_v4i16((LAS v4i16_t*)(vb + off + 512)); }
                const bool rowokA = (unsigned)(kr - r0w) < 8u, rowokB = hasB && (unsigned)(kr + 1 - r0w) < 8u;
                const LAS float* bpA = btab + 64 + (kr - rrow + 7) * 31 + 15 - qtok + wsk + 4 * hi; const LAS float* bpB = hasB ? bpA + 31 : bpA;
                const int e0A = rowokA ? wsk + 4 * hi - cs : -1000, e0B = rowokB ? wsk + 4 * hi - cs : -1000;
                float bvA[16], bvB[16];
#pragma unroll
                for (int i = 0; i < 16; ++i) { bvA[i] = bpA[(i & 3) + 8 * (i >> 2)]; bvB[i] = bpB[(i & 3) + 8 * (i >> 2)]; }
                __builtin_amdgcn_sched_barrier(0);
                bf16x8 pf[4];
                float ls = 0.f;
#pragma unroll
                for (int i = 0; i < 16; ++i) { const int c = (i & 3) + 8 * (i >> 2); const float sb = s0[i] + bvA[i]; const float sv = (unsigned)(e0A + c) < 16u ? sb : -1e30f; s0[i] = __builtin_amdgcn_exp2f(sv); ls += s0[i]; }
#pragma unroll
                for (int s = 0; s < 2; ++s) { u32x4 w;
#pragma unroll
                    for (int e = 0; e < 4; ++e) { const int r = 8 * s + 2 * e; w[e] = pg8::cvt_pk_bf16(s0[r], s0[r + 1]); }
                    pf[s] = __builtin_bit_cast(bf16x8, w); }
                __builtin_amdgcn_sched_barrier(0);
#pragma unroll
                for (int s = 0; s < 2; ++s) {
                    const bf16x8 vf0 = __builtin_shufflevector(vlo[2 * s], vhi[2 * s], 0, 1, 2, 3, 4, 5, 6, 7), vf1 = __builtin_shufflevector(vlo[2 * s + 1], vhi[2 * s + 1], 0, 1, 2, 3, 4, 5, 6, 7);
                    o0 = __builtin_amdgcn_mfma_f32_32x32x16_bf16(vf0, pf[s], o0, 0, 0, 0); o1 = __builtin_amdgcn_mfma_f32_32x32x16_bf16(vf1, pf[s], o1, 0, 0, 0); }
                __builtin_amdgcn_sched_barrier(0);
#pragma unroll
                for (int i = 0; i < 16; ++i) { const int c = (i & 3) + 8 * (i >> 2); const float sb = s1[i] + bvB[i]; const float sv = (unsigned)(e0B + c) < 16u ? sb : -1e30f; s1[i] = __builtin_amdgcn_exp2f(sv); ls += s1[i]; }
                l += ls;
#pragma unroll
                for (int s = 2; s < 4; ++s) { u32x4 w;
#pragma unroll
                    for (int e = 0; e < 4; ++e) { const int r = 8 * (s & 1) + 2 * e; w[e] = pg8::cvt_pk_bf16(s1[r], s1[r + 1]); }
                    pf[s] = __builtin_bit_cast(bf16x8, w); }
                __builtin_amdgcn_sched_barrier(0);
#pragma unroll
                for (int s = 2; s < 4; ++s) {
                    const bf16x8 vf0 = __builtin_shufflevector(vlo[2 * s], vhi[2 * s], 0, 1, 2, 3, 4, 5, 6, 7), vf1 = __builtin_shufflevector(vlo[2 * s + 1], vhi[2 * s + 1], 0, 1, 2, 3, 4, 5, 6, 7);
                    o0 = __builtin_amdgcn_mfma_f32_32x32x16_bf16(vf0, pf[s], o0, 0, 0, 0); o1 = __builtin_amdgcn_mfma_f32_32x32x16_bf16(vf1, pf[s], o1, 0, 0, 0); }
            }
            if (active) {
                const LAS unsigned char* kb = lds + buf * KSTR + r32 * KROWB + hi * 16;
                f32x16 s0, s1;
                bf16x8 kf0[NKS], kf1[NKS];
#pragma unroll
                for (int ks = 0; ks < NKS; ++ks) { kf0[ks] = *(const LAS bf16x8*)(kb + ks * 32); kf1[ks] = *(const LAS bf16x8*)(kb + 32 * KROWB + ks * 32); }
                const LAS unsigned char* vb = lds + VOFF + buf * VSTR + vrd;
                v4i16_t vlo[8], vhi[8];
#pragma unroll
                for (int s = 0; s < 4; ++s)
#pragma unroll
                    for (int dh = 0; dh < 2; ++dh) { vlo[2 * s + dh] = __builtin_amdgcn_ds_read_tr16_b64_v4i16((LAS v4i16_t*)(vb + dh * 4096 + s * 1024)); vhi[2 * s + dh] = __builtin_amdgcn_ds_read_tr16_b64_v4i16((LAS v4i16_t*)(vb + dh * 4096 + s * 1024 + 512)); }
                __builtin_amdgcn_sched_barrier(0);
#pragma unroll
                for (int ks = 0; ks < NKS; ++ks) {
                    s0 = __builtin_amdgcn_mfma_f32_32x32x16_bf16(kf0[ks], qf[ks], ks == 0 ? zacc : s0, 0, 0, 0); s1 = __builtin_amdgcn_mfma_f32_32x32x16_bf16(kf1[ks], qf[ks], ks == 0 ? zacc : s1, 0, 0, 0); }
                __builtin_amdgcn_sched_barrier(0);
                if (MODE == 0 && masked) { const int d0 = qtok - kstart - 4 * hi + 128;
#pragma unroll
                    for (int i = 0; i < 16; ++i) { const int c = (i & 3) + 8 * (i >> 2); if ((unsigned)(d0 - c) > 256u) s0[i] = -1e30f; if ((unsigned)(d0 - c - 32) > 256u) s1[i] = -1e30f; } }
                bf16x8 pf[4];
                float ls = 0.f;
#pragma unroll
                for (int i = 0; i < 16; ++i) { s0[i] = __builtin_amdgcn_exp2f(s0[i]); ls += s0[i]; }
#pragma unroll
                for (int s = 0; s < 2; ++s) { u32x4 w;
#pragma unroll
                    for (int e = 0; e < 4; ++e) { const int r = 8 * s + 2 * e; w[e] = pg8::cvt_pk_bf16(s0[r], s0[r + 1]); }
                    pf[s] = __builtin_bit_cast(bf16x8, w); }
                __builtin_amdgcn_sched_barrier(0);
#pragma unroll
                for (int s = 0; s < 2; ++s) {
                    const bf16x8 vf0 = __builtin_shufflevector(vlo[2 * s], vhi[2 * s], 0, 1, 2, 3, 4, 5, 6, 7), vf1 = __builtin_shufflevector(vlo[2 * s + 1], vhi[2 * s + 1], 0, 1, 2, 3, 4, 5, 6, 7);
                    o0 = __builtin_amdgcn_mfma_f32_32x32x16_bf16(vf0, pf[s], o0, 0, 0, 0); o1 = __builtin_amdgcn_mfma_f32_32x32x16_bf16(vf1, pf[s], o1, 0, 0, 0); }
                __builtin_amdgcn_sched_barrier(0);
#pragma unroll
                for (int i = 0; i < 16; ++i) { s1[i] = __builtin_amdgcn_exp2f(s1[i]); ls += s1[i]; }
                l += ls;
#pragma unroll
                for (int s = 2; s < 4; ++s) { u32x4 w;
#pragma unroll
                    for (int e = 0; e < 4; ++e) { const int r = 8 * (s & 1) + 2 * e; w[e] = pg8::cvt_pk_bf16(s1[r], s1[r + 1]); }
                    pf[s] = __builtin_bit_cast(bf16x8, w); }
                __builtin_amdgcn_sched_barrier(0);
#pragma unroll
                for (int s = 2; s < 4; ++s) {
                    const bf16x8 vf0 = __builtin_shufflevector(vlo[2 * s], vhi[2 * s], 0, 1, 2, 3, 4, 5, 6, 7), vf1 = __builtin_shufflevector(vlo[2 * s + 1], vhi[2 * s + 1], 0, 1, 2, 3, 4, 5, 6, 7);
                    o0 = __builtin_amdgcn_mfma_f32_32x32x16_bf16(vf0, pf[s], o0, 0, 0, 0); o1 = __builtin_amdgcn_mfma_f32_32x32x16_bf16(vf1, pf[s], o1, 0, 0, 0); }
            }
            if (j + 1 < NT) ATT_STORE(buf ^ 1, j + 1);
            __syncthreads();
        }
#undef ATT_TILE_ROW
#undef ATT_TILE_ROWB
#undef ATT_LOAD
#undef ATT_STORE
#undef ATT_LOAD0N
        l += __shfl_xor(l, 32);
        if (MODE == 0) l += __builtin_amdgcn_exp2f(a->in[13][head] * LOG2E);
        const float inv = 1.0f / l;
        bf16_t* op = Ob + (size_t)qrow * DM + head * 64 + 8 * hi;
#pragma unroll
        for (int k = 0; k < 2; ++k)
#pragma unroll
            for (int dh = 0; dh < 2; ++dh) {
                const unsigned A0 = dh ? pg8::cvt_pk_bf16(o1[8 * k] * inv, o1[8 * k + 1] * inv) : pg8::cvt_pk_bf16(o0[8 * k] * inv, o0[8 * k + 1] * inv);
                const unsigned A1 = dh ? pg8::cvt_pk_bf16(o1[8 * k + 2] * inv, o1[8 * k + 3] * inv) : pg8::cvt_pk_bf16(o0[8 * k + 2] * inv, o0[8 * k + 3] * inv);
                const unsigned B0 = dh ? pg8::cvt_pk_bf16(o1[8 * k + 4] * inv, o1[8 * k + 5] * inv) : pg8::cvt_pk_bf16(o0[8 * k + 4] * inv, o0[8 * k + 5] * inv);
                const unsigned B1 = dh ? pg8::cvt_pk_bf16(o1[8 * k + 6] * inv, o1[8 * k + 7] * inv) : pg8::cvt_pk_bf16(o0[8 * k + 6] * inv, o0[8 * k + 7] * inv);
                const auto r0 = __builtin_amdgcn_permlane32_swap(A0, B0, false, false), r1 = __builtin_amdgcn_permlane32_swap(A1, B1, false, false);
                u32x4 w; w.x = r0[0]; w.y = r1[0]; w.z = r0[1]; w.w = r1[1];
                *(u32x4*)(op + 32 * dh + 16 * k) = w; }
    }
}

enum Kind { K_PRO = 0, K_N1, K_G1, K_QKN, K_ATT, K_G2, K_N2, K_G3, K_G4, K_POOL, K_GPOOL, K_GPROJ, K_MLAN1, K_GUP, K_MLAN2 };
constexpr int NPHASES = 23;
__device__ __forceinline__ void decode_phase(int p, int& L, int& kind) {
    if (p == 0) { L = 0; kind = K_PRO; return; }
    if (p <= 6) { L = 0; const int k = p - 1; kind = k == 0 ? K_N1 : k == 1 ? K_G1 : k == 2 ? K_ATT : k == 3 ? K_G2 : k == 4 ? K_G3 : K_G4; return; }
    if (p <= 11) { L = 1; const int k = p - 7; kind = k == 0 ? K_G1 : k == 1 ? K_ATT : k == 2 ? K_G2 : k == 3 ? K_G3 : K_G4; return; }
    if (p <= 15) { L = 2; const int k = p - 12; kind = k == 0 ? K_POOL : k == 1 ? K_GPOOL : k == 2 ? K_G3 : K_G4; return; }
    L = 3; const int k = p - 16;
    kind = k == 0 ? K_GPROJ : k == 1 ? K_GUP : k == 2 ? K_MLAN2 : k == 3 ? K_ATT : k == 4 ? K_G2 : k == 5 ? K_G3 : K_G4;
}

__device__ __forceinline__ int mk_lane_id() { int l; asm volatile("v_mbcnt_lo_u32_b32 %0, -1, 0\n\tv_mbcnt_hi_u32_b32 %0, -1, %0" : "=v"(l)); return l; }
#define XB_TMO      128
#define XB_XCNT(j)  (256  + 64 * (j))
#define XB_XSUB(j)  (1280 + 64 * (j))
#define XB_XGEN(j)  (2304 + 64 * (j))
#define XB_TOP      3328
#define XB_TOPGEN   3392
#define XCD_BAR_WORDS 3456
#define XB_SPIN_CAP (1u << 18)

__device__ __forceinline__ unsigned xb_ld(unsigned* p)              { return __hip_atomic_load(p, __ATOMIC_RELAXED, __HIP_MEMORY_SCOPE_AGENT); }
__device__ __forceinline__ unsigned xb_add(unsigned* p, unsigned v) { return __hip_atomic_fetch_add(p, v, __ATOMIC_RELAXED, __HIP_MEMORY_SCOPE_AGENT); }
__device__ __forceinline__ unsigned xb_xcc_id() { return (unsigned)__builtin_amdgcn_s_getreg((3 << 11) | 20) & 0xFu; }
#define XB_SPIN(cond, bar) do { unsigned _sp = 0; while (cond) { __builtin_amdgcn_s_sleep(1); \
    if ((++_sp & 255u) == 0u) { if (xb_ld(&(bar)[XB_TMO])) break; if (_sp > XB_SPIN_CAP) { atomicAdd(&(bar)[XB_TMO], 1u); break; } } } } while (0)

struct XcdBarrier {
    bool w0;
    unsigned* bar; unsigned x;
    volatile LAS unsigned* st;
};

__device__ __forceinline__ XcdBarrier xcd_barrier_post(unsigned* bar, volatile LAS unsigned* st) {
    XcdBarrier b; b.bar = bar; b.x = xb_xcc_id(); b.st = st; b.w0 = false;
    if (threadIdx.x == 0) (void)xb_add(&bar[XB_XCNT(b.x)], 1u);
    return b;
}
__device__ __forceinline__ void xcd_barrier_complete(unsigned* bar, unsigned x, unsigned& nloc, unsigned& nx) {
    const unsigned G = gridDim.x * gridDim.y * gridDim.z;
    unsigned sum, cnt, mine, sp = 0u;
    for (;;) {
        sum = 0u; cnt = 0u; mine = 0u;
#pragma unroll
        for (unsigned j = 0; j < 16; ++j) { const unsigned c = xb_ld(&bar[XB_XCNT(j)]); sum += c; cnt += (c > 0u) ? 1u : 0u; mine = (j == x) ? c : mine; }
        if (sum == G) break;
        __builtin_amdgcn_s_sleep(1);
        if ((++sp & 255u) == 0u) { if (xb_ld(&bar[XB_TMO])) break; if (sp > XB_SPIN_CAP) { atomicAdd(&bar[XB_TMO], 1u); break; } }
    }
    nloc = mine > 0u ? mine : 1u; nx = cnt > 0u ? cnt : 1u;
}

__device__ __forceinline__ void xcd_barrier(const XcdBarrier& b) {
    asm volatile("s_waitcnt vmcnt(0)" ::: "memory");
    __syncthreads();
    if (b.w0 && mk_lane_id() == 0) {
        unsigned* bar = b.bar;
        __builtin_amdgcn_s_waitcnt(0);
        unsigned nloc = b.st[0], nx = b.st[1];
        if (nloc == 0u) { xcd_barrier_complete(bar, b.x, nloc, nx); b.st[0] = nloc; b.st[1] = nx; }
        const unsigned old = xb_add(&bar[XB_XSUB(b.x)], 1u);
        const unsigned gen = old / nloc;
        if (old + 1u == (gen + 1u) * nloc) {
            __builtin_amdgcn_fence(__ATOMIC_RELEASE, "agent");
            asm volatile("s_waitcnt vmcnt(0)" ::: "memory");
            const unsigned og = xb_add(&bar[XB_TOP], 1u);
            const unsigned tg = og / nx;
            if (og + 1u == (tg + 1u) * nx) xb_add(&bar[XB_TOPGEN], 1u);
            else XB_SPIN(xb_ld(&bar[XB_TOPGEN]) == tg, bar);
            __builtin_amdgcn_fence(__ATOMIC_ACQUIRE, "agent");
            xb_add(&bar[XB_XGEN(b.x)], 1u);
            asm volatile("s_waitcnt vmcnt(0)" ::: "memory");
        } else {
            XB_SPIN(xb_ld(&bar[XB_XGEN(b.x)]) == gen, bar);
            __builtin_amdgcn_fence(__ATOMIC_ACQUIRE, "agent");
            asm volatile("s_waitcnt vmcnt(0)" ::: "memory");
        }
    }
    __syncthreads();
}

#ifndef RESID_STAGGER
#define RESID_STAGGER 0
#endif
#ifndef PROBE_KIND
#define PROBE_KIND -1
#endif
#ifndef PROBE_N
#define PROBE_N 0
#endif
#ifndef PROBE_L
#define PROBE_L -1
#endif
#ifndef PROBE_PLAIN
#define PROBE_PLAIN 0
#endif
#ifndef PROBE_SYNC
#define PROBE_SYNC 0
#endif
__global__ void __launch_bounds__(NTHREADS) fwd_kernel(Args a_by_value) {
    extern __shared__ __attribute__((aligned(16))) unsigned char lds_raw[];
    LAS unsigned char* lds = (LAS unsigned char*)lds_raw;
    cg::grid_group grid = cg::this_grid();
    const int ph_lo = a_by_value.ph_lo, ph_hi = a_by_value.ph_hi;
    volatile LAS unsigned* MISC = (volatile LAS unsigned*)(lds + 131072);
    if (threadIdx.x < 4) MISC[threadIdx.x] = 0u;
    __syncthreads();
    XcdBarrier xbar = xcd_barrier_post((unsigned*)(a_by_value.ws + WS_CTL), MISC);
    const int wave_id = __builtin_amdgcn_readfirstlane((int)(threadIdx.x >> 6));
    xbar.w0 = wave_id == 0;
    if (ph_hi > 4096) grid.sync();
    for (int q = ph_lo * (1 + PROBE_N); q < ph_hi * (1 + PROBE_N); ++q) {
        const int p = q / (1 + PROBE_N);
        int L, kind; decode_phase(p, L, kind);
        const bool extra_visit = PROBE_N > 0 && (q % (1 + PROBE_N)) != 0;
        if (extra_visit && (kind != PROBE_KIND || (PROBE_L >= 0 && L != PROBE_L))) continue;
        KArgs a = (KArgs)__builtin_amdgcn_kernarg_segment_ptr(); asm volatile("" : "+s"(a));
        unsigned char* ws = a->ws;
        const float* MOD = (const float*)(ws + WS_MOD);
        float* HC = (float*)(ws + WS_HC);
        bf16_t* RA = (bf16_t*)(ws + WS_RA); bf16_t* RO = (bf16_t*)(ws + WS_RO); bf16_t* RB = (bf16_t*)(ws + WS_RB);
        int TID = wave_id * 64 + mk_lane_id(); asm volatile("" : "+v"(TID));
        const float* modL = MOD + (size_t)L * NMODB * MODLD;
        const int Mffn = L == 3 ? LAT : MTOT;
        if (kind == K_PRO) {
            prologue_phase(TID, a, lds, (extra_visit && PROBE_PLAIN) ? PROBE_PLAIN : 3);
        } else if (kind == K_N1) {
            norm_phase(TID, a->in[0], a->in[2], MTOT, a->in[6], modL, modL + DM, RA);
        } else if (kind == K_G1) {
            const int N = L == 0 ? 1536 : 3072;
            pg8::Gemm g{RA, (const bf16_t*)(ws + (L == 0 ? WS_SWA_QKV : WS_NA_QKV)), MTOT, N, DM, DM, DM, 0};
            pg8::EpiQKV E{RB, N, 4, L == 0 ? 1 : 4, L == 0 ? 1 : 0, L == 0 ? 11 : 16, L == 0 ? 12 : 17, 0.125f * LOG2E, (unsigned)WS_ROPE};
            pg8::StaticOrder S; S.init(g.M, g.N, (int)gridDim.x, (int)blockIdx.x);
            pg8::gemm_phase<pg8::EpiQKV, pg8::StaticOrder, true, true>(lds, g, S, E, TID);
        } else if (kind == K_GPROJ || kind == K_GUP) {
            const int nrep = kind == K_GUP ? 2 : 1;
            for (int rep = 0; rep < nrep; ++rep) {
                pg8::Gemm g; pg8::EpiStore E;
                if (kind == K_GPROJ) { g = pg8::Gemm{RA, (const bf16_t*)(ws + WS_MLA_WA), MTOT, 512, DM, DM, DM, 0}; E = pg8::EpiStore{(bf16_t*)(ws + WS_PROJ), 512, 1, a->in[24], a->in[25]}; }
                else if (rep == 0) { g = pg8::Gemm{(const bf16_t*)(ws + WS_PROJ), (const bf16_t*)(ws + WS_MLA_WUQ), LAT, 1536, 256, 512, 256, 0}; E = pg8::EpiStore{(bf16_t*)(ws + WS_QR), 1536, 0, nullptr, nullptr}; }
                else { g = pg8::Gemm{(const bf16_t*)(ws + WS_PROJ) + 256, (const bf16_t*)(ws + WS_MLA_WUKV), MTOT, 2048, 128, 512, 128, 0}; E = pg8::EpiStore{(bf16_t*)(ws + WS_KV), 2048, 0, nullptr, nullptr}; }
                pg8::StaticOrder S; S.init(g.M, g.N, (int)gridDim.x, (int)blockIdx.x);
                pg8::gemm_phase<pg8::EpiStore, pg8::StaticOrder, true, true>(lds, g, S, E, TID);
            }
        } else if (kind == K_G3) {
            pg8::Gemm g{L == 3 ? RO : RA, (const bf16_t*)(ws + WS_WGU + (size_t)L * SZ_WGU), Mffn, 2 * DFF, DM, DM, DM, 0};
            pg8::EpiSwiglu E{RB, DFF};
            pg8::StaticOrder S; S.init(g.M, g.N, (int)gridDim.x, (int)blockIdx.x);
            pg8::gemm_phase<pg8::EpiSwiglu, pg8::StaticOrder, true, true>(lds, g, S, E, TID);
        } else if (kind == K_G2 || kind == K_GPOOL || kind == K_G4) {
            pg8::Gemm g; pg8::EpiResid E;
            E.first = (L == 0 && kind == K_G2) ? 1 : 0; E.pool = kind == K_GPOOL ? 1 : 0; E.mod_byte = (unsigned)WS_MOD; E.hc_byte = (unsigned)WS_HC;
            E.gate_off = L * NMODB * MODLD + (kind == K_G4 ? 5 * DM : 2 * DM);
            const bool ffn = kind == K_G4;
            const int Ln = ffn ? L + 1 : L, pi = 2 * L + (ffn ? 1 : 0) - (L == 3 ? 0 : 0);
            E.donorm = ((ffn && L == 3) || (PROBE_PLAIN && extra_visit)) ? 0 : 1; E.g_in = ffn ? 6 : 7; E.g_off = Ln * DM; E.nmod_off = Ln * NMODB * MODLD + (ffn ? 0 : 3 * DM);
            E.a_byte = (L == 3 && !ffn) ? WS_RO : WS_RA; E.cnt_byte = (unsigned)(WS_CNT + (size_t)pi * 144 * 64); E.xbuf_byte = WS_XBUF + (size_t)pi * MTOT * 16;
            if (kind == K_G2) { const size_t wo = L == 0 ? WS_SWA_WO : L == 1 ? WS_NA_WO : WS_MLA_WO; g = pg8::Gemm{L == 3 ? RA : RO, (const bf16_t*)(ws + wo), Mffn, DM, DM, DM, DM, 0}; }
            else if (kind == K_GPOOL) { g = pg8::Gemm{RO, (const bf16_t*)(ws + WS_POOL), MTOT, DM, 256, DM, 256, 256}; }
            else { g = pg8::Gemm{RB, (const bf16_t*)(ws + WS_WDN + (size_t)L * SZ_WDN), Mffn, DM, DFF, DFF, DFF, 0}; }
            pg8::PanelOrder S; S.init(g.M, g.N, (int)gridDim.x, (int)blockIdx.x);
            if (RESID_STAGGER && g.M == MTOT && (int)gridDim.x == 256 && ((int)blockIdx.x >> 5) >= 2) {
                const unsigned long long t0 = __builtin_amdgcn_s_memrealtime(); const unsigned long long ticks = (unsigned long long)(g.K * RESID_STAGGER) / 64ull;
                while (__builtin_amdgcn_s_memrealtime() - t0 < ticks) __builtin_amdgcn_s_sleep(32);
            }
            pg8::gemm_phase<pg8::EpiResid, pg8::PanelOrder, true, true>(lds, g, S, E, TID);
        } else if (kind == K_QKN) {
            if (L == 0) qknorm_phase(TID, RB, 1536, 16, 4, a->in[11], a->in[12], true, 0.125f * LOG2E, lds);
            else qknorm_phase(TID, RB, 3072, 16, 16, a->in[16], a->in[17], false, 0.125f * LOG2E, lds);
        } else if (kind == K_ATT) {
            if (L == 0) attn_phase<0>(TID, a, lds); else if (L == 1) attn_phase<1>(TID, a, lds); else attn_phase<2>(TID, a, lds);
        } else if (kind == K_POOL) {
            pool_phase(TID, RA, RO, lds);
        } else if (kind == K_MLAN1) {
            mlanorm1_phase(TID, (bf16_t*)(ws + WS_PROJ), a->in[24], a->in[25]);
        } else if (kind == K_MLAN2) {
            mlanorm2_phase(TID, (bf16_t*)(ws + WS_QR), (bf16_t*)(ws + WS_KV), (const bf16_t*)(ws + WS_PROJ), (bf16_t*)(ws + WS_KR), a->in[28], a->in[29], 0.10206207261596577f * LOG2E, lds);
        }
        if (q + 1 < ph_hi * (1 + PROBE_N)) { xcd_barrier(xbar); for (int e = 0; e < PROBE_SYNC; ++e) xcd_barrier(xbar); }
    }
}

#ifndef MK_PER_PHASE
#define MK_PER_PHASE 0
#endif
extern "C" void kernel_launch(void* const* d_in, const int* in_sizes, int n_in, void* d_out, int out_size, void* d_ws, size_t ws_size, hipStream_t stream) {
    static int grid = 0;
    if (grid == 0) {
        if (n_in != 31 || in_sizes[0] != LAT * DM || out_size != LAT * DM || ws_size < WS_END) { fprintf(stderr, "kernel_launch: unexpected shapes (n_in %d, in0 %d, out %d, ws %zu < %zu)\n", n_in, n_in > 0 ? in_sizes[0] : -1, out_size, ws_size, (size_t)WS_END); grid = -1; return; }
        int dev = 0, cus = 0, per_cu = 0;
        if (hipGetDevice(&dev) != hipSuccess || hipDeviceGetAttribute(&cus, hipDeviceAttributeMultiprocessorCount, dev) != hipSuccess) { fprintf(stderr, "kernel_launch: device query failed\n"); grid = -1; return; }
        if (hipFuncSetAttribute((const void*)fwd_kernel, hipFuncAttributeMaxDynamicSharedMemorySize, LDS_BYTES) != hipSuccess) { fprintf(stderr, "kernel_launch: hipFuncSetAttribute failed\n"); grid = -1; return; }
        if (hipOccupancyMaxActiveBlocksPerMultiprocessor(&per_cu, (const void*)fwd_kernel, NTHREADS, LDS_BYTES) != hipSuccess || per_cu < 1) { fprintf(stderr, "kernel_launch: occupancy query says %d blocks per CU\n", per_cu); per_cu = 1; }
        (void)hipGetLastError();
        grid = cus * (per_cu > 1 ? 1 : per_cu);
        if (grid % 32 != 0) { fprintf(stderr, "kernel_launch: grid %d is not a multiple of 32 (the fused norm epilogues deal row panels to 4 workgroups per XCD)\n", grid); grid = -1; return; }
    }
    if (grid < 0) return;
    Args a{};
    for (int i = 0; i < 31; ++i) a.in[i] = (const float*)d_in[i];
    a.out = (float*)d_out; a.ws = (unsigned char*)d_ws;
#if MK_PER_PHASE
    for (int p = 0; p < NPHASES; ++p) { a.ph_lo = p; a.ph_hi = p + 1; hipLaunchKernelGGL(fwd_kernel, dim3(grid), dim3(NTHREADS), LDS_BYTES, stream, a); }
#else
    a.ph_lo = 0; a.ph_hi = NPHASES;
    if (hipMemsetAsync((char*)d_ws + WS_CTL, 0, CTL_ZERO_BYTES, stream) != hipSuccess) { fprintf(stderr, "kernel_launch: memset of the barrier words failed\n"); return; }
    void* args[] = {&a};
    hipError_t e = hipLaunchCooperativeKernel((const void*)fwd_kernel, dim3(grid), dim3(NTHREADS), args, LDS_BYTES, stream);
    if (e != hipSuccess) fprintf(stderr, "kernel_launch: cooperative launch failed: %s (grid %d)\n", hipGetErrorString(e), grid);
#endif
}
```

```cpp
#include <hip/hip_runtime.h>
#include <hip/hip_cooperative_groups.h>
#include <cstdio>
#include <cstdint>
#include <cmath>
namespace cg = cooperative_groups;

namespace pg8 {
#define PG8_LAS __attribute__((address_space(3)))
typedef unsigned short bf16_t;
typedef short bf16x8 __attribute__((ext_vector_type(8)));
typedef float f32x4 __attribute__((ext_vector_type(4)));
typedef unsigned u32x4 __attribute__((ext_vector_type(4)));
typedef unsigned u32x2 __attribute__((ext_vector_type(2)));
constexpr int BM = 256, BK = 64, HALF = 128, HTB = HALF * BK * 2  , STAGE_BYTES = 8 * HTB, NXCD = 8, WGM = 4;

__host__ __device__ __forceinline__ int lds_byte(int r, int c) { const int st = (r >> 4) * 2 + (c >> 5), rr = r & 15, cc = c & 31, ob = rr * 64 + cc * 2; return st * 1024 + (ob ^ (((ob >> 9) & 1) << 5)); }
__host__ __device__ __forceinline__ void stage_rc(int b, int& R, int& C) { const int st = b / 1024, sb = b % 1024, swz = sb ^ (((sb >> 9) & 1) << 5); R = (st >> 1) * 16 + swz / 64; C = (st & 1) * 32 + (swz % 64) / 2; }
__host__ __device__ __forceinline__ int perm32(int rho) { const int n = rho >> 4, i = rho & 15; return 8 * (i >> 2) + 4 * n + (i & 3); }

struct Unit { int pm, pn; };
struct Gemm { const bf16_t* A; const bf16_t* Bt; int M, N, K, lda, ldb, akoff; };

struct StaticOrder {
    int nM, nN, nwg, G, c;
    __host__ __device__ void init(int M, int N, int G_, int c_) { nM = M / BM; nN = N / BM; nwg = nM * nN; G = G_; c = c_; }
    __host__ __device__ bool next(int i, Unit& u) const {
        const long L = (long)i * G + c; if (L >= nwg) return false;
        int wgid = (int)L; { const int q = nwg / NXCD, r = nwg % NXCD, xcd = wgid % NXCD, off = wgid / NXCD; wgid = (xcd < r ? xcd * (q + 1) : r * (q + 1) + (xcd - r) * q) + off; }
        const int nig = WGM * nN, gid = wgid / nig, fm = gid * WGM, gsz = (nM - fm) < WGM ? (nM - fm) : WGM;
        u.pm = fm + ((wgid % nig) % gsz); u.pn = (wgid % nig) / gsz; return true;
    }
    __device__ __forceinline__ void a_ready(const Unit&) const {}
    __device__ __forceinline__ void done(const Unit&) const {}
};

__device__ __forceinline__ unsigned cvt_pk_bf16(float lo, float hi) { unsigned r; asm volatile("v_cvt_pk_bf16_f32 %0, %1, %2" : "=v"(r) : "v"(lo), "v"(hi)); return r; }

struct EpiStore {
    static constexpr bool PERM = true, AFTER_DRAIN = false, WITH_LDS = true;
    bf16_t* O; int ldc, proj; const float* gcq; const float* gckv;
    __device__ __forceinline__ void run(f32x4 (&acc)[2][2][4][2], const Unit& u, int wr, int wc, int fr, int fq, PG8_LAS unsigned char* sl, int wid, int lane) const {
        const int row0 = u.pm * BM + wr * 64 + fr, col0 = u.pn * BM + wc * 32 + 8 * fq;
        if (proj) {
            const bool t0 = u.pn == 0;
            PG8_LAS float* P = (PG8_LAS float*)sl;
#pragma unroll
            for (int ai = 0; ai < 2; ++ai)
#pragma unroll
                for (int m = 0; m < 4; ++m) { float s = 0.f;
#pragma unroll
                    for (int bj = 0; bj < 2; ++bj) { if (bj == 0 || t0) { const f32x4 x0 = acc[ai][bj][m][0], x1 = acc[ai][bj][m][1];
                            s += ((x0[0] * x0[0] + x0[1] * x0[1]) + (x0[2] * x0[2] + x0[3] * x0[3])) + ((x1[0] * x1[0] + x1[1] * x1[1]) + (x1[2] * x1[2] + x1[3] * x1[3])); } }
                    s += __shfl_xor(s, 16); s += __shfl_xor(s, 32);
                    if (fq == 0) P[(ai * HALF + wr * 64 + m * 16 + fr) * 4 + wc] = s; }
            asm volatile("s_waitcnt lgkmcnt(0)" ::: "memory"); __builtin_amdgcn_s_barrier(); asm volatile("" ::: "memory");
            const float* g = t0 ? gcq : gckv; const int gc0 = wc * 32 + 8 * fq;
            const f32x4 g00 = *(const f32x4*)(g + gc0), g01 = *(const f32x4*)(g + gc0 + 4);
            f32x4 g10 = {1.f, 1.f, 1.f, 1.f}, g11 = g10; if (t0) { g10 = *(const f32x4*)(g + HALF + gc0); g11 = *(const f32x4*)(g + HALF + gc0 + 4); }
            const float invn = t0 ? 1.0f / 256.0f : 1.0f / 128.0f;
#pragma unroll
            for (int ai = 0; ai < 2; ++ai)
#pragma unroll
                for (int m = 0; m < 4; ++m) { const int rl = ai * HALF + wr * 64 + m * 16 + fr; const PG8_LAS float* pp = P + rl * 4;
                    const float rstd = 1.0f / sqrtf(((pp[0] + pp[1]) + (pp[2] + pp[3])) * invn + 1e-6f); const float r1 = t0 ? rstd : 1.0f;
                    acc[ai][0][m][0] = acc[ai][0][m][0] * rstd * g00; acc[ai][0][m][1] = acc[ai][0][m][1] * rstd * g01;
                    acc[ai][1][m][0] = acc[ai][1][m][0] * r1 * g10; acc[ai][1][m][1] = acc[ai][1][m][1] * r1 * g11; }
        }
#pragma unroll
        for (int ai = 0; ai < 2; ++ai)
#pragma unroll
            for (int m = 0; m < 4; ++m) { bf16_t* rowp = O + (size_t)(row0 + ai * HALF + m * 16) * ldc + col0;
#pragma unroll
                for (int bj = 0; bj < 2; ++bj) { const f32x4 v0 = acc[ai][bj][m][0], v1 = acc[ai][bj][m][1];
                    u32x4 w; w.x = cvt_pk_bf16(v0[0], v0[1]); w.y = cvt_pk_bf16(v0[2], v0[3]); w.z = cvt_pk_bf16(v1[0], v1[1]); w.w = cvt_pk_bf16(v1[2], v1[3]);
                    *(u32x4*)(rowp + bj * HALF) = w; } }
    }
};
__device__ __forceinline__ float silu_mul(float g, float u) { return g * u * __builtin_amdgcn_rcpf(1.0f + __builtin_amdgcn_exp2f(-1.4426950408889634f * g)); }
struct EpiSwiglu {
    static constexpr bool PERM = true, AFTER_DRAIN = false, WITH_LDS = false;
    bf16_t* O; int ldc;
    __device__ __forceinline__ void operator()(const f32x4 (&acc)[2][2][4][2], const Unit& u, int wr, int wc, int fr, int fq) const {
        const int row0 = u.pm * BM + wr * 64 + fr, col0 = u.pn * HALF + wc * 32 + 8 * fq;
#pragma unroll
        for (int ai = 0; ai < 2; ++ai)
#pragma unroll
            for (int m = 0; m < 4; ++m) { bf16_t* rowp = O + (size_t)(row0 + ai * HALF + m * 16) * ldc + col0;
                const f32x4 g0 = acc[ai][0][m][0], g1 = acc[ai][0][m][1], u0 = acc[ai][1][m][0], u1 = acc[ai][1][m][1];
                u32x4 w; w.x = cvt_pk_bf16(silu_mul(g0[0], u0[0]), silu_mul(g0[1], u0[1])); w.y = cvt_pk_bf16(silu_mul(g0[2], u0[2]), silu_mul(g0[3], u0[3]));
                w.z = cvt_pk_bf16(silu_mul(g1[0], u1[0]), silu_mul(g1[1], u1[1])); w.w = cvt_pk_bf16(silu_mul(g1[2], u1[2]), silu_mul(g1[3], u1[3]));
                *(u32x4*)rowp = w; }
    }
};
constexpr int EP_LAT = 32768, EP_SEQ = 2048, EP_D = 1024, EP_MODLD = 6144;
struct EpiArgs { const float* in[31]; float* out; unsigned char* ws; int ph_lo, ph_hi; };
struct EpiQKV {
    static constexpr bool PERM = true, AFTER_DRAIN = false, WITH_LDS = true;
    bf16_t* O; int ldc, nq, nk, rope, gq_in, gk_in; float qscale; unsigned rope_byte;
    __device__ __forceinline__ void run(f32x4 (&acc)[2][2][4][2], const Unit& u, int wr, int wc, int fr, int fq, PG8_LAS unsigned char* sl, int wid, int lane) const {
        const int row0 = u.pm * BM + wr * 64 + fr, col0 = u.pn * BM + wc * 32 + 8 * fq;
        if (u.pn < nq + nk) {
            const __attribute__((address_space(4))) EpiArgs* a = (const __attribute__((address_space(4))) EpiArgs*)__builtin_amdgcn_kernarg_segment_ptr(); asm volatile("" : "+s"(a));
            const bool isq = u.pn < nq;
            PG8_LAS float* P = (PG8_LAS float*)sl;
#pragma unroll
            for (int ai = 0; ai < 2; ++ai)
#pragma unroll
                for (int m = 0; m < 4; ++m)
#pragma unroll
                    for (int bj = 0; bj < 2; ++bj) { const f32x4 x0 = acc[ai][bj][m][0], x1 = acc[ai][bj][m][1];
                        float s = ((x0[0] * x0[0] + x0[1] * x0[1]) + (x0[2] * x0[2] + x0[3] * x0[3])) + ((x1[0] * x1[0] + x1[1] * x1[1]) + (x1[2] * x1[2] + x1[3] * x1[3]));
                        s += __shfl_xor(s, 16); s += __shfl_xor(s, 32);
                        if (fq == 0) P[((ai * HALF + wr * 64 + m * 16 + fr) * 2 + bj) * 4 + wc] = s; }
            asm volatile("s_waitcnt lgkmcnt(0)" ::: "memory"); __builtin_amdgcn_s_barrier(); asm volatile("" ::: "memory");
            const float* gp = (isq ? a->in[gq_in] : a->in[gk_in]) + (wc & 1) * 32 + 8 * fq;
            const f32x4 g0 = *(const f32x4*)gp, g1 = *(const f32x4*)(gp + 4);
            const float osc = isq ? qscale : 1.0f;
            const float* rt_ = (const float*)(a->ws + rope_byte) + 2 * (8 * (fq & 1));
            const bool x2 = fq >= 2;
#pragma unroll
            for (int ai = 0; ai < 2; ++ai)
#pragma unroll
            for (int mh = 0; mh < 2; ++mh) {
                f32x4 tq[2][4];
#pragma unroll
                for (int mm = 0; mm < 2; ++mm) { const int row = u.pm * BM + ai * HALF + wr * 64 + (2 * mh + mm) * 16 + fr; const int t = row & (EP_SEQ - 1), pos = (wc & 1) ? (t & 63) : (t >> 6);
                    const f32x4* tp = (const f32x4*)(rt_ + pos * 32); tq[mm][0] = tp[0]; tq[mm][1] = tp[1]; tq[mm][2] = tp[2]; tq[mm][3] = tp[3]; }
                __builtin_amdgcn_sched_barrier(0);
#pragma unroll
                for (int mm = 0; mm < 2; ++mm) { const int m = 2 * mh + mm; const int rl = ai * HALF + wr * 64 + m * 16 + fr, row = u.pm * BM + rl; bf16_t* rowp = O + (size_t)row * ldc + col0;
                    const bool dorope = rope && row < EP_LAT;
                    f32x4 c0 = {1.f, 1.f, 1.f, 1.f}, c1 = c0, s0 = {0.f, 0.f, 0.f, 0.f}, s1 = s0;
                    if (dorope) { const f32x4 t0 = tq[mm][0], t1 = tq[mm][1], t2 = tq[mm][2], t3 = tq[mm][3];
                        c0 = (f32x4){t0[0], t0[2], t1[0], t1[2]}; s0 = (f32x4){t0[1], t0[3], t1[1], t1[3]}; c1 = (f32x4){t2[0], t2[2], t3[0], t3[2]}; s1 = (f32x4){t2[1], t2[3], t3[1], t3[3]}; }
#pragma unroll
                    for (int bj = 0; bj < 2; ++bj) { const PG8_LAS float* pp = P + (rl * 2 + bj) * 4;
                        const float rstd = 1.0f / sqrtf((pp[wc] + pp[wc ^ 1]) * (1.0f / 64.0f) + 1e-6f);
                        f32x4 v0 = acc[ai][bj][m][0] * rstd * g0, v1 = acc[ai][bj][m][1] * rstd * g1;
                        if (rope) {
                            f32x4 p0, p1;
#pragma unroll
                            for (int j = 0; j < 4; ++j) {
                                const auto ra = __builtin_amdgcn_permlane32_swap(__float_as_uint(v0[j]), __float_as_uint(v0[j]), false, false), rb = __builtin_amdgcn_permlane32_swap(__float_as_uint(v1[j]), __float_as_uint(v1[j]), false, false);
                                p0[j] = __uint_as_float(x2 ? ra[0] : ra[1]); p1[j] = __uint_as_float(x2 ? rb[0] : rb[1]); }
                            if (x2) { v0 = p0 * s0 + v0 * c0; v1 = p1 * s1 + v1 * c1; } else { v0 = v0 * c0 - p0 * s0; v1 = v1 * c1 - p1 * s1; }
                        }
                        v0 = v0 * osc; v1 = v1 * osc;
                        u32x4 w; w.x = cvt_pk_bf16(v0[0], v0[1]); w.y = cvt_pk_bf16(v0[2], v0[3]); w.z = cvt_pk_bf16(v1[0], v1[1]); w.w = cvt_pk_bf16(v1[2], v1[3]);
                        *(u32x4*)(rowp + bj * HALF) = w; } }
            }
        } else {
#pragma unroll
            for (int ai = 0; ai < 2; ++ai)
#pragma unroll
                for (int m = 0; m < 4; ++m) { bf16_t* rowp = O + (size_t)(row0 + ai * HALF + m * 16) * ldc + col0;
#pragma unroll
                    for (int bj = 0; bj < 2; ++bj) { const f32x4 v0 = acc[ai][bj][m][0], v1 = acc[ai][bj][m][1];
                        u32x4 w; w.x = cvt_pk_bf16(v0[0], v0[1]); w.y = cvt_pk_bf16(v0[2], v0[3]); w.z = cvt_pk_bf16(v1[0], v1[1]); w.w = cvt_pk_bf16(v1[2], v1[3]);
                        *(u32x4*)(rowp + bj * HALF) = w; } }
        }
    }
};
struct EpiResid {
    static constexpr bool PERM = true, AFTER_DRAIN = false, WITH_LDS = true;
    int first;
    int gate_off;
    int pool;
    int donorm, g_in, g_off, nmod_off;
    unsigned mod_byte, hc_byte, cnt_byte; size_t a_byte, xbuf_byte;
    __device__ __forceinline__ void run(f32x4 (&acc)[2][2][4][2], const Unit& u, int wr, int wc, int fr, int fq, PG8_LAS unsigned char* sl, int wid, int lane) const {
        const __attribute__((address_space(4))) EpiArgs* a = (const __attribute__((address_space(4))) EpiArgs*)__builtin_amdgcn_kernarg_segment_ptr(); asm volatile("" : "+s"(a));
        unsigned char* ws = a->ws; float* HCp = (float*)(ws + hc_byte);
        const float* in_lat = first ? a->in[0] : a->out; const float* in_ctx = first ? a->in[2] : HCp; float* out_lat = a->out; float* out_ctx = HCp;
        const float* MODp = (const float*)(ws + mod_byte);
        const float* gate = MODp + gate_off; const float* bias = pool ? a->in[21] : nullptr; const float* cscale = pool ? a->in[22] : nullptr;
        const int rt = u.pm * BM; const bool isl = rt < EP_LAT; const int b = isl ? rt / EP_SEQ : 16;
        const float* ip = isl ? in_lat : in_ctx - (size_t)EP_LAT * EP_D; float* op = isl ? out_lat : out_ctx - (size_t)EP_LAT * EP_D;
        const int col0 = u.pn * BM + wc * 32 + 8 * fq; const float* gp = gate + (size_t)b * EP_MODLD + col0;
        if (pool) {
#pragma unroll
            for (int bj = 0; bj < 2; ++bj)
#pragma unroll
                for (int n = 0; n < 2; ++n) { const f32x4 bvv = *(const f32x4*)(bias + col0 + bj * HALF + n * 4), svv = *(const f32x4*)(cscale + col0 + bj * HALF + n * 4);
#pragma unroll
                    for (int ai = 0; ai < 2; ++ai)
#pragma unroll
                        for (int m = 0; m < 4; ++m) acc[ai][bj][m][n] = (acc[ai][bj][m][n] + bvv) * svv; }
        }
        {
        f32x4 gv[2][2];
#pragma unroll
        for (int bj = 0; bj < 2; ++bj)
#pragma unroll
            for (int n = 0; n < 2; ++n) gv[bj][n] = *(const f32x4*)(gp + bj * HALF + n * 4);
#pragma unroll
        for (int ai = 0; ai < 2; ++ai)
#pragma unroll
        for (int mh = 0; mh < 2; ++mh) {
            f32x4 bs[2][2][2];
#pragma unroll
            for (int mm = 0; mm < 2; ++mm) { const int m = 2 * mh + mm; const size_t off = (size_t)(rt + ai * HALF + wr * 64 + m * 16 + fr) * EP_D + col0;
#pragma unroll
                for (int bj = 0; bj < 2; ++bj)
#pragma unroll
                    for (int n = 0; n < 2; ++n) bs[mm][bj][n] = *(const f32x4*)(ip + off + bj * HALF + n * 4); }
            __builtin_amdgcn_sched_barrier(0);
#pragma unroll
            for (int mm = 0; mm < 2; ++mm) { const int m = 2 * mh + mm; const size_t off = (size_t)(rt + ai * HALF + wr * 64 + m * 16 + fr) * EP_D + col0;
#pragma unroll
                for (int bj = 0; bj < 2; ++bj)
#pragma unroll
                    for (int n = 0; n < 2; ++n) { const f32x4 h = bs[mm][bj][n] + gv[bj][n] * acc[ai][bj][m][n];
                        if (!donorm) *(f32x4*)(op + off + bj * HALF + n * 4) = h; acc[ai][bj][m][n] = h; } }
        }
        }
        if (!donorm) return;
        PG8_LAS float* P = (PG8_LAS float*)sl; PG8_LAS float* S = P + 1024;
        bf16_t* Ap = (bf16_t*)(ws + a_byte);
        const float* gnp = a->in[g_in] + g_off + col0; const float* shp = MODp + nmod_off + (size_t)b * EP_MODLD + col0; const float* scp = shp + 1024;
        f32x4 wv[2][2], hv[2][2];
#pragma unroll
        for (int bj = 0; bj < 2; ++bj)
#pragma unroll
            for (int n = 0; n < 2; ++n) { wv[bj][n] = *(const f32x4*)(gnp + bj * HALF + n * 4) * (*(const f32x4*)(scp + bj * HALF + n * 4) + 1.0f); hv[bj][n] = *(const f32x4*)(shp + bj * HALF + n * 4); }
#pragma unroll
        for (int ai = 0; ai < 2; ++ai)
#pragma unroll
            for (int m = 0; m < 4; ++m) { float s = 0.f;
#pragma unroll
                for (int bj = 0; bj < 2; ++bj)
#pragma unroll
                    for (int n = 0; n < 2; ++n) { const f32x4 x = acc[ai][bj][m][n]; s += (x[0] * x[0] + x[1] * x[1]) + (x[2] * x[2] + x[3] * x[3]); }
                s += __shfl_xor(s, 16); s += __shfl_xor(s, 32);
                if (fq == 0) P[(ai * HALF + wr * 64 + m * 16 + fr) * 4 + wc] = s; }
        asm volatile("s_waitcnt lgkmcnt(0)" ::: "memory"); __builtin_amdgcn_s_barrier(); asm volatile("" ::: "memory");
        const int tid = wid * 64 + lane;
        float* xb = (float*)(ws + xbuf_byte) + ((size_t)u.pm * BM) * 4;
        unsigned* cnt = (unsigned*)(ws + cnt_byte) + 16 * u.pm;
        if (tid < BM) { const float s = (P[tid * 4] + P[tid * 4 + 1]) + (P[tid * 4 + 2] + P[tid * 4 + 3]);
            __hip_atomic_store(xb + tid * 4 + u.pn, s, __ATOMIC_RELAXED, __HIP_MEMORY_SCOPE_AGENT); }
        asm volatile("s_waitcnt vmcnt(0)" ::: "memory");
        if (wid < 4 && lane == 0) __hip_atomic_fetch_add(cnt, 1u, __ATOMIC_RELAXED, __HIP_MEMORY_SCOPE_AGENT);
#pragma unroll
        for (int ai = 0; ai < 2; ++ai)
#pragma unroll
            for (int m = 0; m < 4; ++m) { const size_t off = (size_t)(rt + ai * HALF + wr * 64 + m * 16 + fr) * EP_D + col0;
#pragma unroll
                for (int bj = 0; bj < 2; ++bj)
#pragma unroll
                    for (int n = 0; n < 2; ++n) *(f32x4*)(op + off + bj * HALF + n * 4) = acc[ai][bj][m][n]; }
        if (wid == 0) { unsigned sp = 0u;
            while ((unsigned)__builtin_amdgcn_readfirstlane(__hip_atomic_load(cnt, __ATOMIC_RELAXED, __HIP_MEMORY_SCOPE_AGENT)) < 16u) { __builtin_amdgcn_s_sleep(2); if (++sp > (1u << 22)) break; }
            __builtin_amdgcn_fence(__ATOMIC_ACQUIRE, "agent"); }
        asm volatile("s_waitcnt lgkmcnt(0)" ::: "memory"); __builtin_amdgcn_s_barrier(); asm volatile("" ::: "memory");
        if (tid < BM) { float t = 0.f;
#pragma unroll
            for (int k = 0; k < 4; ++k) t += __hip_atomic_load(xb + tid * 4 + k, __ATOMIC_RELAXED, __HIP_MEMORY_SCOPE_AGENT);
            S[tid] = 1.0f / sqrtf(t * (1.0f / EP_D) + 1e-6f); }
        asm volatile("s_waitcnt lgkmcnt(0)" ::: "memory"); __builtin_amdgcn_s_barrier(); asm volatile("" ::: "memory");
#pragma unroll
        for (int ai = 0; ai < 2; ++ai)
#pragma unroll
            for (int m = 0; m < 4; ++m) { const int rl = ai * HALF + wr * 64 + m * 16 + fr; const float rs = S[rl]; bf16_t* arow = Ap + (size_t)(rt + rl) * EP_D + col0;
#pragma unroll
                for (int bj = 0; bj < 2; ++bj) { const f32x4 y0 = (acc[ai][bj][m][0] * rs) * wv[bj][0] + hv[bj][0], y1 = (acc[ai][bj][m][1] * rs) * wv[bj][1] + hv[bj][1];
                    u32x4 w; w.x = cvt_pk_bf16(y0[0], y0[1]); w.y = cvt_pk_bf16(y0[2], y0[3]); w.z = cvt_pk_bf16(y1[0], y1[1]); w.w = cvt_pk_bf16(y1[2], y1[3]); *(u32x4*)(arow + bj * HALF) = w; } }
    }
};
struct PanelOrder {
    int nM, G, x, y;
    __device__ void init(int M, int N, int G_, int c_) { nM = M / BM; G = G_; x = c_ & 7; y = c_ >> 3; (void)N; }
    __device__ bool next(int i, Unit& u) const {
        const int ppr = G / 4, base = i * ppr; if (base >= nM) return false;
        int rem = nM - base; rem = rem > ppr ? ppr : rem;
        const int per_x = (rem + 7) / 8, q = y >> 2; if (q >= per_x) return false;
        const int pm = base + x * per_x + q; if (pm >= nM) return false;
        u.pm = pm; u.pn = y & 3; return true;
    }
    __device__ __forceinline__ void a_ready(const Unit&) const {}
    __device__ __forceinline__ void done(const Unit&) const {}
};

template <class Epi, class Sched, bool ALIGN_EPI = false, bool SP2 = false>
__device__ __forceinline__ void gemm_phase(PG8_LAS unsigned char* lds, const Gemm g, const Sched& S, const Epi& E, const int tid_in) {
    int tid_ = tid_in; asm volatile("" : "+v"(tid_));
    const int tid = tid_, wid = __builtin_amdgcn_readfirstlane(tid >> 6), lane = tid & 63, wr = wid >> 2, wc = wid & 3, fr = lane & 15, fq = lane >> 4;
    const int K = g.K, nt = K / BK;
    unsigned voffA[2], voffB[2];
#pragma unroll
    for (int i = 0; i < 2; ++i) { int R, C; stage_rc(tid * 16 + i * 8192, R, C); const int Rb = Epi::PERM ? ((R & ~31) + perm32(R & 31)) : R;
        voffA[i] = (unsigned)(R * g.lda + C) * 2u; voffB[i] = (unsigned)(Rb * g.ldb + C) * 2u; }
    const size_t kstep = (size_t)(BK * 2);
    const size_t hstepA = (size_t)HALF * g.lda * 2, hstepB = (size_t)HALF * g.ldb * 2;
    const size_t tstepA = 2 * hstepA, tstepB = 2 * hstepB; const size_t akoff = (size_t)g.akoff * 2;
    const unsigned ldsw = (unsigned)wid * 1024u;
    const int aoff = lds_byte(wr * 64 + fr, fq * 8), boff = lds_byte(wc * 32 + fr, fq * 8);
#define PG8_SA(b, h) (((b) * 2 + (h)) * HTB)
#define PG8_SB(b, h) ((4 + (b) * 2 + (h)) * HTB)
#define PG8_STAGE(bufoff, gbase, voff) do { _Pragma("unroll") for (int _i = 0; _i < 2; ++_i) \
        __builtin_amdgcn_global_load_lds((const unsigned*)((const char*)(gbase) + (voff)[_i]), (PG8_LAS unsigned*)(lds + (bufoff) + ldsw + _i * 8192), 16, 0, 0); } while (0)
#define PG8_LDA(dst, b, h) do { _Pragma("unroll") for (int m = 0; m < 4; ++m) _Pragma("unroll") for (int k = 0; k < 2; ++k) dst[m][k] = *(const PG8_LAS bf16x8*)(lds + PG8_SA(b, h) + aoff + m * 2048 + k * 1024); } while (0)
#define PG8_LDB(dst, b, h) do { _Pragma("unroll") for (int n = 0; n < 2; ++n) _Pragma("unroll") for (int k = 0; k < 2; ++k) dst[n][k] = *(const PG8_LAS bf16x8*)(lds + PG8_SB(b, h) + boff + n * 2048 + k * 1024); } while (0)
#define PG8_MMA(ai, bj, At, Bt) do { __builtin_amdgcn_s_setprio(1); _Pragma("unroll") for (int m = 0; m < 4; ++m) _Pragma("unroll") for (int n = 0; n < 2; ++n) _Pragma("unroll") for (int k = 0; k < 2; ++k) \
        acc[ai][bj][m][n] = __builtin_amdgcn_mfma_f32_16x16x32_bf16(Bt[n][k], At[m][k], acc[ai][bj][m][n], 0, 0, 0); __builtin_amdgcn_s_setprio(0); } while (0)
#define PG8_WAIT_V(n) asm volatile("s_waitcnt vmcnt(" #n ")" ::: "memory")
#define PG8_WAIT_L(n) asm volatile("s_waitcnt lgkmcnt(" #n ")" ::: "memory")
#define PG8_BAR __builtin_amdgcn_s_barrier()
#define PG8_SCHED __builtin_amdgcn_sched_barrier(0)
    Unit cur, nxt; int ui = 0;
    if (!S.next(0, cur)) return;
    f32x4 acc[2][2][4][2];
#pragma unroll
    for (int a = 0; a < 2; ++a)
#pragma unroll
        for (int b = 0; b < 2; ++b)
#pragma unroll
            for (int m = 0; m < 4; ++m)
#pragma unroll
                for (int n = 0; n < 2; ++n) acc[a][b][m][n] = (f32x4){0.f, 0.f, 0.f, 0.f};
    bf16x8 At[4][2], B0[2][2], B1[2][2];
    const char* cA = (const char*)g.A + (size_t)cur.pm * tstepA + (size_t)cur.pn * akoff; const char* cB = (const char*)g.Bt + (size_t)cur.pn * tstepB;
    S.a_ready(cur);
    if constexpr (SP2) {
        PG8_STAGE(PG8_SB(0, 0), cB, voffB); PG8_STAGE(PG8_SB(0, 1), cB + hstepB, voffB); PG8_STAGE(PG8_SA(0, 0), cA, voffA); PG8_STAGE(PG8_SA(0, 1), cA + hstepA, voffA);
        if (wr == 1) PG8_BAR;
        PG8_WAIT_V(2); PG8_BAR;
        PG8_STAGE(PG8_SB(1, 0), cB + kstep, voffB); PG8_STAGE(PG8_SA(1, 0), cA + kstep, voffA); PG8_STAGE(PG8_SB(1, 1), cB + hstepB + kstep, voffB);
        PG8_WAIT_V(6); PG8_BAR;
    } else {
        PG8_STAGE(PG8_SB(0, 0), cB, voffB); PG8_STAGE(PG8_SA(0, 0), cA, voffA); PG8_STAGE(PG8_SB(0, 1), cB + hstepB, voffB); PG8_STAGE(PG8_SA(0, 1), cA + hstepA, voffA);
        if (wr == 1) PG8_BAR;
        PG8_WAIT_V(4); PG8_BAR;
        PG8_STAGE(PG8_SB(1, 0), cB + kstep, voffB); PG8_STAGE(PG8_SA(1, 0), cA + kstep, voffA); PG8_STAGE(PG8_SB(1, 1), cB + hstepB + kstep, voffB);
        PG8_WAIT_V(6); PG8_BAR;
    }
    for (;;) {
        const bool has_next = S.next(ui + 1, nxt);
        const char* nA = has_next ? (const char*)g.A + (size_t)nxt.pm * tstepA + (size_t)nxt.pn * akoff : cA; const char* nB = has_next ? (const char*)g.Bt + (size_t)nxt.pn * tstepB : cB;
        for (int t = 0; t < nt; t += 2) {
            const bool last = (t == nt - 2);
            const char* a1 = cA + (size_t)(t + 1) * kstep;
            const char* a2 = last ? nA : cA + (size_t)(t + 2) * kstep; const char* b2 = last ? nB : cB + (size_t)(t + 2) * kstep;
            const char* a3 = a2 + kstep; const char* b3 = b2 + kstep;
            if (last && has_next) S.a_ready(nxt);
            if constexpr (SP2) {
            PG8_LDB(B0, 0, 0); PG8_LDB(B1, 0, 1); PG8_SCHED; PG8_LDA(At, 0, 0); PG8_STAGE(PG8_SA(1, 1), a1 + hstepA, voffA);
            PG8_WAIT_V(8); PG8_WAIT_L(0); PG8_BAR; PG8_MMA(0, 0, At, B0); PG8_MMA(0, 1, At, B1); PG8_BAR; PG8_SCHED;
            PG8_LDA(At, 0, 1); PG8_STAGE(PG8_SB(0, 0), b2, voffB); PG8_STAGE(PG8_SB(0, 1), b2 + hstepB, voffB); PG8_STAGE(PG8_SA(0, 0), a2, voffA);
            PG8_WAIT_V(8); PG8_WAIT_L(0); PG8_BAR; PG8_MMA(1, 0, At, B0); PG8_MMA(1, 1, At, B1); PG8_BAR; PG8_SCHED;
            PG8_LDB(B0, 1, 0); PG8_LDB(B1, 1, 1); PG8_SCHED; PG8_LDA(At, 1, 0); PG8_STAGE(PG8_SA(0, 1), a2 + hstepA, voffA);
            PG8_WAIT_V(8); PG8_WAIT_L(0); PG8_BAR; PG8_MMA(0, 0, At, B0); PG8_MMA(0, 1, At, B1); PG8_BAR; PG8_SCHED;
            PG8_LDA(At, 1, 1); PG8_STAGE(PG8_SB(1, 0), b3, voffB); PG8_STAGE(PG8_SB(1, 1), b3 + hstepB, voffB); PG8_STAGE(PG8_SA(1, 0), a3, voffA);
            PG8_WAIT_V(8); PG8_WAIT_L(0); PG8_BAR; PG8_MMA(1, 0, At, B0); PG8_MMA(1, 1, At, B1); PG8_BAR; PG8_SCHED;
            } else {
            PG8_LDB(B0, 0, 0); PG8_SCHED; PG8_LDA(At, 0, 0); PG8_STAGE(PG8_SA(1, 1), a1 + hstepA, voffA);
            PG8_WAIT_L(8); PG8_BAR; PG8_WAIT_L(0); PG8_MMA(0, 0, At, B0); PG8_BAR; PG8_SCHED;
            PG8_LDB(B1, 0, 1); PG8_STAGE(PG8_SB(0, 0), b2, voffB);
            PG8_BAR; PG8_WAIT_L(0); PG8_MMA(0, 1, At, B1); PG8_BAR;
            PG8_LDA(At, 0, 1); PG8_STAGE(PG8_SA(0, 0), a2, voffA);
            PG8_BAR; PG8_WAIT_L(0); PG8_MMA(1, 0, At, B0); PG8_BAR; PG8_SCHED;
            PG8_STAGE(PG8_SB(0, 1), b2 + hstepB, voffB);
            PG8_WAIT_V(6); PG8_BAR; PG8_MMA(1, 1, At, B1); PG8_BAR;
            PG8_LDB(B0, 1, 0); PG8_SCHED; PG8_LDA(At, 1, 0); PG8_STAGE(PG8_SA(0, 1), a2 + hstepA, voffA);
            PG8_WAIT_L(8); PG8_BAR; PG8_WAIT_L(0); PG8_MMA(0, 0, At, B0); PG8_BAR; PG8_SCHED;
            PG8_LDB(B1, 1, 1); PG8_STAGE(PG8_SB(1, 0), b3, voffB);
            PG8_BAR; PG8_WAIT_L(0); PG8_MMA(0, 1, At, B1); PG8_BAR;
            PG8_LDA(At, 1, 1); PG8_STAGE(PG8_SA(1, 0), a3, voffA);
            PG8_BAR; PG8_WAIT_L(0); PG8_MMA(1, 0, At, B0); PG8_BAR; PG8_SCHED;
            PG8_STAGE(PG8_SB(1, 1), b3 + hstepB, voffB);
            PG8_WAIT_V(6); PG8_BAR; PG8_MMA(1, 1, At, B1); PG8_BAR;
            }
        }
        if constexpr (ALIGN_EPI) { if (wr == 0) PG8_BAR; }
        if constexpr (!Epi::AFTER_DRAIN) { if constexpr (Epi::WITH_LDS) E.run(acc, cur, wr, wc, fr, fq, lds + 131072 + 64, wid, lane); else E(acc, cur, wr, wc, fr, fq); S.done(cur); }
        if (!has_next) break;
#pragma unroll
        for (int a = 0; a < 2; ++a)
#pragma unroll
            for (int b = 0; b < 2; ++b)
#pragma unroll
                for (int m = 0; m < 4; ++m)
#pragma unroll
                    for (int n = 0; n < 2; ++n) acc[a][b][m][n] = (f32x4){0.f, 0.f, 0.f, 0.f};
        cur = nxt; cA = nA; cB = nB; ++ui;
        if constexpr (ALIGN_EPI) { if (wr == 1) PG8_BAR; }
    }
    PG8_WAIT_V(0);
    if constexpr (!ALIGN_EPI) { if (wr == 0) PG8_BAR; }
    PG8_BAR;
    if constexpr (Epi::AFTER_DRAIN) { E.fused(acc, cur, wr, wc, fr, fq, lds, wid, lane); S.done(cur); }
#undef PG8_SA
#undef PG8_SB
#undef PG8_STAGE
#undef PG8_LDA
#undef PG8_LDB
#undef PG8_MMA
#undef PG8_WAIT_V
#undef PG8_WAIT_L
#undef PG8_BAR
#undef PG8_SCHED
}
}

using pg8::bf16_t; using pg8::bf16x8; using pg8::f32x4; using pg8::u32x4;
typedef float f32x16 __attribute__((ext_vector_type(16)));
typedef unsigned u32x2 __attribute__((ext_vector_type(2)));
#define LAS __attribute__((address_space(3)))
constexpr int DM = 1024, NBATCH = 16, SEQ = 2048, LAT = NBATCH * SEQ, CTXL = 256, NCTX = NBATCH * CTXL, MTOT = LAT + NCTX, DFF = 2816, MODLD = 6 * DM, NMODB = 17;
constexpr float EPS = 1e-6f, LOG2E = 1.4426950408889634f;
constexpr int NTHREADS = 512, NWAVES = 8;
constexpr int LDS_BYTES = 143360;

constexpr size_t MiB = 1u << 20;
constexpr size_t WS_MOD = 0;
constexpr size_t WS_CTL = 1835008;
constexpr size_t WS_CNT = WS_CTL + 16384;
constexpr size_t CTL_ZERO_BYTES = 16384 + 7 * 144 * 64;
static_assert(WS_CNT + 7 * 144 * 64 <= 2 * MiB, "control words");
constexpr size_t WS_ROPE = 1916928;
static_assert(WS_ROPE >= WS_CNT + 7 * 144 * 64 && WS_ROPE + 8192 <= 2 * MiB, "rope table");
constexpr size_t WS_W = 2 * MiB;
constexpr size_t SZ_WGU = (size_t)2 * DFF * DM * 2, SZ_WDN = (size_t)DM * DFF * 2;
constexpr size_t WS_WGU = WS_W, WS_WDN = WS_WGU + 4 * SZ_WGU;
constexpr size_t WS_SWA_QKV = WS_WDN + 4 * SZ_WDN, WS_SWA_WO = WS_SWA_QKV + (size_t)1536 * DM * 2;
constexpr size_t WS_NA_QKV = WS_SWA_WO + (size_t)DM * DM * 2, WS_NA_WO = WS_NA_QKV + (size_t)3072 * DM * 2;
constexpr size_t WS_POOL = WS_NA_WO + (size_t)DM * DM * 2;
constexpr size_t WS_MLA_WA = WS_POOL + (size_t)DM * 256 * 2, WS_MLA_WUQ = WS_MLA_WA + (size_t)512 * DM * 2, WS_MLA_WUKV = WS_MLA_WUQ + (size_t)1536 * 256 * 2;
constexpr size_t WS_MLA_WO = WS_MLA_WUKV + (size_t)2048 * 128 * 2, WS_W_END = WS_MLA_WO + (size_t)DM * DM * 2;
constexpr size_t WS_HC = 86 * MiB;
constexpr size_t WS_RA = 102 * MiB;
constexpr size_t WS_RO = WS_RA + 72 * MiB;
constexpr size_t WS_RB = WS_RO + 72 * MiB;
constexpr size_t WS_XBUF = 507 * MiB;
constexpr size_t WS_END = WS_XBUF + (size_t)7 * MTOT * 16;
static_assert(WS_END <= 512 * MiB, "workspace");
static_assert(WS_W_END <= WS_HC, "weights fit");
static_assert(WS_RB + (size_t)MTOT * 3072 * 2 <= WS_XBUF && WS_RB + (size_t)MTOT * DFF * 2 <= WS_XBUF, "big region");
constexpr size_t WS_PROJ = WS_RO, WS_QR = WS_PROJ + (size_t)MTOT * 512 * 2, WS_KV = WS_QR + (size_t)LAT * 1536 * 2, WS_KR = WS_KV + (size_t)MTOT * 2048 * 2;
static_assert(WS_KR + (size_t)MTOT * 512 * 2 <= WS_XBUF, "mla region");

__device__ __forceinline__ unsigned f2bf(float f) { unsigned u = __builtin_bit_cast(unsigned, f); return (u + 0x7fffu + ((u >> 16) & 1u)) >> 16; }
__device__ __forceinline__ unsigned pk2(float lo, float hi) { return f2bf(lo) | (f2bf(hi) << 16); }
__device__ __forceinline__ float bflo(unsigned w) { return __builtin_bit_cast(float, w << 16); }
__device__ __forceinline__ float bfhi(unsigned w) { return __builtin_bit_cast(float, w & 0xffff0000u); }
__device__ __forceinline__ float wave_sum(float v) {
#pragma unroll
    for (int o = 1; o < 64; o <<= 1) v += __shfl_xor(v, o);
    return v;
}

struct Args { const float* in[31]; float* out; unsigned char* ws; int ph_lo, ph_hi; };
typedef const __attribute__((address_space(4))) Args* KArgs;

__device__ __forceinline__ void transpose_item(const float* W, int K, int N, bf16_t* WT, int drow0, int k0, int n0, LAS float* scr, int lane) {
    float tv[32];
#pragma unroll
    for (int i = 0; i < 32; ++i) tv[i] = W[(size_t)(k0 + 2 * i + (lane >> 5)) * N + n0 + (lane & 31)];
#pragma unroll
    for (int i = 0; i < 32; ++i) scr[(2 * i + (lane >> 5)) * 33 + (lane & 31)] = tv[i];
    asm volatile("s_waitcnt lgkmcnt(0)" ::: "memory");
    const int c = lane & 7;
#pragma unroll
    for (int j = 0; j < 4; ++j) { const int n = (lane >> 3) + 8 * j; const LAS float* s = scr + (8 * c) * 33 + n;
        u32x4 o; o.x = pk2(s[0 * 33], s[1 * 33]); o.y = pk2(s[2 * 33], s[3 * 33]); o.z = pk2(s[4 * 33], s[5 * 33]); o.w = pk2(s[6 * 33], s[7 * 33]);
        *(u32x4*)(WT + (size_t)(drow0 + n) * K + k0 + 8 * c) = o; }
    asm volatile("s_waitcnt lgkmcnt(0)" ::: "memory");
}
__device__ __forceinline__ void transpose_job(const float* W, int K, int N, bf16_t* WT, int map, int item, LAS float* scr, int lane) {
    const int nblk = N / 32, kb = item / nblk, nb = item % nblk, k0 = 64 * kb, n0 = 32 * nb;
    int drow0 = n0;
    if (map == 1) { const bool up = n0 >= DFF; const int j = up ? n0 - DFF : n0; drow0 = (j >> 7) * 256 + (up ? 128 : 0) + (j & 127); }
    transpose_item(W, K, N, WT, drow0, k0, n0, scr, lane);
}
__device__ __forceinline__ void prologue_phase(const int TID, KArgs a, LAS unsigned char* lds, const int parts = 3) {
    const int tid = TID, lane = tid & 63, wave = tid >> 6;
    unsigned char* ws = a->ws;
    LAS float* scr = (LAS float*)(lds + wave * 16384);
    const int gw = blockIdx.x * NWAVES + wave, NGW = gridDim.x * NWAVES;
    constexpr int I_GU = (DM / 64) * (2 * DFF / 32), I_DN = (DFF / 64) * (DM / 32), I_SQ = (DM / 64) * (1536 / 32), I_SQ2 = (DM / 64) * (DM / 32), I_NQ = (DM / 64) * (3072 / 32);
    constexpr int I_PL = (256 / 64) * (256 / 32), I_WA = (DM / 64) * (416 / 32), I_UQ = (256 / 64) * (1536 / 32), I_UKV = (128 / 64) * (2048 / 32);
    constexpr int NITEMS = 4 * I_GU + 4 * I_DN + I_SQ + I_SQ2 + I_NQ + I_SQ2 + 4 * I_PL + I_WA + I_UQ + I_UKV + I_SQ2;
    if (parts & 1)
    for (int it = gw; it < NITEMS; it += NGW) {
        int r = it;
        if (r < 4 * I_GU) { const int l = r / I_GU; transpose_job(a->in[8] + (size_t)l * DM * 2 * DFF, DM, 2 * DFF, (bf16_t*)(ws + WS_WGU + l * SZ_WGU), 1, r % I_GU, scr, lane); continue; } r -= 4 * I_GU;
        if (r < 4 * I_DN) { const int l = r / I_DN; transpose_job(a->in[9] + (size_t)l * DFF * DM, DFF, DM, (bf16_t*)(ws + WS_WDN + l * SZ_WDN), 0, r % I_DN, scr, lane); continue; } r -= 4 * I_DN;
        if (r < I_SQ) { transpose_job(a->in[10], DM, 1536, (bf16_t*)(ws + WS_SWA_QKV), 0, r, scr, lane); continue; } r -= I_SQ;
        if (r < I_SQ2) { transpose_job(a->in[14], DM, DM, (bf16_t*)(ws + WS_SWA_WO), 0, r, scr, lane); continue; } r -= I_SQ2;
        if (r < I_NQ) { transpose_job(a->in[15], DM, 3072, (bf16_t*)(ws + WS_NA_QKV), 0, r, scr, lane); continue; } r -= I_NQ;
        if (r < I_SQ2) { transpose_job(a->in[19], DM, DM, (bf16_t*)(ws + WS_NA_WO), 0, r, scr, lane); continue; } r -= I_SQ2;
        if (r < 4 * I_PL) { const int g = r / I_PL; transpose_job(a->in[20] + (size_t)g * 65536, 256, 256, (bf16_t*)(ws + WS_POOL) + (size_t)g * 65536, 0, r % I_PL, scr, lane); continue; } r -= 4 * I_PL;
        if (r < I_WA) { transpose_job(a->in[23], DM, 416, (bf16_t*)(ws + WS_MLA_WA), 0, r, scr, lane); continue; } r -= I_WA;
        if (r < I_UQ) { transpose_job(a->in[26], 256, 1536, (bf16_t*)(ws + WS_MLA_WUQ), 0, r, scr, lane); continue; } r -= I_UQ;
        if (r < I_UKV) { transpose_job(a->in[27], 128, 2048, (bf16_t*)(ws + WS_MLA_WUKV), 0, r, scr, lane); continue; } r -= I_UKV;
        transpose_job(a->in[30], DM, DM, (bf16_t*)(ws + WS_MLA_WO), 0, r, scr, lane);
    }
    if (blockIdx.x == 0) { float* rt = (float*)(ws + WS_ROPE); for (int i = tid; i < 64 * 16; i += NTHREADS) { const int pos = i >> 4, f = i & 15; const float fr = powf(10000.0f, -(float)f / 16.0f); float sn, cs; sincosf((float)pos * fr, &sn, &cs); rt[2 * i] = cs; rt[2 * i + 1] = sn; } }
    { u32x4* z = (u32x4*)(ws + WS_MLA_WA + (size_t)416 * DM * 2); const int nz = 96 * DM * 2 / 16;
      for (int i = blockIdx.x * NTHREADS + tid; i < nz; i += gridDim.x * NTHREADS) z[i] = (u32x4){0u, 0u, 0u, 0u}; }
    __syncthreads();
    if ((int)blockIdx.x < 192 && (parts & 2)) {
        LAS float* cond = (LAS float*)lds;
        typedef float f32x2 __attribute__((ext_vector_type(2)));
        LAS f32x2* red = (LAS f32x2*)(lds + 81920);
        { float cv[34];
#pragma unroll
          for (int r = 0; r < 34; ++r) { const int i = tid + r * NTHREADS, b = i >> 10, k = i & 1023; cv[r] = b < 16 ? a->in[1][b * DM + k] : a->in[3][k]; }
#pragma unroll
          for (int r = 0; r < 34; ++r) { const int i = tid + r * NTHREADS, b = i >> 10, k = i & 1023; cond[k * 20 + b] = cv[r] / (1.0f + __expf(-cv[r])); } }
        __syncthreads();
        const int c2 = tid & 63, kg = tid >> 6;
        for (int u = blockIdx.x; u < 192; u += gridDim.x) {
            const int l = u / 48, cb = u % 48;
            const float* w = a->in[4] + (size_t)l * DM * MODLD + cb * 128 + 2 * c2;
            f32x2 acc[NMODB];
#pragma unroll
            for (int b = 0; b < NMODB; ++b) acc[b] = (f32x2){0.f, 0.f};
#pragma unroll 16
            for (int k = kg * 128; k < kg * 128 + 128; ++k) { const f32x2 wv = *(const f32x2*)(w + (size_t)k * MODLD); const LAS float* cp = cond + k * 20;
#pragma unroll
                for (int b = 0; b < NMODB; ++b) acc[b] += wv * cp[b]; }
#pragma unroll
            for (int st = 4; st >= 1; st >>= 1) {
                if (kg >= st && kg < 2 * st) {
#pragma unroll
                    for (int b = 0; b < NMODB; ++b) red[((kg - st) * NMODB + b) * 64 + c2] = acc[b]; }
                __syncthreads();
                if (kg < st) {
#pragma unroll
                    for (int b = 0; b < NMODB; ++b) acc[b] += red[(kg * NMODB + b) * 64 + c2]; }
                __syncthreads();
            }
            if (kg == 0) { const f32x2 bias = *(const f32x2*)(a->in[5] + l * MODLD + cb * 128 + 2 * c2);
#pragma unroll
                for (int b = 0; b < NMODB; ++b) *(f32x2*)((float*)(ws + WS_MOD) + ((size_t)l * NMODB + b) * MODLD + cb * 128 + 2 * c2) = acc[b] + bias; }
        }
    }
}

__device__ __forceinline__ void norm_phase(const int TID, const float* in_lat, const float* in_ctx, int M, const float* g, const float* sh, const float* sc, bf16_t* A) {
    const int lane = TID & 63, wave = TID >> 6;
    const int gw = blockIdx.x * NWAVES + wave, NGW = gridDim.x * NWAVES;
    f32x4 gv[4];
#pragma unroll
    for (int j = 0; j < 4; ++j) gv[j] = *(const f32x4*)(g + 4 * lane + 256 * j);
    for (int row0 = gw; row0 < M; row0 += 2 * NGW) {
        f32x4 v[2][4]; float s[2];
#pragma unroll
        for (int r = 0; r < 2; ++r) { const int row = row0 + r * NGW; const int rc = row < M ? row : row0;
            const float* xr = rc < LAT ? in_lat + (size_t)rc * DM : in_ctx + (size_t)(rc - LAT) * DM;
#pragma unroll
            for (int j = 0; j < 4; ++j) v[r][j] = *(const f32x4*)(xr + 4 * lane + 256 * j); }
#pragma unroll
        for (int r = 0; r < 2; ++r) { float t = 0.f;
#pragma unroll
            for (int j = 0; j < 4; ++j) t += (v[r][j].x * v[r][j].x + v[r][j].y * v[r][j].y) + (v[r][j].z * v[r][j].z + v[r][j].w * v[r][j].w);
            s[r] = t; }
#pragma unroll
        for (int o = 1; o < 64; o <<= 1) { s[0] += __shfl_xor(s[0], o); s[1] += __shfl_xor(s[1], o); }
#pragma unroll
        for (int r = 0; r < 2; ++r) { const int row = row0 + r * NGW; if (row >= M) continue;
            const int b = row < LAT ? row / SEQ : 16;
            const float rstd = 1.0f / sqrtf(s[r] * (1.0f / DM) + EPS);
            const float* shp = sh + (size_t)b * MODLD + 4 * lane; const float* scp = sc + (size_t)b * MODLD + 4 * lane;
            bf16_t* op = A + (size_t)row * DM + 4 * lane;
#pragma unroll
            for (int j = 0; j < 4; ++j) { const f32x4 s4 = *(const f32x4*)(scp + 256 * j), h4 = *(const f32x4*)(shp + 256 * j);
                const f32x4 y = (v[r][j] * rstd * gv[j]) * (s4 + 1.0f) + h4;
                u32x2 w; w.x = pk2(y.x, y.y); w.y = pk2(y.z, y.w); *(u32x2*)(op + 256 * j) = w; } }
    }
}

template <int HALFD> __device__ __forceinline__ void rope_table(const int TID, LAS float* tab) {
    for (int i = TID; i < 64 * HALFD; i += NTHREADS) { const int pos = i / HALFD, f = i % HALFD;
        const float fr = powf(10000.0f, -(float)f / (float)HALFD); float sn, cs; sincosf((float)pos * fr, &sn, &cs); tab[2 * i] = cs; tab[2 * i + 1] = sn; }
    __syncthreads();
}

__device__ __forceinline__ void qknorm_phase(const int TID, bf16_t* QKV, int ld, int nq, int nk, const float* gq, const float* gk, bool rope, float qscale, LAS unsigned char* lds) {
    LAS float* tab = (LAS float*)lds;
    if (rope) rope_table<16>(TID, tab);
    const int lane = TID & 63, wave = TID >> 6, l16 = lane & 15;
    const int gw = blockIdx.x * NWAVES + wave, NGW = gridDim.x * NWAVES;
    const f32x4 gq4 = *(const f32x4*)(gq + 4 * l16), gk4 = *(const f32x4*)(gk + 4 * l16);
    const int npass = (nq + nk) / 4;
    for (int row = gw; row < MTOT; row += NGW) {
        const bool dorope = rope && row < LAT; const int t = row & (SEQ - 1);
        const int pos = (l16 & 8) ? (t & 63) : (t >> 6); const int fi = 4 * (l16 & 3); const bool x2 = (l16 & 4) != 0;
        f32x4 cs = {1.f, 1.f, 1.f, 1.f}, sn = {0.f, 0.f, 0.f, 0.f};
        if (dorope) {
#pragma unroll
            for (int j = 0; j < 4; ++j) { cs[j] = tab[2 * (pos * 16 + fi + j)]; sn[j] = tab[2 * (pos * 16 + fi + j) + 1]; } }
        for (int p = 0; p < npass; ++p) {
            const int hh = 4 * p + (lane >> 4); const bool isq = hh < nq;
            bf16_t* ptr = QKV + (size_t)row * ld + hh * 64 + 4 * l16;
            const u32x2 w = *(const u32x2*)ptr;
            f32x4 x = {bflo(w.x), bfhi(w.x), bflo(w.y), bfhi(w.y)};
            float s = (x.x * x.x + x.y * x.y) + (x.z * x.z + x.w * x.w);
            s += __shfl_xor(s, 1); s += __shfl_xor(s, 2); s += __shfl_xor(s, 4); s += __shfl_xor(s, 8);
            const float rstd = 1.0f / sqrtf(s * (1.0f / 64.0f) + EPS);
            x = x * rstd * (isq ? gq4 : gk4);
            f32x4 o;
#pragma unroll
            for (int j = 0; j < 4; ++j) { const float other = __shfl_xor(x[j], 4); o[j] = x2 ? (other * sn[j] + x[j] * cs[j]) : (x[j] * cs[j] - other * sn[j]); }
            if (isq) o = o * qscale;
            u32x2 wo; wo.x = pk2(o.x, o.y); wo.y = pk2(o.z, o.w); *(u32x2*)ptr = wo;
        }
    }
}

__device__ __forceinline__ void mlanorm1_phase(const int TID, bf16_t* PROJ, const float* gcq, const float* gckv) {
    const int lane = TID & 63, wave = TID >> 6;
    const int gw = blockIdx.x * NWAVES + wave, NGW = gridDim.x * NWAVES;
    const f32x4 g1 = *(const f32x4*)(gcq + 4 * lane);
    const float g2a = gckv[2 * lane], g2b = gckv[2 * lane + 1];
    for (int row0 = gw; row0 < MTOT; row0 += 4 * NGW) {
        u32x2 w[4]; unsigned w2[4];
#pragma unroll
        for (int r = 0; r < 4; ++r) { const int row = row0 + r * NGW < MTOT ? row0 + r * NGW : row0; const bf16_t* p = PROJ + (size_t)row * 512; w[r] = *(const u32x2*)(p + 4 * lane); w2[r] = *(const unsigned*)(p + 256 + 2 * lane); }
#pragma unroll
        for (int r = 0; r < 4; ++r) { const int row = row0 + r * NGW; if (row >= MTOT) continue;
            bf16_t* p = PROJ + (size_t)row * 512;
            f32x4 x = {bflo(w[r].x), bfhi(w[r].x), bflo(w[r].y), bfhi(w[r].y)}; float ya = bflo(w2[r]), yb = bfhi(w2[r]);
            const float s1 = wave_sum((x.x * x.x + x.y * x.y) + (x.z * x.z + x.w * x.w)), s2 = wave_sum(ya * ya + yb * yb);
            const float r1 = 1.0f / sqrtf(s1 * (1.0f / 256.0f) + EPS), r2 = 1.0f / sqrtf(s2 * (1.0f / 128.0f) + EPS);
            x = x * r1 * g1; ya *= r2 * g2a; yb *= r2 * g2b;
            u32x2 wo; wo.x = pk2(x.x, x.y); wo.y = pk2(x.z, x.w); *(u32x2*)(p + 4 * lane) = wo; *(unsigned*)(p + 256 + 2 * lane) = pk2(ya, yb); }
    }
}
__device__ __forceinline__ void mlanorm2_phase(const int TID, bf16_t* QR, bf16_t* KV, const bf16_t* PROJ, bf16_t* KR, const float* gq, const float* gk, float qscale, LAS unsigned char* lds) {
    LAS float* tab = (LAS float*)lds;
    rope_table<8>(TID, tab);
    const int lane = TID & 63, wave = TID >> 6, l16 = lane & 15, hq = lane >> 4;
    const int gw = blockIdx.x * NWAVES + wave, NGW = gridDim.x * NWAVES;
    const f32x4 gqn = *(const f32x4*)(gq + 4 * l16), gkn = *(const f32x4*)(gk + 4 * l16);
    const float gqr0 = gq[64 + 2 * l16], gqr1 = gq[65 + 2 * l16], gkr0 = gk[64 + 2 * l16], gkr1 = gk[65 + 2 * l16];
    const int fi = 2 * (l16 & 3); const bool x2 = (l16 & 4) != 0, colpos = (l16 & 8) != 0;
    for (int row = gw; row < MTOT; row += NGW) {
        const bool islat = row < LAT; const int t = row & (SEQ - 1); const int pos = colpos ? (t & 63) : (t >> 6);
        float cs0 = 1.f, sn0 = 0.f, cs1 = 1.f, sn1 = 0.f;
        if (islat) { cs0 = tab[2 * (pos * 8 + fi)]; sn0 = tab[2 * (pos * 8 + fi) + 1]; cs1 = tab[2 * (pos * 8 + fi + 1)]; sn1 = tab[2 * (pos * 8 + fi + 1) + 1]; }
        u32x2 qn[4], kn[4]; unsigned qr[4];
        const bf16_t* qrow = QR + (size_t)(islat ? row : 0) * 1536 + hq * 96;
        bf16_t* krow = KV + (size_t)row * 2048 + hq * 128;
#pragma unroll
        for (int p = 0; p < 4; ++p) { qn[p] = *(const u32x2*)(qrow + p * 384 + 4 * l16); qr[p] = *(const unsigned*)(qrow + p * 384 + 64 + 2 * l16); kn[p] = *(const u32x2*)(krow + p * 512 + 4 * l16); }
        const unsigned krw = *(const unsigned*)(PROJ + (size_t)row * 512 + 384 + 2 * l16);
        if (islat) {
#pragma unroll
            for (int p = 0; p < 4; ++p) { bf16_t* q = QR + (size_t)row * 1536 + (4 * p + hq) * 96;
                f32x4 a = {bflo(qn[p].x), bfhi(qn[p].x), bflo(qn[p].y), bfhi(qn[p].y)}; float c0 = bflo(qr[p]), c1 = bfhi(qr[p]);
                float s = ((a.x * a.x + a.y * a.y) + (a.z * a.z + a.w * a.w)) + (c0 * c0 + c1 * c1); s += __shfl_xor(s, 1); s += __shfl_xor(s, 2); s += __shfl_xor(s, 4); s += __shfl_xor(s, 8);
                const float rstd = 1.0f / sqrtf(s * (1.0f / 96.0f) + EPS);
                a = a * rstd * gqn; c0 *= rstd * gqr0; c1 *= rstd * gqr1;
                const float o0 = __shfl_xor(c0, 4), o1 = __shfl_xor(c1, 4);
                c0 = x2 ? (o0 * sn0 + c0 * cs0) : (c0 * cs0 - o0 * sn0); c1 = x2 ? (o1 * sn1 + c1 * cs1) : (c1 * cs1 - o1 * sn1);
                u32x2 w; w.x = pk2(a.x * qscale, a.y * qscale); w.y = pk2(a.z * qscale, a.w * qscale); *(u32x2*)(q + 4 * l16) = w; *(unsigned*)(q + 64 + 2 * l16) = pk2(c0 * qscale, c1 * qscale); }
        }
#pragma unroll
        for (int p = 0; p < 4; ++p) { const int hh = 4 * p + hq; bf16_t* k = KV + (size_t)row * 2048 + hh * 128;
            f32x4 a = {bflo(kn[p].x), bfhi(kn[p].x), bflo(kn[p].y), bfhi(kn[p].y)}; float c0 = bflo(krw), c1 = bfhi(krw);
            float s = ((a.x * a.x + a.y * a.y) + (a.z * a.z + a.w * a.w)) + (c0 * c0 + c1 * c1); s += __shfl_xor(s, 1); s += __shfl_xor(s, 2); s += __shfl_xor(s, 4); s += __shfl_xor(s, 8);
            const float rstd = 1.0f / sqrtf(s * (1.0f / 96.0f) + EPS);
            a = a * rstd * gkn; c0 *= rstd * gkr0; c1 *= rstd * gkr1;
            const float o0 = __shfl_xor(c0, 4), o1 = __shfl_xor(c1, 4);
            c0 = x2 ? (o0 * sn0 + c0 * cs0) : (c0 * cs0 - o0 * sn0); c1 = x2 ? (o1 * sn1 + c1 * cs1) : (c1 * cs1 - o1 * sn1);
            u32x2 w; w.x = pk2(a.x, a.y); w.y = pk2(a.z, a.w); *(u32x2*)(k + 4 * l16) = w; *(unsigned*)(KR + (size_t)row * 512 + hh * 32 + 2 * l16) = pk2(c0, c1); }
    }
}

__device__ __forceinline__ void pool_phase(const int TID, const bf16_t* A, bf16_t* P, LAS unsigned char* lds) {
    const int tid = TID, lane = tid & 63, wave = tid >> 6;
    u32x4 st[8];
#define POOL_GEO(u_, base_, L_, t0_) do { const int r0_ = 16 * (u_); if (r0_ < LAT) { base_ = r0_ & ~(SEQ - 1); L_ = SEQ; t0_ = r0_ - base_; } else { const int r_ = r0_ - LAT; base_ = LAT + (r_ & ~(CTXL - 1)); L_ = CTXL; t0_ = r_ & (CTXL - 1); } } while (0)
#define POOL_FETCH(u_) do { int base_, L_, t0_; POOL_GEO(u_, base_, L_, t0_); _Pragma("unroll") for (int q = 0; q < 8; ++q) { int i = tid + q * NTHREADS; i = i < 31 * 128 ? i : 31 * 128 - 1; int k = t0_ - 8 + (i >> 7); k = k < 0 ? 0 : (k >= L_ ? L_ - 1 : k); st[q] = *(const u32x4*)(A + (size_t)(base_ + k) * DM + (i & 127) * 8); } } while (0)
    int u = blockIdx.x;
    if (u < MTOT / 16) POOL_FETCH(u);
    for (; u < MTOT / 16; u += gridDim.x) {
        int base, L, t0; POOL_GEO(u, base, L, t0); const int r0 = 16 * u; (void)base;
#pragma unroll
        for (int q = 0; q < 8; ++q) { int i = tid + q * NTHREADS; i = i < 31 * 128 ? i : 31 * 128 - 1; *(LAS u32x4*)(lds + (size_t)i * 16) = st[q]; }
        __syncthreads();
        if (u + (int)gridDim.x < MTOT / 16) POOL_FETCH(u + (int)gridDim.x);
#pragma unroll
        for (int rr = 0; rr < 2; ++rr) { const int tl = 2 * wave + rr, t = t0 + tl;
#pragma unroll
            for (int j = 0; j < 4; ++j) {
                const int w = 2 << j; f32x4 s = {0.f, 0.f, 0.f, 0.f};
                const LAS unsigned char* colp = lds + (256 * j + 4 * lane) * 2;
#pragma unroll
                for (int d = 0; d < 16; ++d) { if (d < w) { const int k = t - w / 2 + d; const float wt = (k >= 0 && k < L) ? 1.0f : 0.0f;
                        const u32x2 v = *(const LAS u32x2*)(colp + (tl + 8 - w / 2 + d) * 2048);
                        s += (f32x4){bflo(v.x), bfhi(v.x), bflo(v.y), bfhi(v.y)} * wt; } }
                const u32x2 sv = *(const LAS u32x2*)(colp + (tl + 8) * 2048); const f32x4 self = {bflo(sv.x), bfhi(sv.x), bflo(sv.y), bfhi(sv.y)};
                int lo = t - w / 2, hi = t - w / 2 + w; lo = lo < 0 ? 0 : lo; hi = hi > L ? L : hi;
                const f32x4 o = s * (1.0f / (float)(hi - lo)) - self;
                u32x2 wo; wo.x = pk2(o.x, o.y); wo.y = pk2(o.z, o.w); *(u32x2*)(P + (size_t)(r0 + tl) * DM + 256 * j + 4 * lane) = wo; } }
        __syncthreads();
    }
#undef POOL_GEO
#undef POOL_FETCH
}

typedef short v4i16_t __attribute__((ext_vector_type(4)));
constexpr float ATT_THR = 8.0f;
__device__ __forceinline__ int crow16(int r, int hi) { return (r & 3) + 8 * (r >> 2) + 4 * hi; }
template <int MODE> __device__ __forceinline__ void attn_phase(const int TID, KArgs a, LAS unsigned char* lds) {
    constexpr int DQK = MODE == 2 ? 96 : 64, NKS = DQK / 16;
    constexpr int KROWB = DQK * 2 + 16, KBUF = 64 * KROWB, KSTR = (MODE == 1 ? 2 : 1) * KBUF, VSTR = (MODE == 1 ? 2 : 1) * 8192, VOFF = 2 * KSTR, BIASOFF = VOFF + 2 * VSTR;
    const int tid = TID, lane = tid & 63, wid = __builtin_amdgcn_readfirstlane(tid >> 6), r32 = lane & 31, hi = lane >> 5;
    unsigned char* ws = a->ws;
    const bf16_t *Qb, *Kb, *K2b = nullptr, *Vb; bf16_t* Ob; int ldq, ldk;
    if (MODE == 0) { Qb = (const bf16_t*)(ws + WS_RB); ldq = 1536; Kb = Qb + 1024; Vb = Qb + 1280; ldk = 1536; Ob = (bf16_t*)(ws + WS_RO); }
    else if (MODE == 1) { Qb = (const bf16_t*)(ws + WS_RB); ldq = 3072; Kb = Qb + 1024; Vb = Qb + 2048; ldk = 3072; Ob = (bf16_t*)(ws + WS_RO); }
    else { Qb = (const bf16_t*)(ws + WS_QR); ldq = 1536; Kb = (const bf16_t*)(ws + WS_KV); Vb = Kb + 64; K2b = (const bf16_t*)(ws + WS_KR); ldk = 2048; Ob = (bf16_t*)(ws + WS_RA); }
    const int G = gridDim.x, bx = blockIdx.x, vcu = (G % 8 == 0) ? (bx % 8) * (G / 8) + bx / 8 : bx;
    constexpr int NLAT = 2048, NCTXU = MODE == 2 ? 0 : 256;
    const int lat_per = (NLAT + G - 1) / G, ctx_per = (NCTXU + G - 1) / G;
    LAS float* btab = (LAS float*)(lds + BIASOFF);
    const int srow = tid >> 3, sch = tid & 7, s2row = tid >> 3, s2ch = tid & 7;
    const int kst = srow * KROWB + sch * 16, k2st = s2row * KROWB + 128 + s2ch * 8, vst = (sch >> 2) * 4096 + srow * 64 + (sch & 3) * 16;
    const int vrd = (4 * hi + ((lane & 15) >> 2)) * 64 + (16 * ((lane >> 4) & 1) + 4 * (lane & 3)) * 2;
    u32x4 kreg, vreg; u32x2 k2r = {0u, 0u};
    u32x4 kregB = {0u, 0u, 0u, 0u}, vregB = {0u, 0u, 0u, 0u};
    bool pref = false;
    int bias_head = -1;
    for (int it = 0; it < lat_per + ctx_per; ++it) {
        const bool ctxu = it >= lat_per;
        const int u = ctxu ? vcu * ctx_per + (it - lat_per) : vcu * lat_per + it;
        if (u >= (ctxu ? NCTXU : NLAT)) continue;
        int b, head, hoff, qrow, NT, lat0 = 0, qtok = 0, jj_lo = 0, rrow = 0, R0 = 0, nl = 0;
        if (MODE == 0) {
            if (!ctxu) { b = u >> 7; const int kvh = (u >> 5) & 3, qb = u & 31; head = kvh * 4 + (wid >> 1); hoff = kvh * 64; qtok = qb * 64 + (wid & 1) * 32 + r32; qrow = b * SEQ + qtok;
                jj_lo = 2 - qb > 0 ? 2 - qb : 0; const int jj_hi = 33 - qb < 4 ? 33 - qb : 4; lat0 = b * SEQ + qb * 64 - 128 + 64 * jj_lo; NT = 4 + (jj_hi - jj_lo + 1); }
            else { b = u >> 4; const int kvh = (u >> 2) & 3, qb = u & 3; head = kvh * 4 + (wid >> 1); hoff = kvh * 64; qtok = qb * 64 + (wid & 1) * 32 + r32; qrow = LAT + b * CTXL + qtok; NT = 4; }
        } else if (MODE == 1) {
            if (!ctxu) { b = u >> 7; head = (u >> 3) & 15; const int rq = u & 7; hoff = head * 64; rrow = 4 * rq + (r32 >> 3); qtok = 8 * wid + (r32 & 7); qrow = b * SEQ + rrow * 64 + qtok;
                R0 = 4 * rq - 4; R0 = R0 < 0 ? 0 : (R0 > 24 ? 24 : R0); int R1 = 4 * rq - 1; R1 = (R1 < 0 ? 0 : (R1 > 24 ? 24 : R1)) + 7; lat0 = b * SEQ + R0 * 64; nl = R1 - R0 + 1; NT = 4 + (nl + 1) / 2; }
            else { b = u >> 4; head = u & 15; hoff = head * 64; qrow = LAT + b * CTXL + wid * 32 + r32; NT = 4; }
        } else { b = u >> 7; head = (u >> 3) & 15; const int qb = u & 7; hoff = head * 128; qrow = b * SEQ + qb * 256 + wid * 32 + r32; lat0 = b * SEQ; NT = 4 + 32; }
        const int ctx0 = LAT + b * CTXL;
        bf16x8 qf[NKS];
        { const bf16_t* qp = Qb + (size_t)qrow * ldq + head * DQK + 8 * hi;
#pragma unroll
          for (int ks = 0; ks < NKS; ++ks) qf[ks] = *(const bf16x8*)(qp + 16 * ks); }
        if (MODE == 1 && !ctxu && head != bias_head) { const float* rp = a->in[18] + (size_t)head * 465; for (int i = tid; i < 465; i += NTHREADS) btab[64 + i] = rp[i] * LOG2E; bias_head = head; }
#define ATT_TILE_ROW(j) ((j) < 4 ? ctx0 + 64 * (j) : lat0 + (MODE == 1 ? 128 : 64) * ((j) - 4))
#define ATT_TILE_ROWB(j) (lat0 + 64 * ((2 * ((j) - 4) + 1 < nl) ? 2 * ((j) - 4) + 1 : nl - 1))
#define ATT_LOAD(j) do { const int kr0_ = ATT_TILE_ROW(j); kreg = *(const u32x4*)(Kb + (size_t)(kr0_ + srow) * ldk + hoff + sch * 8); vreg = *(const u32x4*)(Vb + (size_t)(kr0_ + srow) * ldk + hoff + sch * 8); \
        if (MODE == 2) k2r = *(const u32x2*)(K2b + (size_t)(kr0_ + s2row) * 512 + head * 32 + s2ch * 4); \
        if (MODE == 1 && (j) >= 4) { const int krb_ = ATT_TILE_ROWB(j); kregB = *(const u32x4*)(Kb + (size_t)(krb_ + srow) * ldk + hoff + sch * 8); vregB = *(const u32x4*)(Vb + (size_t)(krb_ + srow) * ldk + hoff + sch * 8); } } while (0)
#define ATT_STORE(buf, jt) do { *(LAS u32x4*)(lds + (buf) * KSTR + kst) = kreg; *(LAS u32x4*)(lds + VOFF + (buf) * VSTR + vst) = vreg; if (MODE == 2) *(LAS u32x2*)(lds + (buf) * KSTR + k2st) = k2r; \
        if (MODE == 1 && (jt) >= 4) { *(LAS u32x4*)(lds + (buf) * KSTR + KBUF + kst) = kregB; *(LAS u32x4*)(lds + VOFF + (buf) * VSTR + 8192 + vst) = vregB; } } while (0)
#define ATT_LOAD0N(B_, HOFF_, HEAD_) do { const int kr0_ = LAT + (B_) * CTXL; kreg = *(const u32x4*)(Kb + (size_t)(kr0_ + srow) * ldk + (HOFF_) + sch * 8); vreg = *(const u32x4*)(Vb + (size_t)(kr0_ + srow) * ldk + (HOFF_) + sch * 8); \
        if (MODE == 2) k2r = *(const u32x2*)(K2b + (size_t)(kr0_ + s2row) * 512 + (HEAD_) * 32 + s2ch * 4); } while (0)
        if (!pref) ATT_LOAD(0);
        ATT_STORE(0, 0);
        __syncthreads();
        f32x16 o0, o1;
#pragma unroll
        for (int i = 0; i < 16; ++i) { o0[i] = 0.f; o1[i] = 0.f; }
        float l = 0.f;
        f32x16 zacc;
#pragma unroll
        for (int i = 0; i < 16; ++i) zacc[i] = 0.f;
        int r0w = rrow - 4; r0w = r0w < 0 ? 0 : (r0w > 24 ? 24 : r0w);
        int cs = qtok - 8; cs = cs < 0 ? 0 : (cs > 48 ? 48 : cs);
        for (int j = 0; j < NT; ++j) {
            if (j + 1 < NT) ATT_LOAD(j + 1);
            else {
                const int itn = it + 1; pref = false;
                if (itn < lat_per + ctx_per) { const bool cn = itn >= lat_per; const int un = cn ? vcu * ctx_per + (itn - lat_per) : vcu * lat_per + itn;
                    if (un < (cn ? NCTXU : NLAT)) { int bn, hn, hoffn;
                        if (MODE == 0) { bn = cn ? un >> 4 : un >> 7; const int kvh = cn ? (un >> 2) & 3 : (un >> 5) & 3; hn = 0; hoffn = kvh * 64; }
                        else if (MODE == 1) { bn = cn ? un >> 4 : un >> 7; hn = cn ? un & 15 : (un >> 3) & 15; hoffn = hn * 64; }
                        else { bn = un >> 7; hn = (un >> 3) & 15; hoffn = hn * 128; }
                        ATT_LOAD0N(bn, hoffn, hn); pref = true; } } }
            const int buf = j & 1;
            bool active = true, masked = false; int kr = 0, kstart = 0;
            if (MODE == 0 && j >= 4) { const int jj = jj_lo + (j - 4); masked = (jj == 0 || jj == 4); kstart = (lat0 - b * SEQ) + 64 * (j - 4); }
            if (MODE == 1 && j >= 4) { kr = R0 + 2 * (j - 4); active = false; }
            if (MODE == 1 && j >= 4) {
                const int wsk = wid == 0 ? 0 : (wid > 5 ? 32 : 8 * wid - 8);
                const bool hasB = 2 * (j - 4) + 1 < nl;
                const LAS unsigned char* kb = lds + buf * KSTR + (wsk + r32) * KROWB + hi * 16;
                bf16x8 kf0[NKS], kf1[NKS];
#pragma unroll
                for (int ks = 0; ks < NKS; ++ks) { kf0[ks] = *(const LAS bf16x8*)(kb + ks * 32); kf1[ks] = *(const LAS bf16x8*)(kb + KBUF + ks * 32); }
                const LAS unsigned char* vb = lds + VOFF + buf * VSTR + vrd + wsk * 64;
                v4i16_t vlo[8], vhi[8];
#pragma unroll
                for (int s = 0; s < 4; ++s)
#pragma unroll
                    for (int dh = 0; dh < 2; ++dh) { const int off = (s >> 1) * 8192 + dh * 4096 + (s & 1) * 1024;
                        vlo[2 * s + dh] = __builtin_amdgcn_ds_read_tr16_b64_v4i16((LAS v4i16_t*)(vb + off)); vhi[2 * s + dh] = __builtin_amdgcn_ds_read_tr16_b64_v4i16((LAS v4i16_t*)(vb + off + 512)); }
                __builtin_amdgcn_sched_barrier(0);
                f32x16 s0, s1;
#pragma unroll
                for (int ks = 0; ks < NKS; ++ks) { s0 = __builtin_amdgcn_mfma_f32_32x32x16_bf16(kf0[ks], qf[ks], ks == 0 ? zacc : s0, 0, 0, 0); s1 = __builtin_amdgcn_mfma_f32_32x32x16_bf16(kf1[ks], qf[ks], ks == 0 ? zacc : s1, 0, 0, 0); }
                const bool rowokA = (unsigned)(kr - r0w) < 8u, rowokB = hasB && (unsigned)(kr + 1 - r0w) < 8u;
                const LAS float* bpA = btab + 64 + (kr - rrow + 7) * 31 + 15 - qtok + wsk + 4 * hi; const LAS float* bpB = hasB ? bpA + 31 : bpA;
                const int e0A = rowokA ? wsk + 4 * hi - cs : -1000, e0B = rowokB ? wsk + 4 * hi - cs : -1000;
                float bvA[16], bvB[16];
#pragma unroll
                for (int i = 0; i < 16; ++i) { bvA[i] = bpA[(i & 3) + 8 * (i >> 2)]; bvB[i] = bpB[(i & 3) + 8 * (i >> 2)]; }
                __builtin_amdgcn_sched_barrier(0);
                bf16x8 pf[4];
                float ls = 0.f;
#pragma unroll
                for (int i = 0; i < 16; ++i) { const int c = (i & 3) + 8 * (i >> 2); const float sb = s0[i] + bvA[i]; const float sv = (unsigned)(e0A + c) < 16u ? sb : -1e30f; s0[i] = __builtin_amdgcn_exp2f(sv); ls += s0[i]; }
#pragma unroll
                for (int s = 0; s < 2; ++s) { u32x4 w;
#pragma unroll
                    for (int e = 0; e < 4; ++e) { const int r = 8 * s + 2 * e; w[e] = pg8::cvt_pk_bf16(s0[r], s0[r + 1]); }
                    pf[s] = __builtin_bit_cast(bf16x8, w); }
                __builtin_amdgcn_sched_barrier(0);
#pragma unroll
                for (int s = 0; s < 2; ++s) {
                    const bf16x8 vf0 = __builtin_shufflevector(vlo[2 * s], vhi[2 * s], 0, 1, 2, 3, 4, 5, 6, 7), vf1 = __builtin_shufflevector(vlo[2 * s + 1], vhi[2 * s + 1], 0, 1, 2, 3, 4, 5, 6, 7);
                    o0 = __builtin_amdgcn_mfma_f32_32x32x16_bf16(vf0, pf[s], o0, 0, 0, 0); o1 = __builtin_amdgcn_mfma_f32_32x32x16_bf16(vf1, pf[s], o1, 0, 0, 0); }
                __builtin_amdgcn_sched_barrier(0);
#pragma unroll
                for (int i = 0; i < 16; ++i) { const int c = (i & 3) + 8 * (i >> 2); const float sb = s1[i] + bvB[i]; const float sv = (unsigned)(e0B + c) < 16u ? sb : -1e30f; s1[i] = __builtin_amdgcn_exp2f(sv); ls += s1[i]; }
                l += ls;
#pragma unroll
                for (int s = 2; s < 4; ++s) { u32x4 w;
#pragma unroll
                    for (int e = 0; e < 4; ++e) { const int r = 8 * (s & 1) + 2 * e; w[e] = pg8::cvt_pk_bf16(s1[r], s1[r + 1]); }
                    pf[s] = __builtin_bit_cast(bf16x8, w); }
                __builtin_amdgcn_sched_barrier(0);
#pragma unroll
                for (int s = 2; s < 4; ++s) {
                    const bf16x8 vf0 = __builtin_shufflevector(vlo[2 * s], vhi[2 * s], 0, 1, 2, 3, 4, 5, 6, 7), vf1 = __builtin_shufflevector(vlo[2 * s + 1], vhi[2 * s + 1], 0, 1, 2, 3, 4, 5, 6, 7);
                    o0 = __builtin_amdgcn_mfma_f32_32x32x16_bf16(vf0, pf[s], o0, 0, 0, 0); o1 = __builtin_amdgcn_mfma_f32_32x32x16_bf16(vf1, pf[s], o1, 0, 0, 0); }
            }
            if (active) {
                const LAS unsigned char* kb = lds + buf * KSTR + r32 * KROWB + hi * 16;
                f32x16 s0, s1;
                bf16x8 kf0[NKS], kf1[NKS];
#pragma unroll
                for (int ks = 0; ks < NKS; ++ks) { kf0[ks] = *(const LAS bf16x8*)(kb + ks * 32); kf1[ks] = *(const LAS bf16x8*)(kb + 32 * KROWB + ks * 32); }
                const LAS unsigned char* vb = lds + VOFF + buf * VSTR + vrd;
                v4i16_t vlo[8], vhi[8];
#pragma unroll
                for (int s = 0; s < 4; ++s)
#pragma unroll
                    for (int dh = 0; dh < 2; ++dh) { vlo[2 * s + dh] = __builtin_amdgcn_ds_read_tr16_b64_v4i16((LAS v4i16_t*)(vb + dh * 4096 + s * 1024)); vhi[2 * s + dh] = __builtin_amdgcn_ds_read_tr16_b64_v4i16((LAS v4i16_t*)(vb + dh * 4096 + s * 1024 + 512)); }
                __builtin_amdgcn_sched_barrier(0);
#pragma unroll
                for (int ks = 0; ks < NKS; ++ks) {
                    s0 = __builtin_amdgcn_mfma_f32_32x32x16_bf16(kf0[ks], qf[ks], ks == 0 ? zacc : s0, 0, 0, 0); s1 = __builtin_amdgcn_mfma_f32_32x32x16_bf16(kf1[ks], qf[ks], ks == 0 ? zacc : s1, 0, 0, 0); }
                __builtin_amdgcn_sched_barrier(0);
                if (MODE == 0 && masked) { const int d0 = qtok - kstart - 4 * hi + 128;
#pragma unroll
                    for (int i = 0; i < 16; ++i) { const int c = (i & 3) + 8 * (i >> 2); if ((unsigned)(d0 - c) > 256u) s0[i] = -1e30f; if ((unsigned)(d0 - c - 32) > 256u) s1[i] = -1e30f; } }
                bf16x8 pf[4];
                float ls = 0.f;
#pragma unroll
                for (int i = 0; i < 16; ++i) { s0[i] = __builtin_amdgcn_exp2f(s0[i]); ls += s0[i]; }
#pragma unroll
                for (int s = 0; s < 2; ++s) { u32x4 w;
#pragma unroll
                    for (int e = 0; e < 4; ++e) { const int r = 8 * s + 2 * e; w[e] = pg8::cvt_pk_bf16(s0[r], s0[r + 1]); }
                    pf[s] = __builtin_bit_cast(bf16x8, w); }
                __builtin_amdgcn_sched_barrier(0);
#pragma unroll
                for (int s = 0; s < 2; ++s) {
                    const bf16x8 vf0 = __builtin_shufflevector(vlo[2 * s], vhi[2 * s], 0, 1, 2, 3, 4, 5, 6, 7), vf1 = __builtin_shufflevector(vlo[2 * s + 1], vhi[2 * s + 1], 0, 1, 2, 3, 4, 5, 6, 7);
                    o0 = __builtin_amdgcn_mfma_f32_32x32x16_bf16(vf0, pf[s], o0, 0, 0, 0); o1 = __builtin_amdgcn_mfma_f32_32x32x16_bf16(vf1, pf[s], o1, 0, 0, 0); }
                __builtin_amdgcn_sched_barrier(0);
#pragma unroll
                for (int i = 0; i < 16; ++i) { s1[i] = __builtin_amdgcn_exp2f(s1[i]); ls += s1[i]; }
                l += ls;
#pragma unroll
                for (int s = 2; s < 4; ++s) { u32x4 w;
#pragma unroll
                    for (int e = 0; e < 4; ++e) { const int r = 8 * (s & 1) + 2 * e; w[e] = pg8::cvt_pk_bf16(s1[r], s1[r + 1]); }
                    pf[s] = __builtin_bit_cast(bf16x8, w); }
                __builtin_amdgcn_sched_barrier(0);
#pragma unroll
                for (int s = 2; s < 4; ++s) {
                    const bf16x8 vf0 = __builtin_shufflevector(vlo[2 * s], vhi[2 * s], 0, 1, 2, 3, 4, 5, 6, 7), vf1 = __builtin_shufflevector(vlo[2 * s + 1], vhi[2 * s + 1], 0, 1, 2, 3, 4, 5, 6, 7);
                    o0 = __builtin_amdgcn_mfma_f32_32x32x16_bf16(vf0, pf[s], o0, 0, 0, 0); o1 = __builtin_amdgcn_mfma_f32_32x32x16_bf16(vf1, pf[s], o1, 0, 0, 0); }
            }
            if (j + 1 < NT) ATT_STORE(buf ^ 1, j + 1);
            __syncthreads();
        }
#undef ATT_TILE_ROW
#undef ATT_TILE_ROWB
#undef ATT_LOAD
#undef ATT_STORE
#undef ATT_LOAD0N
        l += __shfl_xor(l, 32);
        if (MODE == 0) l += __builtin_amdgcn_exp2f(a->in[13][head] * LOG2E);
        const float inv = 1.0f / l;
        bf16_t* op = Ob + (size_t)qrow * DM + head * 64 + 8 * hi;
#pragma unroll
        for (int k = 0; k < 2; ++k)
#pragma unroll
            for (int dh = 0; dh < 2; ++dh) {
                const unsigned A0 = dh ? pg8::cvt_pk_bf16(o1[8 * k] * inv, o1[8 * k + 1] * inv) : pg8::cvt_pk_bf16(o0[8 * k] * inv, o0[8 * k + 1] * inv);
                const unsigned A1 = dh ? pg8::cvt_pk_bf16(o1[8 * k + 2] * inv, o1[8 * k + 3] * inv) : pg8::cvt_pk_bf16(o0[8 * k + 2] * inv, o0[8 * k + 3] * inv);
                const unsigned B0 = dh ? pg8::cvt_pk_bf16(o1[8 * k + 4] * inv, o1[8 * k + 5] * inv) : pg8::cvt_pk_bf16(o0[8 * k + 4] * inv, o0[8 * k + 5] * inv);
                const unsigned B1 = dh ? pg8::cvt_pk_bf16(o1[8 * k + 6] * inv, o1[8 * k + 7] * inv) : pg8::cvt_pk_bf16(o0[8 * k + 6] * inv, o0[8 * k + 7] * inv);
                const auto r0 = __builtin_amdgcn_permlane32_swap(A0, B0, false, false), r1 = __builtin_amdgcn_permlane32_swap(A1, B1, false, false);
                u32x4 w; w.x = r0[0]; w.y = r1[0]; w.z = r0[1]; w.w = r1[1];
                *(u32x4*)(op + 32 * dh + 16 * k) = w; }
    }
}

enum Kind { K_PRO = 0, K_N1, K_G1, K_QKN, K_ATT, K_G2, K_N2, K_G3, K_G4, K_POOL, K_GPOOL, K_GPROJ, K_MLAN1, K_GUP, K_MLAN2 };
constexpr int NPHASES = 23;
__device__ __forceinline__ void decode_phase(int p, int& L, int& kind) {
    if (p == 0) { L = 0; kind = K_PRO; return; }
    if (p <= 6) { L = 0; const int k = p - 1; kind = k == 0 ? K_N1 : k == 1 ? K_G1 : k == 2 ? K_ATT : k == 3 ? K_G2 : k == 4 ? K_G3 : K_G4; return; }
    if (p <= 11) { L = 1; const int k = p - 7; kind = k == 0 ? K_G1 : k == 1 ? K_ATT : k == 2 ? K_G2 : k == 3 ? K_G3 : K_G4; return; }
    if (p <= 15) { L = 2; const int k = p - 12; kind = k == 0 ? K_POOL : k == 1 ? K_GPOOL : k == 2 ? K_G3 : K_G4; return; }
    L = 3; const int k = p - 16;
    kind = k == 0 ? K_GPROJ : k == 1 ? K_GUP : k == 2 ? K_MLAN2 : k == 3 ? K_ATT : k == 4 ? K_G2 : k == 5 ? K_G3 : K_G4;
}

__device__ __forceinline__ int mk_lane_id() { int l; asm volatile("v_mbcnt_lo_u32_b32 %0, -1, 0\n\tv_mbcnt_hi_u32_b32 %0, -1, %0" : "=v"(l)); return l; }
#define XB_TMO      128
#define XB_XCNT(j)  (256  + 64 * (j))
#define XB_XSUB(j)  (1280 + 64 * (j))
#define XB_XGEN(j)  (2304 + 64 * (j))
#define XB_TOP      3328
#define XB_TOPGEN   3392
#define XCD_BAR_WORDS 3456
#define XB_SPIN_CAP (1u << 18)

__device__ __forceinline__ unsigned xb_ld(unsigned* p)              { return __hip_atomic_load(p, __ATOMIC_RELAXED, __HIP_MEMORY_SCOPE_AGENT); }
__device__ __forceinline__ unsigned xb_add(unsigned* p, unsigned v) { return __hip_atomic_fetch_add(p, v, __ATOMIC_RELAXED, __HIP_MEMORY_SCOPE_AGENT); }
__device__ __forceinline__ unsigned xb_xcc_id() { return (unsigned)__builtin_amdgcn_s_getreg((3 << 11) | 20) & 0xFu; }
#define XB_SPIN(cond, bar) do { unsigned _sp = 0; while (cond) { __builtin_amdgcn_s_sleep(1); \
    if ((++_sp & 255u) == 0u) { if (xb_ld(&(bar)[XB_TMO])) break; if (_sp > XB_SPIN_CAP) { atomicAdd(&(bar)[XB_TMO], 1u); break; } } } } while (0)

struct XcdBarrier {
    bool w0;
    unsigned* bar; unsigned x;
    volatile LAS unsigned* st;
};

__device__ __forceinline__ XcdBarrier xcd_barrier_post(unsigned* bar, volatile LAS unsigned* st) {
    XcdBarrier b; b.bar = bar; b.x = xb_xcc_id(); b.st = st; b.w0 = false;
    if (threadIdx.x == 0) (void)xb_add(&bar[XB_XCNT(b.x)], 1u);
    return b;
}
__device__ __forceinline__ void xcd_barrier_complete(unsigned* bar, unsigned x, unsigned& nloc, unsigned& nx) {
    const unsigned G = gridDim.x * gridDim.y * gridDim.z;
    unsigned sum, cnt, mine, sp = 0u;
    for (;;) {
        sum = 0u; cnt = 0u; mine = 0u;
#pragma unroll
        for (unsigned j = 0; j < 16; ++j) { const unsigned c = xb_ld(&bar[XB_XCNT(j)]); sum += c; cnt += (c > 0u) ? 1u : 0u; mine = (j == x) ? c : mine; }
        if (sum == G) break;
        __builtin_amdgcn_s_sleep(1);
        if ((++sp & 255u) == 0u) { if (xb_ld(&bar[XB_TMO])) break; if (sp > XB_SPIN_CAP) { atomicAdd(&bar[XB_TMO], 1u); break; } }
    }
    nloc = mine > 0u ? mine : 1u; nx = cnt > 0u ? cnt : 1u;
}

__device__ __forceinline__ void xcd_barrier(const XcdBarrier& b) {
    asm volatile("s_waitcnt vmcnt(0)" ::: "memory");
    __syncthreads();
    if (b.w0 && mk_lane_id() == 0) {
        unsigned* bar = b.bar;
        __builtin_amdgcn_s_waitcnt(0);
        unsigned nloc = b.st[0], nx = b.st[1];
        if (nloc == 0u) { xcd_barrier_complete(bar, b.x, nloc, nx); b.st[0] = nloc; b.st[1] = nx; }
        const unsigned old = xb_add(&bar[XB_XSUB(b.x)], 1u);
        const unsigned gen = old / nloc;
        if (old + 1u == (gen + 1u) * nloc) {
            __builtin_amdgcn_fence(__ATOMIC_RELEASE, "agent");
            asm volatile("s_waitcnt vmcnt(0)" ::: "memory");
            const unsigned og = xb_add(&bar[XB_TOP], 1u);
            const unsigned tg = og / nx;
            if (og + 1u == (tg + 1u) * nx) xb_add(&bar[XB_TOPGEN], 1u);
            else XB_SPIN(xb_ld(&bar[XB_TOPGEN]) == tg, bar);
            __builtin_amdgcn_fence(__ATOMIC_ACQUIRE, "agent");
            xb_add(&bar[XB_XGEN(b.x)], 1u);
            asm volatile("s_waitcnt vmcnt(0)" ::: "memory");
        } else {
            XB_SPIN(xb_ld(&bar[XB_XGEN(b.x)]) == gen, bar);
            __builtin_amdgcn_fence(__ATOMIC_ACQUIRE, "agent");
            asm volatile("s_waitcnt vmcnt(0)" ::: "memory");
        }
    }
    __syncthreads();
}

#ifndef RESID_STAGGER
#define RESID_STAGGER 0
#endif
#ifndef PROBE_KIND
#define PROBE_KIND -1
#endif
#ifndef PROBE_N
#define PROBE_N 0
#endif
#ifndef PROBE_L
#define PROBE_L -1
#endif
#ifndef PROBE_PLAIN
#define PROBE_PLAIN 0
#endif
#ifndef PROBE_SYNC
#define PROBE_SYNC 0
#endif
__global__ void __launch_bounds__(NTHREADS) fwd_kernel(Args a_by_value) {
    extern __shared__ __attribute__((aligned(16))) unsigned char lds_raw[];
    LAS unsigned char* lds = (LAS unsigned char*)lds_raw;
    cg::grid_group grid = cg::this_grid();
    const int ph_lo = a_by_value.ph_lo, ph_hi = a_by_value.ph_hi;
    volatile LAS unsigned* MISC = (volatile LAS unsigned*)(lds + 131072);
    if (threadIdx.x < 4) MISC[threadIdx.x] = 0u;
    __syncthreads();
    XcdBarrier xbar = xcd_barrier_post((unsigned*)(a_by_value.ws + WS_CTL), MISC);
    const int wave_id = __builtin_amdgcn_readfirstlane((int)(threadIdx.x >> 6));
    xbar.w0 = wave_id == 0;
    if (ph_hi > 4096) grid.sync();
    for (int q = ph_lo * (1 + PROBE_N); q < ph_hi * (1 + PROBE_N); ++q) {
        const int p = q / (1 + PROBE_N);
        int L, kind; decode_phase(p, L, kind);
        const bool extra_visit = PROBE_N > 0 && (q % (1 + PROBE_N)) != 0;
        if (extra_visit && (kind != PROBE_KIND || (PROBE_L >= 0 && L != PROBE_L))) continue;
        KArgs a = (KArgs)__builtin_amdgcn_kernarg_segment_ptr(); asm volatile("" : "+s"(a));
        unsigned char* ws = a->ws;
        const float* MOD = (const float*)(ws + WS_MOD);
        float* HC = (float*)(ws + WS_HC);
        bf16_t* RA = (bf16_t*)(ws + WS_RA); bf16_t* RO = (bf16_t*)(ws + WS_RO); bf16_t* RB = (bf16_t*)(ws + WS_RB);
        int TID = wave_id * 64 + mk_lane_id(); asm volatile("" : "+v"(TID));
        const float* modL = MOD + (size_t)L * NMODB * MODLD;
        const int Mffn = L == 3 ? LAT : MTOT;
        if (kind == K_PRO) {
            prologue_phase(TID, a, lds, (extra_visit && PROBE_PLAIN) ? PROBE_PLAIN : 3);
        } else if (kind == K_N1) {
            norm_phase(TID, a->in[0], a->in[2], MTOT, a->in[6], modL, modL + DM, RA);
        } else if (kind == K_G1) {
            const int N = L == 0 ? 1536 : 3072;
            pg8::Gemm g{RA, (const bf16_t*)(ws + (L == 0 ? WS_SWA_QKV : WS_NA_QKV)), MTOT, N, DM, DM, DM, 0};
            pg8::EpiQKV E{RB, N, 4, L == 0 ? 1 : 4, L == 0 ? 1 : 0, L == 0 ? 11 : 16, L == 0 ? 12 : 17, 0.125f * LOG2E, (unsigned)WS_ROPE};
            pg8::StaticOrder S; S.init(g.M, g.N, (int)gridDim.x, (int)blockIdx.x);
            pg8::gemm_phase<pg8::EpiQKV, pg8::StaticOrder, true, true>(lds, g, S, E, TID);
        } else if (kind == K_GPROJ || kind == K_GUP) {
            const int nrep = kind == K_GUP ? 2 : 1;
            for (int rep = 0; rep < nrep; ++rep) {
                pg8::Gemm g; pg8::EpiStore E;
                if (kind == K_GPROJ) { g = pg8::Gemm{RA, (const bf16_t*)(ws + WS_MLA_WA), MTOT, 512, DM, DM, DM, 0}; E = pg8::EpiStore{(bf16_t*)(ws + WS_PROJ), 512, 1, a->in[24], a->in[25]}; }
                else if (rep == 0) { g = pg8::Gemm{(const bf16_t*)(ws + WS_PROJ), (const bf16_t*)(ws + WS_MLA_WUQ), LAT, 1536, 256, 512, 256, 0}; E = pg8::EpiStore{(bf16_t*)(ws + WS_QR), 1536, 0, nullptr, nullptr}; }
                else { g = pg8::Gemm{(const bf16_t*)(ws + WS_PROJ) + 256, (const bf16_t*)(ws + WS_MLA_WUKV), MTOT, 2048, 128, 512, 128, 0}; E = pg8::EpiStore{(bf16_t*)(ws + WS_KV), 2048, 0, nullptr, nullptr}; }
                pg8::StaticOrder S; S.init(g.M, g.N, (int)gridDim.x, (int)blockIdx.x);
                pg8::gemm_phase<pg8::EpiStore, pg8::StaticOrder, true, true>(lds, g, S, E, TID);
            }
        } else if (kind == K_G3) {
            pg8::Gemm g{L == 3 ? RO : RA, (const bf16_t*)(ws + WS_WGU + (size_t)L * SZ_WGU), Mffn, 2 * DFF, DM, DM, DM, 0};
            pg8::EpiSwiglu E{RB, DFF};
            pg8::StaticOrder S; S.init(g.M, g.N, (int)gridDim.x, (int)blockIdx.x);
            pg8::gemm_phase<pg8::EpiSwiglu, pg8::StaticOrder, true, true>(lds, g, S, E, TID);
        } else if (kind == K_G2 || kind == K_GPOOL || kind == K_G4) {
            pg8::Gemm g; pg8::EpiResid E;
            E.first = (L == 0 && kind == K_G2) ? 1 : 0; E.pool = kind == K_GPOOL ? 1 : 0; E.mod_byte = (unsigned)WS_MOD; E.hc_byte = (unsigned)WS_HC;
            E.gate_off = L * NMODB * MODLD + (kind == K_G4 ? 5 * DM : 2 * DM);
            const bool ffn = kind == K_G4;
            const int Ln = ffn ? L + 1 : L, pi = 2 * L + (ffn ? 1 : 0) - (L == 3 ? 0 : 0);
            E.donorm = ((ffn && L == 3) || (PROBE_PLAIN && extra_visit)) ? 0 : 1; E.g_in = ffn ? 6 : 7; E.g_off = Ln * DM; E.nmod_off = Ln * NMODB * MODLD + (ffn ? 0 : 3 * DM);
            E.a_byte = (L == 3 && !ffn) ? WS_RO : WS_RA; E.cnt_byte = (unsigned)(WS_CNT + (size_t)pi * 144 * 64); E.xbuf_byte = WS_XBUF + (size_t)pi * MTOT * 16;
            if (kind == K_G2) { const size_t wo = L == 0 ? WS_SWA_WO : L == 1 ? WS_NA_WO : WS_MLA_WO; g = pg8::Gemm{L == 3 ? RA : RO, (const bf16_t*)(ws + wo), Mffn, DM, DM, DM, DM, 0}; }
            else if (kind == K_GPOOL) { g = pg8::Gemm{RO, (const bf16_t*)(ws + WS_POOL), MTOT, DM, 256, DM, 256, 256}; }
            else { g = pg8::Gemm{RB, (const bf16_t*)(ws + WS_WDN + (size_t)L * SZ_WDN), Mffn, DM, DFF, DFF, DFF, 0}; }
            pg8::PanelOrder S; S.init(g.M, g.N, (int)gridDim.x, (int)blockIdx.x);
            if (RESID_STAGGER && g.M == MTOT && (int)gridDim.x == 256 && ((int)blockIdx.x >> 5) >= 2) {
                const unsigned long long t0 = __builtin_amdgcn_s_memrealtime(); const unsigned long long ticks = (unsigned long long)(g.K * RESID_STAGGER) / 64ull;
                while (__builtin_amdgcn_s_memrealtime() - t0 < ticks) __builtin_amdgcn_s_sleep(32);
            }
            pg8::gemm_phase<pg8::EpiResid, pg8::PanelOrder, true, true>(lds, g, S, E, TID);
        } else if (kind == K_QKN) {
            if (L == 0) qknorm_phase(TID, RB, 1536, 16, 4, a->in[11], a->in[12], true, 0.125f * LOG2E, lds);
            else qknorm_phase(TID, RB, 3072, 16, 16, a->in[16], a->in[17], false, 0.125f * LOG2E, lds);
        } else if (kind == K_ATT) {
            if (L == 0) attn_phase<0>(TID, a, lds); else if (L == 1) attn_phase<1>(TID, a, lds); else attn_phase<2>(TID, a, lds);
        } else if (kind == K_POOL) {
            pool_phase(TID, RA, RO, lds);
        } else if (kind == K_MLAN1) {
            mlanorm1_phase(TID, (bf16_t*)(ws + WS_PROJ), a->in[24], a->in[25]);
        } else if (kind == K_MLAN2) {
            mlanorm2_phase(TID, (bf16_t*)(ws + WS_QR), (bf16_t*)(ws + WS_KV), (const bf16_t*)(ws + WS_PROJ), (bf16_t*)(ws + WS_KR), a->in[28], a->in[29], 0.10206207261596577f * LOG2E, lds);
        }
        if (q + 1 < ph_hi * (1 + PROBE_N)) { xcd_barrier(xbar); for (int e = 0; e < PROBE_SYNC; ++e) xcd_barrier(xbar); }
    }
}

#ifndef MK_PER_PHASE
#define MK_PER_PHASE 0
#endif
extern "C" void kernel_launch(void* const* d_in, const int* in_sizes, int n_in, void* d_out, int out_size, void* d_ws, size_t ws_size, hipStream_t stream) {
    static int grid = 0;
    if (grid == 0) {
        if (n_in != 31 || in_sizes[0] != LAT * DM || out_size != LAT * DM || ws_size < WS_END) { fprintf(stderr, "kernel_launch: unexpected shapes (n_in %d, in0 %d, out %d, ws %zu < %zu)\n", n_in, n_in > 0 ? in_sizes[0] : -1, out_size, ws_size, (size_t)WS_END); grid = -1; return; }
        int dev = 0, cus = 0, per_cu = 0;
        if (hipGetDevice(&dev) != hipSuccess || hipDeviceGetAttribute(&cus, hipDeviceAttributeMultiprocessorCount, dev) != hipSuccess) { fprintf(stderr, "kernel_launch: device query failed\n"); grid = -1; return; }
        if (hipFuncSetAttribute((const void*)fwd_kernel, hipFuncAttributeMaxDynamicSharedMemorySize, LDS_BYTES) != hipSuccess) { fprintf(stderr, "kernel_launch: hipFuncSetAttribute failed\n"); grid = -1; return; }
        if (hipOccupancyMaxActiveBlocksPerMultiprocessor(&per_cu, (const void*)fwd_kernel, NTHREADS, LDS_BYTES) != hipSuccess || per_cu < 1) { fprintf(stderr, "kernel_launch: occupancy query says %d blocks per CU\n", per_cu); per_cu = 1; }
        (void)hipGetLastError();
        grid = cus * (per_cu > 1 ? 1 : per_cu);
        if (grid % 32 != 0) { fprintf(stderr, "kernel_launch: grid %d is not a multiple of 32 (the fused norm epilogues deal row panels to 4 workgroups per XCD)\n", grid); grid = -1; return; }
    }
    if (grid < 0) return;
    Args a{};
    for (int i = 0; i < 31; ++i) a.in[i] = (const float*)d_in[i];
    a.out = (float*)d_out; a.ws = (unsigned char*)d_ws;
#if MK_PER_PHASE
    for (int p = 0; p < NPHASES; ++p) { a.ph_lo = p; a.ph_hi = p + 1; hipLaunchKernelGGL(fwd_kernel, dim3(grid), dim3(NTHREADS), LDS_BYTES, stream, a); }
#else
    a.ph_lo = 0; a.ph_hi = NPHASES;
    if (hipMemsetAsync((char*)d_ws + WS_CTL, 0, CTL_ZERO_BYTES, stream) != hipSuccess) { fprintf(stderr, "kernel_launch: memset of the barrier words failed\n"); return; }
    void* args[] = {&a};
    hipError_t e = hipLaunchCooperativeKernel((const void*)fwd_kernel, dim3(grid), dim3(NTHREADS), args, LDS_BYTES, stream);
    if (e != hipSuccess) fprintf(stderr, "kernel_launch: cooperative launch failed: %s (grid %d)\n", hipGetErrorString(e), grid);
#endif
}
```
